# Optimizing an MI355X kernel written in HIP

```python
import math
import jax, jax.numpy as jnp
from jax import lax
import numpy as np

D_MODEL = 1024
BATCH = 4
SEQ = 8192
DEPTH = 2

CHUNK = 64
N_A_LAYERS = DEPTH // 2
N_B_LAYERS = DEPTH - N_A_LAYERS
CONV_WIDTH = 31
N_HEADS = 8
QK_NOPE_DIM = 128
QK_ROPE_DIM = 64
V_HEAD_DIM = 128
Q_LORA_RANK = 384
KV_LORA_RANK = 256
ROPE_THETA = 10000.0
Q_BLOCK = 128
N_EXPERTS = 32
TOP_K = 4
D_EXPERT = 1024
SWIGLU_ALPHA = 1.702
SWIGLU_LIMIT = 7.0
EXPERT_BLOCK = 256
EPS = 1e-6

kernel_name = "yoco_conformer_mla_moe_adaln"


def rms_norm(x, g):
    xf = x.astype(jnp.float32)
    y = xf * lax.rsqrt(jnp.mean(xf * xf, axis=-1, keepdims=True) + EPS)
    return (y * g.astype(jnp.float32)).astype(x.dtype)


def layer_norm(x, g, b):
    xf = x.astype(jnp.float32)
    mu = jnp.mean(xf, axis=-1, keepdims=True)
    d = xf - mu
    var = jnp.mean(d * d, axis=-1, keepdims=True)
    return (d * lax.rsqrt(var + EPS) * g.astype(jnp.float32) + b.astype(jnp.float32)).astype(x.dtype)


def modulate(h, shift, scale):
    return h * (1 + scale[:, None, :]) + shift[:, None, :]


def rope_tables(positions):
    half = QK_ROPE_DIM // 2
    inv = jnp.exp(-(2.0 * math.log(ROPE_THETA) / QK_ROPE_DIM) * jnp.arange(half, dtype=jnp.float32))
    ang = positions.astype(jnp.float32)[..., None] * inv
    return jnp.cos(ang), jnp.sin(ang)


def apply_rope(x, cos, sin):
    half = x.shape[-1] // 2
    xf = x.astype(jnp.float32)
    x1, x2 = xf[..., :half], xf[..., half:]
    return jnp.concatenate([x1 * cos - x2 * sin, x2 * cos + x1 * sin], axis=-1).astype(x.dtype)


def conformer_conv(h, pw1_w, pw1_b, dw_w, dw_b, ln_g, ln_b, pw2_w, pw2_b):
    u = h @ pw1_w + pw1_b
    a, g = jnp.split(u, 2, axis=-1)
    u = a * jax.nn.sigmoid(g)
    u = lax.conv_general_dilated(
        u, dw_w[:, None, :].astype(u.dtype), window_strides=(1,),
        padding=[(CONV_WIDTH - 1, 0)], dimension_numbers=('NWC', 'WIO', 'NWC'),
        feature_group_count=D_MODEL) + dw_b
    u = jax.nn.silu(layer_norm(u, ln_g, ln_b))
    return u @ pw2_w + pw2_b


def mla_shared_kv(h, cos, sin, kv_norm_g, w_dkv, ckv_norm_g, w_uk, w_uv):
    hn = rms_norm(h, kv_norm_g)
    lat = hn @ w_dkv
    c_kv = rms_norm(lat[..., :KV_LORA_RANK], ckv_norm_g)
    k_rope = apply_rope(lat[..., KV_LORA_RANK:], cos, sin)
    k_nope = jnp.einsum('bsr,rhd->bshd', c_kv, w_uk)
    v = jnp.einsum('bsr,rhd->bshd', c_kv, w_uv)
    return k_nope, k_rope, v


def mla_attention(h, k_nope, k_rope, v, cos, sin, w_dq, cq_norm_g, w_uq, w_o):
    b, s, _ = h.shape
    c_q = rms_norm(h @ w_dq, cq_norm_g)
    q = jnp.einsum('bsr,rhd->bshd', c_q, w_uq)
    q_nope = q[..., :QK_NOPE_DIM]
    q_rope = apply_rope(q[..., QK_NOPE_DIM:], cos[:, :, None, :], sin[:, :, None, :])
    n_qb = s // Q_BLOCK

    def to_blocks(t):
        return jnp.moveaxis(t.reshape(b, n_qb, Q_BLOCK, *t.shape[2:]), 1, 0)

    key_chunk = jnp.arange(s) // CHUNK
    scale = (QK_NOPE_DIM + QK_ROPE_DIM) ** -0.5

    def attend(args):
        qn, qr, qb = args
        sc = (jnp.einsum('bqhd,bkhd->bhqk', qn, k_nope)
              + jnp.einsum('bqhr,bkr->bhqk', qr, k_rope)).astype(jnp.float32) * scale
        q_chunk = (qb * Q_BLOCK + jnp.arange(Q_BLOCK)) // CHUNK
        sc = jnp.where(key_chunk[None, :] <= q_chunk[:, None], sc, -jnp.inf)
        p = jax.nn.softmax(sc, axis=-1).astype(v.dtype)
        return jnp.einsum('bhqk,bkhd->bqhd', p, v)

    o = lax.map(attend, (to_blocks(q_nope), to_blocks(q_rope), jnp.arange(n_qb)))
    o = jnp.moveaxis(o, 0, 1).reshape(b, s, N_HEADS * V_HEAD_DIM)
    return o @ w_o


def moe_ffn(h, router_w, router_b, w_gu, b_gu, w_dn, b_dn):
    b, s, d = h.shape
    n = b * s
    t = h.reshape(n, d)
    logits = (t @ router_w + router_b).astype(jnp.float32)
    top_logit, top_idx = lax.top_k(logits, TOP_K)
    gates = jax.nn.softmax(top_logit, axis=-1)
    n_assign = n * TOP_K
    flat_e = top_idx.reshape(-1)
    order = jnp.argsort(flat_e)
    e_sorted = flat_e[order]
    tok_sorted = (order // TOP_K).astype(jnp.int32)
    gate_sorted = gates.reshape(-1)[order]
    counts = jnp.bincount(flat_e, length=N_EXPERTS)
    padded = (counts + EXPERT_BLOCK - 1) // EXPERT_BLOCK * EXPERT_BLOCK
    pad_end = jnp.cumsum(padded)
    pad_start = pad_end - padded
    start = jnp.cumsum(counts) - counts
    dest = pad_start[e_sorted] + jnp.arange(n_assign) - start[e_sorted]
    n_rows = -(-(n_assign + N_EXPERTS * (EXPERT_BLOCK - 1)) // EXPERT_BLOCK) * EXPERT_BLOCK
    n_blocks = n_rows // EXPERT_BLOCK
    row_tok = jnp.zeros((n_rows,), jnp.int32).at[dest].set(tok_sorted)
    row_gate = jnp.zeros((n_rows,), h.dtype).at[dest].set(gate_sorted.astype(h.dtype))
    block_expert = jnp.minimum(
        jnp.searchsorted(pad_end, jnp.arange(n_blocks) * EXPERT_BLOCK, side='right'), N_EXPERTS - 1)
    x_blocks = t[row_tok].reshape(n_blocks, EXPERT_BLOCK, d)

    def expert_block(args):
        xb, e = args
        gu = xb @ w_gu[e] + b_gu[e]
        g = jnp.minimum(gu[:, :D_EXPERT], SWIGLU_LIMIT)
        u = jnp.clip(gu[:, D_EXPERT:], -SWIGLU_LIMIT, SWIGLU_LIMIT)
        a = (u + 1) * g * jax.nn.sigmoid(SWIGLU_ALPHA * g)
        return a @ w_dn[e] + b_dn[e]

    y_rows = lax.map(expert_block, (x_blocks, block_expert)).reshape(n_rows, d)
    out = jnp.zeros((n, d), h.dtype).at[row_tok].add(y_rows * row_gate[:, None])
    return out.reshape(b, s, d)


def setup_inputs(seed: int = 0) -> dict:
    key = jax.random.key(seed)
    ks = jax.random.split(key, 32)
    D = D_MODEL

    def nrm(k, shape, scale):
        return jax.random.normal(k, shape, jnp.float32) * scale

    def gain(k, shape):
        return 1.0 + 0.02 * jax.random.normal(k, shape, jnp.float32)

    offsets = jax.random.randint(ks[2], (BATCH, 1), 0, 64, dtype=jnp.int32) * CHUNK
    positions = offsets + jnp.arange(SEQ, dtype=jnp.int32)[None, :]
    return {
        "x": nrm(ks[0], (BATCH, SEQ, D), 1.0),
        "c": nrm(ks[1], (BATCH, D), 1.0),
        "positions": positions,
        "mod_w": nrm(ks[3], (DEPTH, D, 6 * D), D ** -0.5),
        "mod_b": nrm(ks[4], (DEPTH, 6 * D), 0.02),
        "norm1_g": gain(ks[5], (DEPTH, D)),
        "norm2_g": gain(ks[6], (DEPTH, D)),
        "conv_pw1_w": nrm(ks[7], (N_A_LAYERS, D, 2 * D), D ** -0.5),
        "conv_pw1_b": nrm(ks[8], (N_A_LAYERS, 2 * D), 0.02),
        "conv_dw_w": nrm(ks[9], (N_A_LAYERS, CONV_WIDTH, D), CONV_WIDTH ** -0.5),
        "conv_dw_b": nrm(ks[10], (N_A_LAYERS, D), 0.02),
        "conv_ln_g": gain(ks[11], (N_A_LAYERS, D)),
        "conv_ln_b": nrm(ks[12], (N_A_LAYERS, D), 0.02),
        "conv_pw2_w": nrm(ks[13], (N_A_LAYERS, D, D), D ** -0.5),
        "conv_pw2_b": nrm(ks[14], (N_A_LAYERS, D), 0.02),
        "kv_norm_g": gain(ks[15], (D,)),
        "w_dkv": nrm(ks[16], (D, KV_LORA_RANK + QK_ROPE_DIM), D ** -0.5),
        "ckv_norm_g": gain(ks[17], (KV_LORA_RANK,)),
        "w_uk": nrm(ks[18], (KV_LORA_RANK, N_HEADS, QK_NOPE_DIM), KV_LORA_RANK ** -0.5),
        "w_uv": nrm(ks[19], (KV_LORA_RANK, N_HEADS, V_HEAD_DIM), KV_LORA_RANK ** -0.5),
        "w_dq": nrm(ks[20], (N_B_LAYERS, D, Q_LORA_RANK), D ** -0.5),
        "cq_norm_g": gain(ks[21], (N_B_LAYERS, Q_LORA_RANK)),
        "w_uq": nrm(ks[22], (N_B_LAYERS, Q_LORA_RANK, N_HEADS, QK_NOPE_DIM + QK_ROPE_DIM), Q_LORA_RANK ** -0.5),
        "w_o": nrm(ks[23], (N_B_LAYERS, N_HEADS * V_HEAD_DIM, D), (N_HEADS * V_HEAD_DIM) ** -0.5),
        "router_w": nrm(ks[24], (DEPTH, D, N_EXPERTS), D ** -0.5),
        "router_b": nrm(ks[25], (DEPTH, N_EXPERTS), 0.01),
        "exp_w_gu": nrm(ks[26], (DEPTH, N_EXPERTS, D, 2 * D_EXPERT), D ** -0.5),
        "exp_b_gu": nrm(ks[27], (DEPTH, N_EXPERTS, 2 * D_EXPERT), 0.02),
        "exp_w_dn": nrm(ks[28], (DEPTH, N_EXPERTS, D_EXPERT, D), D_EXPERT ** -0.5),
        "exp_b_dn": nrm(ks[29], (DEPTH, N_EXPERTS, D), 0.02),
        "final_g": gain(ks[30], (D,)),
    }


def reference(x, c, positions, mod_w, mod_b, norm1_g, norm2_g,
              conv_pw1_w, conv_pw1_b, conv_dw_w, conv_dw_b, conv_ln_g, conv_ln_b,
              conv_pw2_w, conv_pw2_b, kv_norm_g, w_dkv, ckv_norm_g, w_uk, w_uv,
              w_dq, cq_norm_g, w_uq, w_o, router_w, router_b,
              exp_w_gu, exp_b_gu, exp_w_dn, exp_b_dn, final_g):
    cos, sin = rope_tables(positions)
    c_act = jax.nn.silu(c)
    k_nope = k_rope = v = None
    for l in range(DEPTH):
        mod = c_act @ mod_w[l] + mod_b[l]
        shift1, scale1, gate1, shift2, scale2, gate2 = jnp.split(mod, 6, axis=-1)
        hn = modulate(rms_norm(x, norm1_g[l]), shift1, scale1)
        if l < N_A_LAYERS:
            y = conformer_conv(hn, conv_pw1_w[l], conv_pw1_b[l], conv_dw_w[l], conv_dw_b[l],
                               conv_ln_g[l], conv_ln_b[l], conv_pw2_w[l], conv_pw2_b[l])
        else:
            j = l - N_A_LAYERS
            y = mla_attention(hn, k_nope, k_rope, v, cos, sin,
                              w_dq[j], cq_norm_g[j], w_uq[j], w_o[j])
        x = x + gate1[:, None, :] * y
        hn = modulate(rms_norm(x, norm2_g[l]), shift2, scale2)
        x = x + gate2[:, None, :] * moe_ffn(hn, router_w[l], router_b[l],
                                            exp_w_gu[l], exp_b_gu[l], exp_w_dn[l], exp_b_dn[l])
        if l == N_A_LAYERS - 1:
            k_nope, k_rope, v = mla_shared_kv(x, cos, sin, kv_norm_g, w_dkv, ckv_norm_g, w_uk, w_uv)
    return rms_norm(x, final_g)
```

```cpp
#define N_LAUNCH_MODE 0
#include <hip/hip_runtime.h>
#include <cstdio>
#include <cstdint>

#ifndef N_LAUNCH_MODE
#define N_LAUNCH_MODE 1
#endif
#ifndef NAIVE_GEMM
#define NAIVE_GEMM 0
#endif
#ifndef NAIVE_ATTN
#define NAIVE_ATTN 0
#endif

#define LAS __attribute__((address_space(3)))
typedef unsigned short bf16_t;
typedef short bf16x8 __attribute__((ext_vector_type(8)));
typedef float f32x4 __attribute__((ext_vector_type(4)));
typedef float f32x2 __attribute__((ext_vector_type(2)));
typedef float f32x16 __attribute__((ext_vector_type(16)));
typedef unsigned u32x4 __attribute__((ext_vector_type(4)));
typedef unsigned u32x2 __attribute__((ext_vector_type(2)));

constexpr int D = 1024, NB = 4, SEQ = 8192, NTOK = NB * SEQ;
constexpr int CONVW = 31, NH = 8, DNOPE = 128, DROPE = 64, DQK = 192, DV = 128, QLORA = 384, KVLORA = 256;
constexpr int NE = 32, TOPK = 4, DE = 1024, EBLK = 256;
constexpr int NASSIGN = NTOK * TOPK;
constexpr int NROWS = ((NASSIGN + NE * (EBLK - 1) + EBLK - 1) / EBLK) * EBLK;
constexpr int MAXBLK = NROWS / EBLK;
constexpr float EPS = 1e-6f;
constexpr int NTHR = 512, NWAVE = 8;
constexpr int LDS_BYTES = 147456;
constexpr int LDS_MISC = 135168;

constexpr size_t MiB = (size_t)1 << 20;
constexpr size_t WS_CTL = 0;
constexpr size_t WS_BLKCNT = 64 * 1024;
constexpr size_t WS_BEXP = 192 * 1024;
constexpr size_t WS_MOD = 1 * MiB;
constexpr size_t WS_TOPI = 2 * MiB;
constexpr size_t WS_GATE = WS_TOPI + 512 * 1024;
constexpr size_t WS_RANK = WS_GATE + 512 * 1024;
constexpr size_t WS_SLOT = WS_RANK + 512 * 1024;
constexpr size_t WS_CS = 4 * MiB;
constexpr size_t WS_WPW1 = 16 * MiB;
constexpr size_t WS_WPW2 = WS_WPW1 + 4 * MiB;
constexpr size_t WS_WDKV = WS_WPW2 + 2 * MiB;
constexpr size_t WS_WDQ = WS_WDKV + 1 * MiB;
constexpr size_t WS_WUK = WS_WDQ + 1 * MiB;
constexpr size_t WS_WUV = WS_WUK + MiB / 2;
constexpr size_t WS_WUQ = WS_WUV + MiB / 2;
constexpr size_t WS_WO = WS_WUQ + 2 * MiB;
constexpr size_t WS_WGU = 32 * MiB;
constexpr size_t WS_WDN = WS_WGU + 256 * MiB;
constexpr size_t WS_X = WS_WDN + 128 * MiB;
constexpr size_t WS_HA = WS_X + 128 * MiB;
constexpr size_t WS_HB = WS_HA + 64 * MiB;
constexpr size_t WS_HC = WS_HB + 64 * MiB;
constexpr size_t WS_XG = WS_HC + 64 * MiB;
constexpr size_t WS_ACT = WS_XG + 272 * MiB;
constexpr size_t WS_END = WS_ACT + 272 * MiB;
constexpr size_t WS_LAT = WS_XG;
constexpr size_t WS_CQP = WS_LAT + 64 * MiB;
constexpr size_t WS_CKV = WS_CQP + 64 * MiB;
constexpr size_t WS_KR = WS_CKV + 16 * MiB;
constexpr size_t WS_CQ = WS_KR + 4 * MiB;
constexpr size_t WS_KN = WS_CQ + 28 * MiB;
constexpr size_t WS_VT = WS_KN + 64 * MiB;
constexpr size_t WS_Q = WS_VT + 64 * MiB;
static_assert(WS_Q + 96 * MiB <= WS_END, "ws map");

struct Args {
    const float* in[31]; float* out; unsigned char* ws; int ph_lo, ph_hi;
};
enum { I_X = 0, I_C, I_POS, I_MODW, I_MODB, I_N1G, I_N2G, I_PW1W, I_PW1B, I_DWW, I_DWB, I_LNG, I_LNB, I_PW2W, I_PW2B, I_KVG, I_WDKV, I_CKVG, I_WUK, I_WUV,
       I_WDQ, I_CQG, I_WUQ, I_WO, I_RW, I_RB, I_WGU, I_BGU, I_WDN, I_BDN, I_FG };

__device__ __forceinline__ unsigned cvt_pk_bf16(float lo, float hi) { unsigned r; asm volatile("v_cvt_pk_bf16_f32 %0, %1, %2" : "=v"(r) : "v"(lo), "v"(hi)); return r; }
__device__ __forceinline__ float bf2f(unsigned short b) { return __uint_as_float(((unsigned)b) << 16); }
__device__ __forceinline__ float bflo(unsigned w) { return __uint_as_float(w << 16); }
__device__ __forceinline__ float bfhi(unsigned w) { return __uint_as_float(w & 0xffff0000u); }
__device__ __forceinline__ float wave_sum(float v) {
#pragma unroll
    for (int o = 32; o >= 1; o >>= 1) v += __shfl_xor(v, o);
    return v;
}
__device__ __forceinline__ float sigmoidf_(float x) { return 1.0f / (1.0f + __expf(-x)); }
#define XB_TMO      128
#define XB_XCNT(j)  (256  + 64 * (j))
#define XB_XSUB(j)  (1280 + 64 * (j))
#define XB_XGEN(j)  (2304 + 64 * (j))
#define XB_TOP      3328
#define XB_TOPGEN   3392
#define XCD_BAR_WORDS 3456
#define XB_SPIN_CAP (1u << 18)

__device__ __forceinline__ unsigned xb_ld(unsigned* p)              { return __hip_atomic_load(p, __ATOMIC_RELAXED, __HIP_MEMORY_SCOPE_AGENT); }
__device__ __forceinline__ unsigned xb_add(unsigned* p, unsigned v) { return __hip_atomic_fetch_add(p, v, __ATOMIC_RELAXED, __HIP_MEMORY_SCOPE_AGENT); }
__device__ __forceinline__ unsigned xb_xcc_id() { return (unsigned)__builtin_amdgcn_s_getreg((3 << 11) | 20) & 0xFu; }
#define XB_SPIN(cond, bar) do { unsigned _sp = 0; while (cond) { __builtin_amdgcn_s_sleep(1); \
    if ((++_sp & 255u) == 0u) { if (xb_ld(&(bar)[XB_TMO])) break; if (_sp > XB_SPIN_CAP) { atomicAdd(&(bar)[XB_TMO], 1u); break; } } } } while (0)

struct XcdBarrier {
    unsigned* bar; unsigned x;
    volatile LAS unsigned* st;
};

__device__ __forceinline__ XcdBarrier xcd_barrier_post(unsigned* bar, volatile LAS unsigned* st) {
    XcdBarrier b; b.bar = bar; b.x = xb_xcc_id(); b.st = st;
    if (threadIdx.x == 0) (void)xb_add(&bar[XB_XCNT(b.x)], 1u);
    return b;
}
__device__ __forceinline__ void xcd_barrier_complete(unsigned* bar, unsigned x, unsigned& nloc, unsigned& nx) {
    const unsigned G = gridDim.x * gridDim.y * gridDim.z;
    unsigned sum, cnt, mine, sp = 0u;
    for (;;) {
        sum = 0u; cnt = 0u; mine = 0u;
#pragma unroll
        for (unsigned j = 0; j < 16; ++j) { const unsigned c = xb_ld(&bar[XB_XCNT(j)]); sum += c; cnt += (c > 0u) ? 1u : 0u; mine = (j == x) ? c : mine; }
        if (sum == G) break;
        __builtin_amdgcn_s_sleep(1);
        if ((++sp & 255u) == 0u) { if (xb_ld(&bar[XB_TMO])) break; if (sp > XB_SPIN_CAP) { atomicAdd(&bar[XB_TMO], 1u); break; } }
    }
    nloc = mine > 0u ? mine : 1u; nx = cnt > 0u ? cnt : 1u;
}

__device__ __forceinline__ void xcd_barrier(const XcdBarrier& b) {
    asm volatile("s_waitcnt vmcnt(0)" ::: "memory");
    __syncthreads();
    if (threadIdx.x == 0) {
        unsigned* bar = b.bar;
        __builtin_amdgcn_s_waitcnt(0);
        unsigned nloc = b.st[0], nx = b.st[1];
        if (nloc == 0u) { xcd_barrier_complete(bar, b.x, nloc, nx); b.st[0] = nloc; b.st[1] = nx; }
        const unsigned old = xb_add(&bar[XB_XSUB(b.x)], 1u);
        const unsigned gen = old / nloc;
        if (old + 1u == (gen + 1u) * nloc) {
            __builtin_amdgcn_fence(__ATOMIC_RELEASE, "agent");
            asm volatile("s_waitcnt vmcnt(0)" ::: "memory");
            const unsigned og = xb_add(&bar[XB_TOP], 1u);
            const unsigned tg = og / nx;
            if (og + 1u == (tg + 1u) * nx) xb_add(&bar[XB_TOPGEN], 1u);
            else XB_SPIN(xb_ld(&bar[XB_TOPGEN]) == tg, bar);
            __builtin_amdgcn_fence(__ATOMIC_ACQUIRE, "agent");
            xb_add(&bar[XB_XGEN(b.x)], 1u);
            asm volatile("s_waitcnt vmcnt(0)" ::: "memory");
        } else {
            XB_SPIN(xb_ld(&bar[XB_XGEN(b.x)]) == gen, bar);
            __builtin_amdgcn_fence(__ATOMIC_ACQUIRE, "agent");
            asm volatile("s_waitcnt vmcnt(0)" ::: "memory");
        }
    }
    __syncthreads();
}
namespace pg8 {
#define PG8_LAS __attribute__((address_space(3)))
constexpr int BM = 256, BK = 64, HALF = 128, HTB = HALF * BK * 2  , STAGE_BYTES = 8 * HTB, NXCD = 8, WGM = 8;

__host__ __device__ __forceinline__ int lds_byte(int r, int c) { const int st = (r >> 4) * 2 + (c >> 5), rr = r & 15, cc = c & 31, ob = rr * 64 + cc * 2; return st * 1024 + (ob ^ (((ob >> 9) & 1) << 5)); }
__host__ __device__ __forceinline__ void stage_rc(int b, int& R, int& C) { const int st = b / 1024, sb = b % 1024, swz = sb ^ (((sb >> 9) & 1) << 5); R = (st >> 1) * 16 + swz / 64; C = (st & 1) * 32 + (swz % 64) / 2; }
__host__ __device__ __forceinline__ int perm32(int rho) { const int n = rho >> 4, i = rho & 15; return 8 * (i >> 2) + 4 * n + (i & 3); }

struct Unit { int pm, pn; };
struct Gemm { const bf16_t* A; const bf16_t* Bt; int M, N, K; };

struct StaticOrder {
    int nM, nN, nwg, G, c;
    __host__ __device__ void init(int M, int N, int G_, int c_) { nM = M / BM; nN = N / BM; nwg = nM * nN; G = G_; c = c_; }
    __host__ __device__ bool next(int i, Unit& u) const {
        const long L = (long)i * G + c; if (L >= nwg) return false;
        int wgid = (int)L; { const int q = nwg / NXCD, r = nwg % NXCD, xcd = wgid % NXCD, off = wgid / NXCD; wgid = (xcd < r ? xcd * (q + 1) : r * (q + 1) + (xcd - r) * q) + off; }
        const int nig = WGM * nN, gid = wgid / nig, fm = gid * WGM, gsz = (nM - fm) < WGM ? (nM - fm) : WGM;
        u.pm = fm + ((wgid % nig) % gsz); u.pn = (wgid % nig) / gsz; return true;
    }
    __device__ __forceinline__ void a_ready(const Unit&) const {}
    __device__ __forceinline__ size_t boff(const Unit& u, size_t tstep) const { return (size_t)u.pn * tstep; }
    __device__ __forceinline__ void done(const Unit&) const {}
};
template <class Epi, class Sched>
__device__ __forceinline__ void gemm_phase(PG8_LAS unsigned char* lds, const Gemm g, const Sched& S, const Epi& E) {
    constexpr bool STAMP = false; unsigned long long* stamps = nullptr;
    int tid_ = threadIdx.x; asm volatile("" : "+v"(tid_));
    const int tid = tid_, wid = __builtin_amdgcn_readfirstlane(tid >> 6), lane = tid & 63, wr = wid >> 2, wc = wid & 3, fr = lane & 15, fq = lane >> 4;
    const int K = g.K, nt = K / BK;
    int ts_lo = 0, ts_hi = 0, nts = 0; const unsigned long long rt_entry = STAMP ? (unsigned long long)wall_clock64() : 0ull;
#define PG8_STAMP() do { if (STAMP && wid == 0 && nts < 64) { const unsigned long long _c = (unsigned long long)clock64(); \
        ts_lo = (lane == nts) ? (int)(unsigned)_c : ts_lo; ts_hi = (lane == nts) ? (int)(unsigned)(_c >> 32) : ts_hi; ++nts; } } while (0)
    PG8_STAMP();
    unsigned voffA[2], voffB[2];
#pragma unroll
    for (int i = 0; i < 2; ++i) { int R, C; stage_rc(tid * 16 + i * 8192, R, C); const int Rb = Epi::PERM ? ((R & ~31) + perm32(R & 31)) : R;
        voffA[i] = (unsigned)(R * K + C) * 2u; voffB[i] = (unsigned)(Rb * K + C) * 2u; }
    const size_t kstep = (size_t)(BK * 2);
    const size_t hstep = (size_t)HALF * K * 2;
    const size_t tstep = 2 * hstep;
    const unsigned ldsw = (unsigned)wid * 1024u;
    const int aoff = lds_byte(wr * 64 + fr, fq * 8), boff = lds_byte(wc * 32 + fr, fq * 8);
#define PG8_SA(b, h) (((b) * 2 + (h)) * HTB)
#define PG8_SB(b, h) ((4 + (b) * 2 + (h)) * HTB)
#define PG8_STAGE(bufoff, gbase, voff) do { _Pragma("unroll") for (int _i = 0; _i < 2; ++_i) \
        __builtin_amdgcn_global_load_lds((const unsigned*)((const char*)(gbase) + (voff)[_i]), (PG8_LAS unsigned*)(lds + (bufoff) + ldsw + _i * 8192), 16, 0, 0); } while (0)
#define PG8_LDA(dst, b, h) do { _Pragma("unroll") for (int m = 0; m < 4; ++m) _Pragma("unroll") for (int k = 0; k < 2; ++k) dst[m][k] = *(const PG8_LAS bf16x8*)(lds + PG8_SA(b, h) + aoff + m * 2048 + k * 1024); } while (0)
#define PG8_LDB(dst, b, h) do { _Pragma("unroll") for (int n = 0; n < 2; ++n) _Pragma("unroll") for (int k = 0; k < 2; ++k) dst[n][k] = *(const PG8_LAS bf16x8*)(lds + PG8_SB(b, h) + boff + n * 2048 + k * 1024); } while (0)
#define PG8_MMA(ai, bj, At, Bt) do { __builtin_amdgcn_s_setprio(1); _Pragma("unroll") for (int m = 0; m < 4; ++m) _Pragma("unroll") for (int n = 0; n < 2; ++n) _Pragma("unroll") for (int k = 0; k < 2; ++k) \
        acc[ai][bj][m][n] = __builtin_amdgcn_mfma_f32_16x16x32_bf16(Bt[n][k], At[m][k], acc[ai][bj][m][n], 0, 0, 0); __builtin_amdgcn_s_setprio(0); } while (0)
#define PG8_WAIT_V(n) asm volatile("s_waitcnt vmcnt(" #n ")" ::: "memory")
#define PG8_WAIT_L(n) asm volatile("s_waitcnt lgkmcnt(" #n ")" ::: "memory")
#define PG8_BAR __builtin_amdgcn_s_barrier()
#define PG8_SCHED __builtin_amdgcn_sched_barrier(0)
    Unit cur, nxt; int ui = 0;
    if (!S.next(0, cur)) return;
    f32x4 acc[2][2][4][2];
#pragma unroll
    for (int a = 0; a < 2; ++a)
#pragma unroll
        for (int b = 0; b < 2; ++b)
#pragma unroll
            for (int m = 0; m < 4; ++m)
#pragma unroll
                for (int n = 0; n < 2; ++n) acc[a][b][m][n] = (f32x4){0.f, 0.f, 0.f, 0.f};
    bf16x8 At[4][2], B0[2][2], B1[2][2];
    const char* cA = (const char*)g.A + (size_t)cur.pm * tstep; const char* cB = (const char*)g.Bt + S.boff(cur, tstep);
    S.a_ready(cur);
    PG8_STAGE(PG8_SB(0, 0), cB, voffB); PG8_STAGE(PG8_SA(0, 0), cA, voffA); PG8_STAGE(PG8_SB(0, 1), cB + hstep, voffB); PG8_STAGE(PG8_SA(0, 1), cA + hstep, voffA);
    if (wr == 1) PG8_BAR;
    PG8_WAIT_V(4); PG8_BAR;
    PG8_STAGE(PG8_SB(1, 0), cB + kstep, voffB); PG8_STAGE(PG8_SA(1, 0), cA + kstep, voffA); PG8_STAGE(PG8_SB(1, 1), cB + hstep + kstep, voffB);
    PG8_WAIT_V(6); PG8_BAR;
    PG8_STAMP();
    for (;;) {
        const bool has_next = S.next(ui + 1, nxt);
        const char* nA = has_next ? (const char*)g.A + (size_t)nxt.pm * tstep : cA; const char* nB = has_next ? (const char*)g.Bt + S.boff(nxt, tstep) : cB;
        for (int t = 0; t < nt; t += 2) {
            const bool last = (t == nt - 2);
            const char* a1 = cA + (size_t)(t + 1) * kstep;
            const char* a2 = last ? nA : cA + (size_t)(t + 2) * kstep; const char* b2 = last ? nB : cB + (size_t)(t + 2) * kstep;
            const char* a3 = a2 + kstep; const char* b3 = b2 + kstep;
            if (last && has_next) S.a_ready(nxt);
            PG8_LDB(B0, 0, 0); PG8_SCHED; PG8_LDA(At, 0, 0); PG8_STAGE(PG8_SA(1, 1), a1 + hstep, voffA);
            PG8_WAIT_L(8); PG8_BAR; PG8_WAIT_L(0); PG8_MMA(0, 0, At, B0); PG8_BAR; PG8_SCHED;
            PG8_LDB(B1, 0, 1); PG8_STAGE(PG8_SB(0, 0), b2, voffB);
            PG8_BAR; PG8_WAIT_L(0); PG8_MMA(0, 1, At, B1); PG8_BAR;
            PG8_LDA(At, 0, 1); PG8_STAGE(PG8_SA(0, 0), a2, voffA);
            PG8_BAR; PG8_WAIT_L(0); PG8_MMA(1, 0, At, B0); PG8_BAR; PG8_SCHED;
            PG8_STAGE(PG8_SB(0, 1), b2 + hstep, voffB);
            PG8_WAIT_V(6); PG8_BAR; PG8_MMA(1, 1, At, B1); PG8_BAR;
            PG8_LDB(B0, 1, 0); PG8_SCHED; PG8_LDA(At, 1, 0); PG8_STAGE(PG8_SA(0, 1), a2 + hstep, voffA);
            PG8_WAIT_L(8); PG8_BAR; PG8_WAIT_L(0); PG8_MMA(0, 0, At, B0); PG8_BAR; PG8_SCHED;
            PG8_LDB(B1, 1, 1); PG8_STAGE(PG8_SB(1, 0), b3, voffB);
            PG8_BAR; PG8_WAIT_L(0); PG8_MMA(0, 1, At, B1); PG8_BAR;
            PG8_LDA(At, 1, 1); PG8_STAGE(PG8_SA(1, 0), a3, voffA);
            PG8_BAR; PG8_WAIT_L(0); PG8_MMA(1, 0, At, B0); PG8_BAR; PG8_SCHED;
            PG8_STAGE(PG8_SB(1, 1), b3 + hstep, voffB);
            PG8_WAIT_V(6); PG8_BAR; PG8_MMA(1, 1, At, B1); PG8_BAR;
        }
        PG8_STAMP();
        if constexpr (!Epi::AFTER_DRAIN) { E(acc, cur, wr, wc, fr, fq); S.done(cur); }
        PG8_STAMP();
        if (!has_next) break;
#pragma unroll
        for (int a = 0; a < 2; ++a)
#pragma unroll
            for (int b = 0; b < 2; ++b)
#pragma unroll
                for (int m = 0; m < 4; ++m)
#pragma unroll
                    for (int n = 0; n < 2; ++n) acc[a][b][m][n] = (f32x4){0.f, 0.f, 0.f, 0.f};
        cur = nxt; cA = nA; cB = nB; ++ui;
    }
    PG8_WAIT_V(0);
    if (wr == 0) PG8_BAR;
    PG8_BAR;
    if constexpr (Epi::AFTER_DRAIN) { E.fused(acc, cur, wr, wc, fr, fq, lds, wid, lane); S.done(cur); }
    PG8_STAMP();
    if (STAMP && wid == 0) { stamps[lane] = lane < nts ? (((unsigned long long)(unsigned)ts_hi << 32) | (unsigned)ts_lo) : 0ull;
        if (lane == 62) stamps[62] = rt_entry; if (lane == 63) stamps[63] = (unsigned long long)wall_clock64(); }
#undef PG8_STAMP
#undef PG8_SA
#undef PG8_SB
#undef PG8_STAGE
#undef PG8_LDA
#undef PG8_LDB
#undef PG8_MMA
#undef PG8_WAIT_V
#undef PG8_WAIT_L
#undef PG8_BAR
#undef PG8_SCHED
}
}
namespace pg8 {
struct MoeOrder : StaticOrder {
    const int* bexp; size_t estride;
    __device__ __forceinline__ size_t boff(const Unit& u, size_t tstep) const { return (size_t)__builtin_amdgcn_readfirstlane(bexp[1 + u.pm]) * estride + (size_t)u.pn * tstep; }
};


template <int MODE> struct EpiGated {
    static constexpr bool PERM = true, AFTER_DRAIN = false;
    bf16_t* O; int ldo; const float* bias; int nh; const int* bexp;
    __device__ __forceinline__ void operator()(const f32x4 (&acc)[2][2][4][2], const Unit& u, int wr, int wc, int fr, int fq) const {
        const int row0 = u.pm * BM + wr * 64 + fr, colh = u.pn * HALF + wc * 32 + 8 * fq;
        const float* bp = bias; if (MODE == 1) bp += (size_t)__builtin_amdgcn_readfirstlane(bexp[1 + u.pm]) * (size_t)(2 * nh);
        f32x4 b0[2], b1[2];
#pragma unroll
        for (int n = 0; n < 2; ++n) { b0[n] = *(const f32x4*)(bp + colh + 4 * n); b1[n] = *(const f32x4*)(bp + nh + colh + 4 * n); }
#pragma unroll
        for (int ai = 0; ai < 2; ++ai)
#pragma unroll
            for (int m = 0; m < 4; ++m) {
                float o[8];
#pragma unroll
                for (int n = 0; n < 2; ++n) { const f32x4 a = acc[ai][0][m][n] + b0[n], g = acc[ai][1][m][n] + b1[n];
#pragma unroll
                    for (int j = 0; j < 4; ++j) {
                        if (MODE == 0) o[4 * n + j] = a[j] * sigmoidf_(g[j]);
                        else { const float gg = fminf(a[j], 7.0f), uu = fminf(fmaxf(g[j], -7.0f), 7.0f); o[4 * n + j] = (uu + 1.0f) * gg * sigmoidf_(1.702f * gg); } } }
                u32x4 w; w.x = cvt_pk_bf16(o[0], o[1]); w.y = cvt_pk_bf16(o[2], o[3]); w.z = cvt_pk_bf16(o[4], o[5]); w.w = cvt_pk_bf16(o[6], o[7]);
                *(u32x4*)(O + (size_t)(row0 + ai * HALF + m * 16) * ldo + colh) = w; }
    }
};
struct EpiBf16P {
    static constexpr bool PERM = true, AFTER_DRAIN = false;
    bf16_t* O; int ldo; const float* bias; int nbias; const int* bexp;
    __device__ __forceinline__ void operator()(const f32x4 (&acc)[2][2][4][2], const Unit& u, int wr, int wc, int fr, int fq) const {
        const int row0 = u.pm * BM + wr * 64 + fr, col0 = u.pn * BM + wc * 32 + 8 * fq;
        const float* bp = bias; if (bias && bexp) bp += (size_t)__builtin_amdgcn_readfirstlane(bexp[1 + u.pm]) * (size_t)nbias;
        f32x4 bv[2][2];
#pragma unroll
        for (int bj = 0; bj < 2; ++bj)
#pragma unroll
            for (int n = 0; n < 2; ++n) bv[bj][n] = bias ? *(const f32x4*)(bp + col0 + bj * HALF + 4 * n) : (f32x4){0.f, 0.f, 0.f, 0.f};
#pragma unroll
        for (int ai = 0; ai < 2; ++ai)
#pragma unroll
            for (int m = 0; m < 4; ++m) { bf16_t* rowp = O + (size_t)(row0 + ai * HALF + m * 16) * ldo + col0;
#pragma unroll
                for (int bj = 0; bj < 2; ++bj) { const f32x4 v0 = acc[ai][bj][m][0] + bv[bj][0], v1 = acc[ai][bj][m][1] + bv[bj][1];
                    u32x4 w; w.x = cvt_pk_bf16(v0[0], v0[1]); w.y = cvt_pk_bf16(v0[2], v0[3]); w.z = cvt_pk_bf16(v1[0], v1[1]); w.w = cvt_pk_bf16(v1[2], v1[3]);
                    *(u32x4*)(rowp + bj * HALF) = w; } }
    }
};
struct EpiF32P {
    static constexpr bool PERM = false, AFTER_DRAIN = false;
    float* C; int ldc;
    __device__ __forceinline__ void operator()(const f32x4 (&acc)[2][2][4][2], const Unit& u, int wr, int wc, int fr, int fq) const {
        const int row0 = u.pm * BM + wr * 64 + fr, col0 = u.pn * BM + wc * 32 + 4 * fq;
#pragma unroll
        for (int ai = 0; ai < 2; ++ai)
#pragma unroll
            for (int m = 0; m < 4; ++m) { float* rowp = C + (size_t)(row0 + ai * HALF + m * 16) * ldc + col0;
#pragma unroll
                for (int bj = 0; bj < 2; ++bj)
#pragma unroll
                    for (int n = 0; n < 2; ++n) *(f32x4*)(rowp + bj * HALF + n * 16) = acc[ai][bj][m][n]; }
    }
};
struct EpiResid {
    static constexpr bool PERM = false, AFTER_DRAIN = false;
    const float* base; float* X; const float* bias; const float* gate;
    __device__ __forceinline__ void operator()(const f32x4 (&acc)[2][2][4][2], const Unit& u, int wr, int wc, int fr, int fq) const {
        const int row0 = u.pm * BM + wr * 64 + fr, col0 = u.pn * BM + wc * 32 + 4 * fq;
        const float* gp = gate + (size_t)((u.pm * BM) / SEQ) * (6 * D);
        f32x4 bv[2][2], gv[2][2];
#pragma unroll
        for (int bj = 0; bj < 2; ++bj)
#pragma unroll
            for (int n = 0; n < 2; ++n) { bv[bj][n] = bias ? *(const f32x4*)(bias + col0 + bj * HALF + n * 16) : (f32x4){0.f, 0.f, 0.f, 0.f}; gv[bj][n] = *(const f32x4*)(gp + col0 + bj * HALF + n * 16); }
#pragma unroll
        for (int ai = 0; ai < 2; ++ai)
#pragma unroll
            for (int m = 0; m < 4; ++m) { const size_t off = (size_t)(row0 + ai * HALF + m * 16) * D + col0;
#pragma unroll
                for (int bj = 0; bj < 2; ++bj)
#pragma unroll
                    for (int n = 0; n < 2; ++n) { const f32x4 bs = *(const f32x4*)(base + off + bj * HALF + n * 16);
                        *(f32x4*)(X + off + bj * HALF + n * 16) = bs + gv[bj][n] * (acc[ai][bj][m][n] + bv[bj][n]); } }
    }
};
struct EpiQRope {
    static constexpr bool PERM = true, AFTER_DRAIN = false;
    bf16_t* O; const f32x2* cs;
    __device__ __forceinline__ void operator()(const f32x4 (&acc)[2][2][4][2], const Unit& u, int wr, int wc, int fr, int fq) const {
        const int row0 = u.pm * BM + wr * 64 + fr, col0 = u.pn * BM + wc * 32 + 8 * fq;
#pragma unroll
        for (int bj = 0; bj < 2; ++bj) {
            const int c = col0 + bj * HALF, w = c % DQK; const bool rope = w >= DNOPE; const int k4 = rope ? ((w - DNOPE) >> 3) * 4 : 0;
#pragma unroll
            for (int ai = 0; ai < 2; ++ai)
#pragma unroll
                for (int m = 0; m < 4; ++m) { const int row = row0 + ai * HALF + m * 16;
                    f32x4 v0 = acc[ai][bj][m][0], v1 = acc[ai][bj][m][1];
                    if (rope) { const f32x4 t0 = *(const f32x4*)(cs + (size_t)row * 32 + k4), t1 = *(const f32x4*)(cs + (size_t)row * 32 + k4 + 2);
                        const float co[4] = {t0[0], t0[2], t1[0], t1[2]}, si[4] = {t0[1], t0[3], t1[1], t1[3]};
#pragma unroll
                        for (int j = 0; j < 4; ++j) { const float x1 = v0[j], x2 = v1[j]; v0[j] = x1 * co[j] - x2 * si[j]; v1[j] = x2 * co[j] + x1 * si[j]; } }
                    u32x4 wv; wv.x = cvt_pk_bf16(v0[0], v0[1]); wv.y = cvt_pk_bf16(v0[2], v0[3]); wv.z = cvt_pk_bf16(v1[0], v1[1]); wv.w = cvt_pk_bf16(v1[2], v1[3]);
                    *(u32x4*)(O + (size_t)row * (NH * DQK) + c) = wv;
                    asm volatile("" ::: "memory"); } }
    }
};

#if NAIVE_GEMM
template <class Epi, class Sched>
__device__ __forceinline__ void gemm_phase_naive(PG8_LAS unsigned char*, const Gemm g, const Sched& S, const Epi& E) {
    const int tid = threadIdx.x, wid = tid >> 6, lane = tid & 63, wr = wid >> 2, wc = wid & 3, fr = lane & 15, fq = lane >> 4;
    const size_t tstep = (size_t)BM * g.K * 2;
    Unit u;
    for (int i = 0; S.next(i, u); ++i) {
        f32x4 acc[2][2][4][2];
        const bf16_t* Bb = (const bf16_t*)((const char*)g.Bt + S.boff(u, tstep));
#pragma unroll 1
        for (int ai = 0; ai < 2; ++ai)
#pragma unroll 1
            for (int m = 0; m < 4; ++m) {
                const bf16_t* ar = g.A + (size_t)(u.pm * BM + ai * HALF + wr * 64 + m * 16 + fr) * g.K;
#pragma unroll
                for (int bj = 0; bj < 2; ++bj)
#pragma unroll
                    for (int n = 0; n < 2; ++n) {
                        const int cs = Epi::PERM ? (bj * HALF + wc * 32 + 8 * fq + 4 * n) : (bj * HALF + wc * 32 + 16 * n + 4 * fq);
                        float s[4] = {0.f, 0.f, 0.f, 0.f};
                        for (int k = 0; k < g.K; k += 8) {
                            const u32x4 av = *(const u32x4*)(ar + k);
#pragma unroll
                            for (int j = 0; j < 4; ++j) { const u32x4 bv = *(const u32x4*)(Bb + (size_t)(cs + j) * g.K + k);
                                s[j] += bflo(av.x) * bflo(bv.x) + bfhi(av.x) * bfhi(bv.x) + bflo(av.y) * bflo(bv.y) + bfhi(av.y) * bfhi(bv.y)
                                      + bflo(av.z) * bflo(bv.z) + bfhi(av.z) * bfhi(bv.z) + bflo(av.w) * bflo(bv.w) + bfhi(av.w) * bfhi(bv.w); } }
                        f32x4 r = {s[0], s[1], s[2], s[3]};
#pragma unroll
                        for (int a2 = 0; a2 < 2; ++a2)
#pragma unroll
                            for (int m2 = 0; m2 < 4; ++m2) if (a2 == ai && m2 == m) acc[a2][bj][m2][n] = r;
                    }
            }
        E(acc, u, wr, wc, fr, fq);
    }
}
#endif
}

#if NAIVE_GEMM
#define GEMM_PHASE pg8::gemm_phase_naive
#else
#define GEMM_PHASE pg8::gemm_phase
#endif
struct Frame {
    LAS unsigned char* lds; unsigned char* ws; const Args* a;
    int tid, lane, wave, G, blk;
};
__device__ __forceinline__ const float* modp(const Frame& F, int l, int b, int part) { return (const float*)(F.ws + WS_MOD) + ((size_t)(l * NB + b) * 6 + part) * D; }

enum { CM_ID = 0, CM_GLU = 1, CM_UQ = 2 };
__device__ __forceinline__ int cvt_srccol(int mode, int n, int nvalid, int nh) {
    if (mode == CM_GLU) { const int pn = n >> 8, r = n & 255; return r < 128 ? pn * 128 + r : nh + pn * 128 + (r - 128); }
    if (mode == CM_UQ) { const int h = n / DQK, w = n - h * DQK; if (w < DNOPE) return n; const int p = w - DNOPE, blk = p >> 3, wi = p & 7, i = 4 * blk + (wi & 3); return h * DQK + (wi < 4 ? DNOPE + i : DNOPE + 32 + i); }
    return n < nvalid ? n : -1;
}
struct CvtJob { const float* src; bf16_t* dst; int K, ld, ndst, nvalid, mode, batch; size_t sstride, dstride; float scale; };
__device__ __forceinline__ int cvt_tiles(const CvtJob& j) { return j.batch * (j.ndst / 128) * (j.K / 128); }
__device__ __forceinline__ void cvt_tile(const Frame& F, const CvtJob& J, int t) {
    const int nkt = J.K / 128, nnt = J.ndst / 128, per = nkt * nnt, bi = t / per, r = t - bi * per, nt = r / nkt, kt = r - nt * nkt;
    const float* src = J.src + (size_t)bi * J.sstride; bf16_t* dst = J.dst + (size_t)bi * J.dstride;
    const int nq = F.tid & 31, kg = F.tid >> 5, n0 = nt * 128, k0 = kt * 128;
    const int sc = cvt_srccol(J.mode, n0 + 4 * nq, J.nvalid, J.ndst / 2);
    f32x4 v[8];
#pragma unroll
    for (int i = 0; i < 8; ++i) v[i] = sc >= 0 ? *(const f32x4*)(src + (size_t)(k0 + 8 * kg + i) * J.ld + sc) * J.scale : (f32x4){0.f, 0.f, 0.f, 0.f};
#pragma unroll
    for (int j = 0; j < 4; ++j) {
        u32x4 w; w.x = cvt_pk_bf16(v[0][j], v[1][j]); w.y = cvt_pk_bf16(v[2][j], v[3][j]); w.z = cvt_pk_bf16(v[4][j], v[5][j]); w.w = cvt_pk_bf16(v[6][j], v[7][j]);
        *(LAS u32x4*)(F.lds + (4 * nq + j) * 256 + ((kg ^ (nq & 7)) << 4)) = w; }
    __syncthreads();
#pragma unroll
    for (int p = 0; p < 4; ++p) { const int row = p * 32 + (F.tid >> 4), c = F.tid & 15;
        const u32x4 w = *(const LAS u32x4*)(F.lds + row * 256 + ((c ^ ((row >> 2) & 7)) << 4));
        *(u32x4*)(dst + (size_t)(n0 + row) * J.K + k0 + c * 8) = w; }
    __syncthreads();
}
__device__ __forceinline__ void sincos_small(float r, float& s, float& c) {
    const float q = rintf(r * 0.63661977236758134f); const float y = fmaf(q, -1.5707963267948966f, r) + q * 4.371139e-8f; const int qi = (int)q & 3;
    const float y2 = y * y;
    const float sp = y + y * y2 * (-1.6666654611e-1f + y2 * (8.3321608736e-3f + y2 * (-1.9515295891e-4f)));
    const float cp = 1.0f - 0.5f * y2 + y2 * y2 * (4.166664568298827e-2f + y2 * (-1.388731625493765e-3f + y2 * 2.443315711809948e-5f));
    s = (qi == 0) ? sp : (qi == 1) ? cp : (qi == 2) ? -sp : -cp;
    c = (qi == 0) ? cp : (qi == 1) ? -sp : (qi == 2) ? -cp : sp;
}
__device__ __forceinline__ void ph_prologue(const Frame& F) {
    const Args& A = *F.a; unsigned char* ws = F.ws;
    const float qscale = 0.07216878364870322f * 1.4426950408889634f;
    CvtJob J[10];
    J[0] = {A.in[I_PW1W], (bf16_t*)(ws + WS_WPW1), 1024, 2048, 2048, 2048, CM_GLU, 1, 0, 0, 1.f};
    J[1] = {A.in[I_PW2W], (bf16_t*)(ws + WS_WPW2), 1024, 1024, 1024, 1024, CM_ID, 1, 0, 0, 1.f};
    J[2] = {A.in[I_WDKV], (bf16_t*)(ws + WS_WDKV), 1024, 320, 512, 320, CM_ID, 1, 0, 0, 1.f};
    J[3] = {A.in[I_WDQ], (bf16_t*)(ws + WS_WDQ), 1024, 384, 512, 384, CM_ID, 1, 0, 0, 1.f};
    J[4] = {A.in[I_WUK], (bf16_t*)(ws + WS_WUK), 256, 1024, 1024, 1024, CM_ID, 1, 0, 0, 1.f};
    J[5] = {A.in[I_WUV], (bf16_t*)(ws + WS_WUV), 256, 1024, 1024, 1024, CM_ID, 1, 0, 0, 1.f};
    J[6] = {A.in[I_WUQ], (bf16_t*)(ws + WS_WUQ), 384, 1536, 1536, 1536, CM_UQ, 1, 0, 0, qscale};
    J[7] = {A.in[I_WO], (bf16_t*)(ws + WS_WO), 1024, 1024, 1024, 1024, CM_ID, 1, 0, 0, 1.f};
    J[8] = {A.in[I_WGU], (bf16_t*)(ws + WS_WGU), 1024, 2048, 2048, 2048, CM_GLU, 64, (size_t)1024 * 2048, (size_t)2048 * 1024, 1.f};
    J[9] = {A.in[I_WDN], (bf16_t*)(ws + WS_WDN), 1024, 1024, 1024, 1024, CM_ID, 64, (size_t)1024 * 1024, (size_t)1024 * 1024, 1.f};
    int base = 0;
#pragma unroll
    for (int j = 0; j < 10; ++j) { const int nt = cvt_tiles(J[j]);
        int t = F.blk - (base % F.G); if (t < 0) t += F.G;
        for (; t < nt; t += F.G) cvt_tile(F, J[j], t);
        base += nt; }
    {
        LAS float* cact = (LAS float*)F.lds;
        LAS float* red = cact + 4096;
        for (int i = F.tid; i < NB * D; i += NTHR) { const float c = A.in[I_C][i]; cact[i] = c * sigmoidf_(c); }
        __syncthreads();
        for (int it = F.blk; it < 2 * 96; it += F.G) {
            const int l = it / 96, j0 = (it - l * 96) * 64, col = F.tid & 63, dg = F.tid >> 6;
            const float* wp = A.in[I_MODW] + (size_t)l * D * 6 * D + (size_t)(dg * 128) * (6 * D) + j0 + col;
            float a0 = 0.f, a1 = 0.f, a2 = 0.f, a3 = 0.f;
#pragma unroll 8
            for (int d = 0; d < 128; ++d) { const float w = wp[(size_t)d * (6 * D)]; const int dd = dg * 128 + d;
                a0 += w * cact[dd]; a1 += w * cact[1024 + dd]; a2 += w * cact[2048 + dd]; a3 += w * cact[3072 + dd]; }
            red[(dg * 4 + 0) * 64 + col] = a0; red[(dg * 4 + 1) * 64 + col] = a1; red[(dg * 4 + 2) * 64 + col] = a2; red[(dg * 4 + 3) * 64 + col] = a3;
            __syncthreads();
            if (F.tid < 256) { const int b = F.tid >> 6, c2 = F.tid & 63; float s = A.in[I_MODB][l * 6 * D + j0 + c2];
#pragma unroll
                for (int g = 0; g < 8; ++g) s += red[(g * 4 + b) * 64 + c2];
                ((float*)(ws + WS_MOD))[(size_t)(l * NB + b) * (6 * D) + j0 + c2] = s; }
            __syncthreads();
        }
    }
    {
        const int* pos = (const int*)A.in[I_POS]; f32x2* cs = (f32x2*)(ws + WS_CS);
        for (int idx = F.blk * NTHR + F.tid; idx < NTOK * 32; idx += F.G * NTHR) {
            const int tok = idx >> 5, i = idx & 31;
            const double inv = exp(-(2.0 * 9.210340371976184 / 64.0) * (double)i);
            const double ang = (double)pos[tok] * inv, rev = ang * 0.15915494309189535, fr = rev - rint(rev);
            float s, c; sincos_small((float)(fr * 6.283185307179586), s, c);
            cs[idx] = (f32x2){c, s};
        }
    }
}

__device__ __forceinline__ void row_ld16(const float* p, int lane, f32x4 (&v)[4]) {
#pragma unroll
    for (int i = 0; i < 4; ++i) v[i] = *(const f32x4*)(p + i * 256 + lane * 4);
}
__device__ __forceinline__ void row_st16_bf16(bf16_t* p, int lane, const f32x4 (&v)[4]) {
#pragma unroll
    for (int i = 0; i < 4; ++i) { u32x2 w; w.x = cvt_pk_bf16(v[i][0], v[i][1]); w.y = cvt_pk_bf16(v[i][2], v[i][3]); *(u32x2*)(p + i * 256 + lane * 4) = w; }
}
__device__ __forceinline__ float row_rstd(const f32x4 (&v)[4]) {
    float s = 0.f;
#pragma unroll
    for (int i = 0; i < 4; ++i) s += v[i][0] * v[i][0] + v[i][1] * v[i][1] + v[i][2] * v[i][2] + v[i][3] * v[i][3];
    s = wave_sum(s);
    return rsqrtf(s * (1.0f / D) + EPS);
}

__device__ __forceinline__ void ph_norm1(const Frame& F) {
    const Args& A = *F.a; bf16_t* HA = (bf16_t*)(F.ws + WS_HA); const float* g = A.in[I_N1G];
    for (int row = F.blk * NWAVE + F.wave; row < NTOK; row += F.G * NWAVE) {
        const int b = row / SEQ; f32x4 v[4], gv[4], sh[4], sc[4];
        row_ld16(A.in[I_X] + (size_t)row * D, F.lane, v); row_ld16(g, F.lane, gv); row_ld16(modp(F, 0, b, 0), F.lane, sh); row_ld16(modp(F, 0, b, 1), F.lane, sc);
        const float rs = row_rstd(v);
#pragma unroll
        for (int i = 0; i < 4; ++i) v[i] = v[i] * rs * gv[i] * (sc[i] + 1.0f) + sh[i];
        row_st16_bf16(HA + (size_t)row * D, F.lane, v);
    }
}

__device__ __forceinline__ void ph_conv(const Frame& F) {
    const Args& A = *F.a; const bf16_t* U = (const bf16_t*)(F.ws + WS_HB); bf16_t* O = (bf16_t*)(F.ws + WS_HC);
    LAS unsigned char* tile = F.lds;
    LAS f32x2* red = (LAS f32x2*)(F.lds + 62 * 2048);
    const int c2 = F.tid * 2;
    f32x2 w[CONVW];
#pragma unroll
    for (int j = 0; j < CONVW; ++j) w[j] = *(const f32x2*)(A.in[I_DWW] + j * D + c2);
    const f32x2 db = *(const f32x2*)(A.in[I_DWB] + c2), lg = *(const f32x2*)(A.in[I_LNG] + c2), lb = *(const f32x2*)(A.in[I_LNB] + c2);
    for (int t = F.blk; t < NTOK / 32; t += F.G) {
        const int tok0 = t * 32, s0 = tok0 % SEQ;
        for (int ch = F.tid; ch < 62 * 128; ch += NTHR) { const int r = ch >> 7, cc = ch & 127; u32x4 v = {0u, 0u, 0u, 0u};
            if (s0 + r - 30 >= 0) v = *(const u32x4*)(U + (size_t)(tok0 + r - 30) * D + cc * 8);
            *(LAS u32x4*)(tile + r * 2048 + cc * 16) = v; }
        __syncthreads();
#pragma unroll 1
        for (int g = 0; g < 4; ++g) {
            f32x2 acc[8];
#pragma unroll
            for (int r = 0; r < 8; ++r) acc[r] = db;
#pragma unroll
            for (int j = 0; j < 38; ++j) { const unsigned u = *(const LAS unsigned*)(tile + (g * 8 + j) * 2048 + F.tid * 4); const f32x2 x = {bflo(u), bfhi(u)};
#pragma unroll
                for (int r = 0; r < 8; ++r) { const int tap = j - r; if (tap >= 0 && tap < CONVW) acc[r] += x * w[tap]; } }
#pragma unroll
            for (int r = 0; r < 8; ++r) { float s = acc[r][0] + acc[r][1], q = acc[r][0] * acc[r][0] + acc[r][1] * acc[r][1];
                s = wave_sum(s); q = wave_sum(q); if (F.lane == 0) red[r * 8 + F.wave] = (f32x2){s, q}; }
            __syncthreads();
#pragma unroll
            for (int r = 0; r < 8; ++r) { float s = 0.f, q = 0.f;
#pragma unroll
                for (int k = 0; k < 8; ++k) { const f32x2 p = red[r * 8 + k]; s += p[0]; q += p[1]; }
                const float mean = s * (1.0f / D), var = fmaxf(q * (1.0f / D) - mean * mean, 0.f), rs = rsqrtf(var + EPS);
                const float y0 = (acc[r][0] - mean) * rs * lg[0] + lb[0], y1 = (acc[r][1] - mean) * rs * lg[1] + lb[1];
                *(unsigned*)(O + (size_t)(tok0 + g * 8 + r) * D + c2) = cvt_pk_bf16(y0 * sigmoidf_(y0), y1 * sigmoidf_(y1)); }
            __syncthreads();
        }
    }
}

__device__ __forceinline__ void ph_router(const Frame& F, int l) {
    const Args& A = *F.a; const float* X = (const float*)(F.ws + WS_X); bf16_t* HA = (bf16_t*)(F.ws + WS_HA);
    LAS float* rwT = (LAS float*)F.lds;
    LAS int* cnt = (LAS int*)(F.lds + 131072);
    const float* rw = A.in[I_RW] + (size_t)l * D * NE;
    for (int i = F.tid; i < D * NE; i += NTHR) { const int d = i >> 5, e = i & 31; rwT[e * D + d] = rw[i]; }
    if (F.tid < NE) cnt[F.tid] = 0;
    __syncthreads();
    const float* g = A.in[I_N2G] + l * D;
    int* topi = (int*)(F.ws + WS_TOPI); float* gate = (float*)(F.ws + WS_GATE); int* rank = (int*)(F.ws + WS_RANK);
    const int ntok_blk = NTOK / F.G;
    for (int it = F.wave; it < ntok_blk; it += NWAVE) {
        const int row = F.blk * ntok_blk + it, b = row / SEQ;
        f32x4 v[4], gv[4], sh[4], sc[4];
        row_ld16(X + (size_t)row * D, F.lane, v); row_ld16(g, F.lane, gv); row_ld16(modp(F, l, b, 3), F.lane, sh); row_ld16(modp(F, l, b, 4), F.lane, sc);
        const float rs = row_rstd(v);
#pragma unroll
        for (int i = 0; i < 4; ++i) v[i] = v[i] * rs * gv[i] * (sc[i] + 1.0f) + sh[i];
        row_st16_bf16(HA + (size_t)row * D, F.lane, v);
        float p[NE];
#pragma unroll
        for (int e = 0; e < NE; ++e) { float s = 0.f;
#pragma unroll
            for (int i = 0; i < 4; ++i) { const f32x4 wv = *(const LAS f32x4*)(rwT + e * D + i * 256 + F.lane * 4); s += v[i][0] * wv[0] + v[i][1] * wv[1] + v[i][2] * wv[2] + v[i][3] * wv[3]; }
            p[e] = s; }
#define RS_STEP(N_, BIT_) { const bool up = (F.lane & BIT_) != 0; _Pragma("unroll") for (int k = 0; k < N_; ++k) { const float keep = up ? p[k + N_] : p[k], send = up ? p[k] : p[k + N_]; p[k] = keep + __shfl_xor(send, BIT_); } }
        RS_STEP(16, 32) RS_STEP(8, 16) RS_STEP(4, 8) RS_STEP(2, 4) RS_STEP(1, 2)
#undef RS_STEP
        float logit = p[0] + __shfl_xor(p[0], 1);
        const int e = F.lane >> 1; logit += A.in[I_RB][l * NE + e];
        float tv[4]; int ti[4]; float cur = logit;
#pragma unroll
        for (int k = 0; k < 4; ++k) { float bv = cur; int bi = e;
#pragma unroll
            for (int o = 32; o >= 1; o >>= 1) { const float ov = __shfl_xor(bv, o); const int oi = __shfl_xor(bi, o); if (ov > bv || (ov == bv && oi < bi)) { bv = ov; bi = oi; } }
            tv[k] = bv; ti[k] = bi; if (e == bi) cur = -__builtin_inff(); }
        if (F.lane == 0) {
            const float e1 = __expf(tv[1] - tv[0]), e2 = __expf(tv[2] - tv[0]), e3 = __expf(tv[3] - tv[0]), inv = 1.0f / (1.0f + e1 + e2 + e3);
            *(f32x4*)(gate + (size_t)row * 4) = (f32x4){inv, e1 * inv, e2 * inv, e3 * inv};
            int4 tq, rq; tq.x = ti[0]; tq.y = ti[1]; tq.z = ti[2]; tq.w = ti[3];
            rq.x = __hip_atomic_fetch_add(&cnt[ti[0]], 1, __ATOMIC_RELAXED, __HIP_MEMORY_SCOPE_WORKGROUP); rq.y = __hip_atomic_fetch_add(&cnt[ti[1]], 1, __ATOMIC_RELAXED, __HIP_MEMORY_SCOPE_WORKGROUP); rq.z = __hip_atomic_fetch_add(&cnt[ti[2]], 1, __ATOMIC_RELAXED, __HIP_MEMORY_SCOPE_WORKGROUP); rq.w = __hip_atomic_fetch_add(&cnt[ti[3]], 1, __ATOMIC_RELAXED, __HIP_MEMORY_SCOPE_WORKGROUP);
            *(int4*)(topi + (size_t)row * 4) = tq; *(int4*)(rank + (size_t)row * 4) = rq;
        }
    }
    __syncthreads();
    if (F.tid < NE) ((int*)(F.ws + WS_BLKCNT))[(l * 256 + F.blk) * NE + F.tid] = cnt[F.tid];
    __syncthreads();
}

__device__ __forceinline__ void ph_scatter(const Frame& F, int l) {
    LAS int* part = (LAS int*)F.lds;
    LAS int* basee = part + 1024;
    const int* bc = (const int*)(F.ws + WS_BLKCNT) + l * 256 * NE;
    { const int e = F.tid & 31, pt = F.tid >> 5; int pre = 0, tot = 0;
      for (int b = pt * 16; b < pt * 16 + 16; ++b) { const int c = bc[b * NE + e]; tot += c; if (b < F.blk) pre += c; }
      part[pt * 32 + e] = pre; part[512 + pt * 32 + e] = tot; }
    __syncthreads();
    if (F.tid < NE) { int pre = 0, tot = 0;
        for (int pt = 0; pt < 16; ++pt) { pre += part[pt * 32 + F.tid]; tot += part[512 + pt * 32 + F.tid]; }
        part[F.tid] = pre; part[512 + F.tid] = tot; }
    __syncthreads();
    if (F.tid == 0) { int ps = 0; int* bexp = (int*)(F.ws + WS_BEXP) + l * 1024;
        for (int e = 0; e < NE; ++e) { const int padded = (part[512 + e] + EBLK - 1) / EBLK * EBLK; basee[e] = ps + part[e];
            if (F.blk == 0) for (int i = ps / EBLK; i < (ps + padded) / EBLK; ++i) bexp[1 + i] = e;
            ps += padded; }
        if (F.blk == 0) bexp[0] = ps / EBLK; }
    __syncthreads();
    const int* topi = (const int*)(F.ws + WS_TOPI); const int* rank = (const int*)(F.ws + WS_RANK); int* slot = (int*)(F.ws + WS_SLOT);
    const bf16_t* HA = (const bf16_t*)(F.ws + WS_HA); bf16_t* XG = (bf16_t*)(F.ws + WS_XG);
    const int ntok_blk = NTOK / F.G;
    for (int it = F.wave; it < ntok_blk; it += NWAVE) {
        const int row = F.blk * ntok_blk + it;
        const int4 tq = *(const int4*)(topi + (size_t)row * 4), rq = *(const int4*)(rank + (size_t)row * 4);
        int4 sq; sq.x = basee[tq.x] + rq.x; sq.y = basee[tq.y] + rq.y; sq.z = basee[tq.z] + rq.z; sq.w = basee[tq.w] + rq.w;
        if (F.lane == 0) *(int4*)(slot + (size_t)row * 4) = sq;
        const u32x4 v0 = *(const u32x4*)(HA + (size_t)row * D + F.lane * 8), v1 = *(const u32x4*)(HA + (size_t)row * D + 512 + F.lane * 8);
        const int ss[4] = {sq.x, sq.y, sq.z, sq.w};
#pragma unroll
        for (int k = 0; k < 4; ++k) { bf16_t* d = XG + (size_t)ss[k] * D; *(u32x4*)(d + F.lane * 8) = v0; *(u32x4*)(d + 512 + F.lane * 8) = v1; }
    }
}

__device__ __forceinline__ void ph_combine(const Frame& F, int l) {
    const Args& A = *F.a; float* X = (float*)(F.ws + WS_X); const bf16_t* Y = (const bf16_t*)(F.ws + WS_XG);
    const int* slot = (const int*)(F.ws + WS_SLOT); const float* gate = (const float*)(F.ws + WS_GATE);
    for (int row = F.blk * NWAVE + F.wave; row < NTOK; row += F.G * NWAVE) {
        const int b = row / SEQ;
        const int4 sq = *(const int4*)(slot + (size_t)row * 4); const f32x4 gq = *(const f32x4*)(gate + (size_t)row * 4);
        const int ss[4] = {sq.x, sq.y, sq.z, sq.w};
        float acc[16];
#pragma unroll
        for (int i = 0; i < 16; ++i) acc[i] = 0.f;
#pragma unroll
        for (int k = 0; k < 4; ++k) { const bf16_t* yr = Y + (size_t)ss[k] * D; const float gk = gq[k];
#pragma unroll
            for (int i = 0; i < 2; ++i) { const u32x4 w = *(const u32x4*)(yr + i * 512 + F.lane * 8);
                acc[i * 8 + 0] += gk * bflo(w.x); acc[i * 8 + 1] += gk * bfhi(w.x); acc[i * 8 + 2] += gk * bflo(w.y); acc[i * 8 + 3] += gk * bfhi(w.y);
                acc[i * 8 + 4] += gk * bflo(w.z); acc[i * 8 + 5] += gk * bfhi(w.z); acc[i * 8 + 6] += gk * bflo(w.w); acc[i * 8 + 7] += gk * bfhi(w.w); } }
        const float* g2 = modp(F, l, b, 5);
        float xv[16]; float ssq = 0.f;
#pragma unroll
        for (int i = 0; i < 2; ++i)
#pragma unroll
            for (int h = 0; h < 2; ++h) { const int c = i * 512 + F.lane * 8 + h * 4; const f32x4 x0 = *(const f32x4*)(X + (size_t)row * D + c), gg = *(const f32x4*)(g2 + c);
#pragma unroll
                for (int j = 0; j < 4; ++j) { const float x = x0[j] + gg[j] * acc[i * 8 + h * 4 + j]; xv[i * 8 + h * 4 + j] = x; ssq += x * x; } }
        ssq = wave_sum(ssq); const float rs = rsqrtf(ssq * (1.0f / D) + EPS);
        if (l == 0) {
            bf16_t* HB = (bf16_t*)(F.ws + WS_HB); bf16_t* HA = (bf16_t*)(F.ws + WS_HA);
            const float* kvg = A.in[I_KVG]; const float* g1 = A.in[I_N1G] + D; const float* sh = modp(F, 1, b, 0); const float* sc = modp(F, 1, b, 1);
#pragma unroll
            for (int i = 0; i < 2; ++i) { const int c = i * 512 + F.lane * 8; float o1[8], o2[8];
#pragma unroll
                for (int h = 0; h < 2; ++h) { const f32x4 kg = *(const f32x4*)(kvg + c + h * 4), gg = *(const f32x4*)(g1 + c + h * 4), s1 = *(const f32x4*)(sh + c + h * 4), s2 = *(const f32x4*)(sc + c + h * 4);
                    *(f32x4*)(X + (size_t)row * D + c + h * 4) = (f32x4){xv[i * 8 + h * 4], xv[i * 8 + h * 4 + 1], xv[i * 8 + h * 4 + 2], xv[i * 8 + h * 4 + 3]};
#pragma unroll
                    for (int j = 0; j < 4; ++j) { const float xh = xv[i * 8 + h * 4 + j] * rs; o1[h * 4 + j] = xh * kg[j]; o2[h * 4 + j] = xh * gg[j] * (s2[j] + 1.0f) + s1[j]; } }
                u32x4 w1, w2; w1.x = cvt_pk_bf16(o1[0], o1[1]); w1.y = cvt_pk_bf16(o1[2], o1[3]); w1.z = cvt_pk_bf16(o1[4], o1[5]); w1.w = cvt_pk_bf16(o1[6], o1[7]);
                w2.x = cvt_pk_bf16(o2[0], o2[1]); w2.y = cvt_pk_bf16(o2[2], o2[3]); w2.z = cvt_pk_bf16(o2[4], o2[5]); w2.w = cvt_pk_bf16(o2[6], o2[7]);
                *(u32x4*)(HB + (size_t)row * D + c) = w1; *(u32x4*)(HA + (size_t)row * D + c) = w2; }
        } else {
            const float* fg = A.in[I_FG];
#pragma unroll
            for (int i = 0; i < 2; ++i)
#pragma unroll
                for (int h = 0; h < 2; ++h) { const int c = i * 512 + F.lane * 8 + h * 4; const f32x4 gg = *(const f32x4*)(fg + c);
                    *(f32x4*)(A.out + (size_t)row * D + c) = (f32x4){xv[i * 8 + h * 4] * rs * gg[0], xv[i * 8 + h * 4 + 1] * rs * gg[1], xv[i * 8 + h * 4 + 2] * rs * gg[2], xv[i * 8 + h * 4 + 3] * rs * gg[3]}; }
        }
    }
}

__device__ __forceinline__ void ph_latpost(const Frame& F) {
    const Args& A = *F.a; const float* LAT = (const float*)(F.ws + WS_LAT); const float* CQP = (const float*)(F.ws + WS_CQP);
    bf16_t* CKV = (bf16_t*)(F.ws + WS_CKV); bf16_t* KR = (bf16_t*)(F.ws + WS_KR); bf16_t* CQ = (bf16_t*)(F.ws + WS_CQ); const f32x2* cs = (const f32x2*)(F.ws + WS_CS);
    for (int row = F.blk * NWAVE + F.wave; row < NTOK; row += F.G * NWAVE) {
        const float* lr = LAT + (size_t)row * 512;
        { const f32x4 v = *(const f32x4*)(lr + F.lane * 4), g = *(const f32x4*)(A.in[I_CKVG] + F.lane * 4);
          float s = wave_sum(v[0] * v[0] + v[1] * v[1] + v[2] * v[2] + v[3] * v[3]); const float rs = rsqrtf(s * (1.0f / KVLORA) + EPS);
          u32x2 w; w.x = cvt_pk_bf16(v[0] * rs * g[0], v[1] * rs * g[1]); w.y = cvt_pk_bf16(v[2] * rs * g[2], v[3] * rs * g[3]); *(u32x2*)(CKV + (size_t)row * KVLORA + F.lane * 4) = w; }
        if (F.lane < 32) { const int i = F.lane; const float x1 = lr[KVLORA + i], x2 = lr[KVLORA + 32 + i]; const f32x2 t = cs[(size_t)row * 32 + i];
          const float r1 = x1 * t[0] - x2 * t[1], r2 = x2 * t[0] + x1 * t[1]; const int p = (i >> 2) * 8 + (i & 3);
          KR[(size_t)row * DROPE + p] = (bf16_t)(cvt_pk_bf16(r1, r1) & 0xffffu); KR[(size_t)row * DROPE + p + 4] = (bf16_t)(cvt_pk_bf16(r2, r2) & 0xffffu); }
        { const float* qr = CQP + (size_t)row * 512; f32x2 v[3]; float s = 0.f;
#pragma unroll
          for (int i = 0; i < 3; ++i) { v[i] = *(const f32x2*)(qr + i * 128 + F.lane * 2); s += v[i][0] * v[i][0] + v[i][1] * v[i][1]; }
          s = wave_sum(s); const float rs = rsqrtf(s * (1.0f / QLORA) + EPS);
#pragma unroll
          for (int i = 0; i < 3; ++i) { const f32x2 g = *(const f32x2*)(A.in[I_CQG] + i * 128 + F.lane * 2);
              *(unsigned*)(CQ + (size_t)row * QLORA + i * 128 + F.lane * 2) = cvt_pk_bf16(v[i][0] * rs * g[0], v[i][1] * rs * g[1]); } }
    }
}
constexpr int AT_KN = 0, AT_KR = 16384, AT_VT = 24576, AT_STAGE = 40960;
#define AT_GLDS(src, dstoff) __builtin_amdgcn_global_load_lds((const unsigned*)(src), (LAS unsigned*)(F.lds + (dstoff)), 16, 0, 0)

__device__ __forceinline__ int swap23(int k) { return (k & ~0xC) | ((k & 4) << 1) | ((k & 8) >> 1); }

#if !NAIVE_ATTN
__device__ __forceinline__ void ph_attn(const Frame& F) {
    const char* Qg = (const char*)(F.ws + WS_Q); const char* KNg = (const char*)(F.ws + WS_KN); const char* KRg = (const char*)(F.ws + WS_KR); const char* VTg = (const char*)(F.ws + WS_VT);
    bf16_t* Og = (bf16_t*)(F.ws + WS_HC);
    const int lane = F.lane, w = F.wave, r32 = lane & 31, hi = lane >> 5;
    unsigned offKn[2], offVt[2], offKr;
#pragma unroll
    for (int i = 0; i < 2; ++i) { const int g = (i * 8 + w) * 64 + lane;
        { const int rho = g >> 4, ph = g & 15, c = ph ^ (rho & 15), key = swap23(rho); offKn[i] = (unsigned)key * 2048u + (unsigned)c * 16u; }
        { const int d = g >> 3, ph = g & 7, c = ph ^ ((d >> 1) & 7); offVt[i] = (unsigned)d * (unsigned)(NTOK * 2) + (unsigned)c * 16u; } }
    { const int g = w * 64 + lane, rho = g >> 3, ph = g & 7, c = ph ^ ((rho >> 1) & 7), key = swap23(rho); offKr = (unsigned)key * 128u + (unsigned)c * 16u; }
    const int knrd = r32 * 256, krrd = r32 * 128, sw16 = r32 & 15, sw8 = (r32 >> 1) & 7;
    for (int item = F.blk; item < 512; item += F.G) {
        const int xcd = item & 7, kk = item >> 3, bh = xcd * 4 + (kk >> 4), x = kk & 15, b = bh >> 3, h = bh & 7;
#pragma unroll 1
        for (int pass = 0; pass < 2; ++pass) {
            const int j = pass ? 31 - x : x, NT = 4 * j + 4, cw = 4 * j + (w >> 1);
            const size_t tokb = (size_t)b * SEQ;
            const char* knb = KNg + tokb * 2048 + h * 256; const char* krb = KRg + tokb * 128; const char* vtb = VTg + ((size_t)h * 128 * NTOK + tokb) * 2;
            bf16x8 qr[12];
            { const char* qp = Qg + (tokb + (size_t)j * 256 + w * 32 + r32) * (NH * DQK * 2) + h * (DQK * 2) + hi * 16;
#pragma unroll
              for (int d0 = 0; d0 < 12; ++d0) qr[d0] = *(const bf16x8*)(qp + d0 * 32);
              const float* csr = (const float*)(F.ws + WS_CS) + (tokb + (size_t)j * 256 + w * 32 + r32) * 64;
#pragma unroll
              for (int dd = 0; dd < 4; ++dd) { const int k4 = (dd * 2 + hi) * 4; const f32x4 t0 = *(const f32x4*)(csr + 2 * k4), t1 = *(const f32x4*)(csr + 2 * k4 + 4);
                  const u32x4 wq = *(const u32x4*)&qr[8 + dd];
                  const float x1[4] = {bflo(wq.x), bfhi(wq.x), bflo(wq.y), bfhi(wq.y)}, x2[4] = {bflo(wq.z), bfhi(wq.z), bflo(wq.w), bfhi(wq.w)};
                  const float co[4] = {t0[0], t0[2], t1[0], t1[2]}, si[4] = {t0[1], t0[3], t1[1], t1[3]}; float r1[4], r2[4];
#pragma unroll
                  for (int jj = 0; jj < 4; ++jj) { r1[jj] = x1[jj] * co[jj] - x2[jj] * si[jj]; r2[jj] = x2[jj] * co[jj] + x1[jj] * si[jj]; }
                  u32x4 wo = {cvt_pk_bf16(r1[0], r1[1]), cvt_pk_bf16(r1[2], r1[3]), cvt_pk_bf16(r2[0], r2[1]), cvt_pk_bf16(r2[2], r2[3])}; qr[8 + dd] = *(bf16x8*)&wo; } }
            f32x16 o[4];
#pragma unroll
            for (int d0 = 0; d0 < 4; ++d0)
#pragma unroll
                for (int r = 0; r < 16; ++r) o[d0][r] = 0.f;
            float m_run = -1e30f, l_run = 0.f;
#define AT_ISSUE(t, st) do { const int t_ = (t); \
                AT_GLDS(knb + (size_t)t_ * (64 * 2048) + offKn[0], (st) * AT_STAGE + AT_KN + w * 1024); AT_GLDS(knb + (size_t)t_ * (64 * 2048) + offKn[1], (st) * AT_STAGE + AT_KN + (8 + w) * 1024); \
                AT_GLDS(krb + (size_t)t_ * (64 * 128) + offKr, (st) * AT_STAGE + AT_KR + w * 1024); \
                AT_GLDS(vtb + (size_t)t_ * 128 + offVt[0], (st) * AT_STAGE + AT_VT + w * 1024); AT_GLDS(vtb + (size_t)t_ * 128 + offVt[1], (st) * AT_STAGE + AT_VT + (8 + w) * 1024); } while (0)
#define AT_COMPUTE(st) do { \
                const LAS char* kn = (const LAS char*)F.lds + (st) * AT_STAGE + AT_KN; const LAS char* kr = (const LAS char*)F.lds + (st) * AT_STAGE + AT_KR; const LAS char* vt = (const LAS char*)F.lds + (st) * AT_STAGE + AT_VT; \
                f32x16 p0, p1; _Pragma("unroll") for (int r = 0; r < 16; ++r) { p0[r] = 0.f; p1[r] = 0.f; } \
                _Pragma("unroll") for (int d0 = 0; d0 < 8; ++d0) { const int off = knrd + (((2 * d0 + hi) ^ sw16) << 4); \
                    const bf16x8 b0 = *(const LAS bf16x8*)(kn + off), b1 = *(const LAS bf16x8*)(kn + off + 8192); \
                    p0 = __builtin_amdgcn_mfma_f32_32x32x16_bf16(b0, qr[d0], p0, 0, 0, 0); p1 = __builtin_amdgcn_mfma_f32_32x32x16_bf16(b1, qr[d0], p1, 0, 0, 0); } \
                _Pragma("unroll") for (int d0 = 0; d0 < 4; ++d0) { const int off = krrd + (((2 * d0 + hi) ^ sw8) << 4); \
                    const bf16x8 b0 = *(const LAS bf16x8*)(kr + off), b1 = *(const LAS bf16x8*)(kr + off + 4096); \
                    p0 = __builtin_amdgcn_mfma_f32_32x32x16_bf16(b0, qr[8 + d0], p0, 0, 0, 0); p1 = __builtin_amdgcn_mfma_f32_32x32x16_bf16(b1, qr[8 + d0], p1, 0, 0, 0); } \
                float mx = p0[0]; _Pragma("unroll") for (int r = 1; r < 16; ++r) mx = fmaxf(mx, p0[r]); _Pragma("unroll") for (int r = 0; r < 16; ++r) mx = fmaxf(mx, p1[r]); \
                mx = fmaxf(mx, __shfl_xor(mx, 32)); \
                if (!__all(mx - m_run <= 11.0f)) { const float mn = fmaxf(m_run, mx), al = __builtin_amdgcn_exp2f(m_run - mn); m_run = mn; l_run *= al; \
                    _Pragma("unroll") for (int d0 = 0; d0 < 4; ++d0) _Pragma("unroll") for (int r = 0; r < 16; ++r) o[d0][r] *= al; } \
                float ps = 0.f; \
                _Pragma("unroll") for (int r = 0; r < 16; ++r) { p0[r] = __builtin_amdgcn_exp2f(p0[r] - m_run); p1[r] = __builtin_amdgcn_exp2f(p1[r] - m_run); ps += p0[r] + p1[r]; } \
                l_run += ps; \
                bf16x8 pa[4]; \
                { u32x4 t0 = {cvt_pk_bf16(p0[0], p0[1]), cvt_pk_bf16(p0[2], p0[3]), cvt_pk_bf16(p0[4], p0[5]), cvt_pk_bf16(p0[6], p0[7])}; pa[0] = *(bf16x8*)&t0; \
                  u32x4 t1 = {cvt_pk_bf16(p0[8], p0[9]), cvt_pk_bf16(p0[10], p0[11]), cvt_pk_bf16(p0[12], p0[13]), cvt_pk_bf16(p0[14], p0[15])}; pa[1] = *(bf16x8*)&t1; \
                  u32x4 t2 = {cvt_pk_bf16(p1[0], p1[1]), cvt_pk_bf16(p1[2], p1[3]), cvt_pk_bf16(p1[4], p1[5]), cvt_pk_bf16(p1[6], p1[7])}; pa[2] = *(bf16x8*)&t2; \
                  u32x4 t3 = {cvt_pk_bf16(p1[8], p1[9]), cvt_pk_bf16(p1[10], p1[11]), cvt_pk_bf16(p1[12], p1[13]), cvt_pk_bf16(p1[14], p1[15])}; pa[3] = *(bf16x8*)&t3; } \
                _Pragma("unroll") for (int d0 = 0; d0 < 4; ++d0) _Pragma("unroll") for (int s = 0; s < 4; ++s) { \
                    const bf16x8 a = *(const LAS bf16x8*)(vt + (d0 * 32 + r32) * 128 + (((2 * s + hi) ^ sw8) << 4)); \
                    o[d0] = __builtin_amdgcn_mfma_f32_32x32x16_bf16(a, pa[s], o[d0], 0, 0, 0); } } while (0)
            AT_ISSUE(0, 0);
            asm volatile("s_waitcnt vmcnt(0)" ::: "memory"); __syncthreads();
#pragma unroll 1
            for (int t = 0; t < NT; t += 2) {
                AT_ISSUE(t + 1, 1);
                if (t <= cw) AT_COMPUTE(0);
                asm volatile("s_waitcnt vmcnt(0)" ::: "memory"); __syncthreads();
                if (t + 2 < NT) AT_ISSUE(t + 2, 0);
                if (t + 1 <= cw) AT_COMPUTE(1);
                asm volatile("s_waitcnt vmcnt(0)" ::: "memory"); __syncthreads();
            }
#undef AT_ISSUE
#undef AT_COMPUTE
            const float lt = l_run + __shfl_xor(l_run, 32), inv = 1.0f / lt;
            bf16_t* op = Og + (tokb + (size_t)j * 256 + w * 32 + r32) * D + h * DV + 4 * hi;
#pragma unroll
            for (int d0 = 0; d0 < 4; ++d0)
#pragma unroll
                for (int g4 = 0; g4 < 4; ++g4) { u32x2 wv; wv.x = cvt_pk_bf16(o[d0][4 * g4] * inv, o[d0][4 * g4 + 1] * inv); wv.y = cvt_pk_bf16(o[d0][4 * g4 + 2] * inv, o[d0][4 * g4 + 3] * inv);
                    *(u32x2*)(op + d0 * 32 + 8 * g4) = wv; }
        }
    }
}
#else
__device__ __forceinline__ void ph_attn(const Frame& F) {
    const bf16_t* Qg = (const bf16_t*)(F.ws + WS_Q); const bf16_t* KNg = (const bf16_t*)(F.ws + WS_KN); const bf16_t* KRg = (const bf16_t*)(F.ws + WS_KR); const bf16_t* VTg = (const bf16_t*)(F.ws + WS_VT);
    bf16_t* Og = (bf16_t*)(F.ws + WS_HC);
    for (int it = F.blk * NWAVE + F.wave; it < NTOK * NH; it += F.G * NWAVE) {
        const int n = it >> 3, h = it & 7, b = n / SEQ, s = n - b * SEQ, nkb = s / 64 + 1; const size_t tokb = (size_t)b * SEQ;
        const bf16_t* q = Qg + (size_t)n * (NH * DQK) + h * DQK;
        float m = -1e30f, l = 0.f, o0 = 0.f, o1 = 0.f;
        for (int kb = 0; kb < nkb; ++kb) {
            const size_t key = tokb + kb * 64 + F.lane; float sc = 0.f;
            for (int d = 0; d < DNOPE; d += 8) { const u32x4 kv = *(const u32x4*)(KNg + key * D + h * DNOPE + d), qv = *(const u32x4*)(q + d);
                sc += bflo(kv.x) * bflo(qv.x) + bfhi(kv.x) * bfhi(qv.x) + bflo(kv.y) * bflo(qv.y) + bfhi(kv.y) * bfhi(qv.y) + bflo(kv.z) * bflo(qv.z) + bfhi(kv.z) * bfhi(qv.z) + bflo(kv.w) * bflo(qv.w) + bfhi(kv.w) * bfhi(qv.w); }
            for (int d = 0; d < DROPE; d += 8) { const u32x4 kv = *(const u32x4*)(KRg + key * DROPE + d), qv = *(const u32x4*)(q + DNOPE + d);
                sc += bflo(kv.x) * bflo(qv.x) + bfhi(kv.x) * bfhi(qv.x) + bflo(kv.y) * bflo(qv.y) + bfhi(kv.y) * bfhi(qv.y) + bflo(kv.z) * bflo(qv.z) + bfhi(kv.z) * bfhi(qv.z) + bflo(kv.w) * bflo(qv.w) + bfhi(kv.w) * bfhi(qv.w); }
            float mx = sc;
#pragma unroll
            for (int of = 32; of >= 1; of >>= 1) mx = fmaxf(mx, __shfl_xor(mx, of));
            const float mn = fmaxf(m, mx), al = exp2f(m - mn), p = exp2f(sc - mn); m = mn;
            l = l * al + wave_sum(p); o0 *= al; o1 *= al;
            for (int d = 0; d < DV; ++d) { const float v = bf2f(VTg[(size_t)(h * DV + d) * NTOK + key]); const float tot = wave_sum(p * v);
                if (F.lane == (d & 63)) { if (d < 64) o0 += tot; else o1 += tot; } }
        }
        const float inv = 1.0f / l;
        Og[(size_t)n * D + h * DV + F.lane] = (bf16_t)(cvt_pk_bf16(o0 * inv, 0.f) & 0xffffu);
        Og[(size_t)n * D + h * DV + 64 + F.lane] = (bf16_t)(cvt_pk_bf16(o1 * inv, 0.f) & 0xffffu);
    }
}
#endif
constexpr int NPH = 20;
__global__ void __launch_bounds__(NTHR, 2) yoco_fwd(Args args) {
    extern __shared__ __attribute__((aligned(16))) unsigned char lds_raw[];
    Frame F; F.lds = (LAS unsigned char*)lds_raw; F.ws = args.ws; F.a = &args;
    F.tid = threadIdx.x; F.lane = F.tid & 63; F.wave = __builtin_amdgcn_readfirstlane(F.tid >> 6); F.G = gridDim.x; F.blk = blockIdx.x;
    volatile LAS unsigned* misc = (volatile LAS unsigned*)(F.lds + LDS_MISC);
    if (F.tid < 16) misc[F.tid] = 0u;
    __syncthreads();
    const int lo = args.ph_lo, hi = args.ph_hi;
    XcdBarrier bar; bar.bar = (unsigned*)(F.ws + WS_CTL); bar.x = 0; bar.st = misc;
    if (hi - lo > 1) bar = xcd_barrier_post((unsigned*)(F.ws + WS_CTL), misc);
#ifndef PH_MASK
#define PH_MASK 0xFFFFFu
#endif
#define IN(k) (((PH_MASK >> ((k) % 20 >= 15 ? (k) - 10 : (k))) & 1u) && lo <= (k) && (k) < hi)
#define FRESH() do { F.tid = threadIdx.x; asm volatile("" : "+v"(F.tid)); F.lane = F.tid & 63; F.wave = __builtin_amdgcn_readfirstlane(F.tid >> 6); F.ws = args.ws; asm volatile("" : "+s"(F.ws)); } while (0)
#define SEAM(k) do { if (IN(k) && IN((k) + 1)) xcd_barrier(bar); } while (0)
    LAS unsigned char* stage = F.lds;
#define MOD ((const float*)(F.ws + WS_MOD))

    if (IN(0)) { FRESH(); ph_prologue(F); } SEAM(0);
    if (IN(1)) { FRESH(); ph_norm1(F); } SEAM(1);
    if (IN(2)) { FRESH();
        pg8::Gemm g{(const bf16_t*)(F.ws + WS_HA), (const bf16_t*)(F.ws + WS_WPW1), NTOK, 2 * D, D}; pg8::StaticOrder S; S.init(NTOK, 2 * D, F.G, F.blk);
        pg8::EpiGated<0> E{(bf16_t*)(F.ws + WS_HB), D, args.in[I_PW1B], D, nullptr};
        GEMM_PHASE<pg8::EpiGated<0>, pg8::StaticOrder>(stage, g, S, E);
    } SEAM(2);
    if (IN(3)) { FRESH(); ph_conv(F); } SEAM(3);
    if (IN(4)) { FRESH();
        pg8::Gemm g{(const bf16_t*)(F.ws + WS_HC), (const bf16_t*)(F.ws + WS_WPW2), NTOK, D, D}; pg8::StaticOrder S; S.init(NTOK, D, F.G, F.blk);
        pg8::EpiResid E{args.in[I_X], (float*)(F.ws + WS_X), args.in[I_PW2B], MOD + 2 * D};
        GEMM_PHASE<pg8::EpiResid, pg8::StaticOrder>(stage, g, S, E);
    } SEAM(4);
#pragma unroll 1
    for (int l = 0; l < 2; ++l) {
        const int pb = 5 + 10 * l;
        if (IN(pb)) { FRESH(); ph_router(F, l); } SEAM(pb);
        if (IN(pb + 1)) { FRESH(); ph_scatter(F, l); } SEAM(pb + 1);
        const int* bexp = (const int*)(F.ws + WS_BEXP) + l * 1024;
        if (IN(pb + 2)) { FRESH();
            const int nblk = __builtin_amdgcn_readfirstlane(bexp[0]);
            pg8::Gemm g{(const bf16_t*)(F.ws + WS_XG), (const bf16_t*)(F.ws + WS_WGU) + (size_t)l * NE * 2 * DE * D, nblk * 256, 2 * DE, D};
            pg8::MoeOrder S; S.init(nblk * 256, 2 * DE, F.G, F.blk); S.bexp = bexp; S.estride = (size_t)2 * DE * D * 2;
            pg8::EpiGated<1> E{(bf16_t*)(F.ws + WS_ACT), DE, args.in[I_BGU] + (size_t)l * NE * 2 * DE, DE, bexp};
            GEMM_PHASE<pg8::EpiGated<1>, pg8::MoeOrder>(stage, g, S, E);
        } SEAM(pb + 2);
        if (IN(pb + 3)) { FRESH();
            const int nblk = __builtin_amdgcn_readfirstlane(bexp[0]);
            pg8::Gemm g{(const bf16_t*)(F.ws + WS_ACT), (const bf16_t*)(F.ws + WS_WDN) + (size_t)l * NE * DE * D, nblk * 256, D, DE};
            pg8::MoeOrder S; S.init(nblk * 256, D, F.G, F.blk); S.bexp = bexp; S.estride = (size_t)DE * D * 2;
            pg8::EpiBf16P E{(bf16_t*)(F.ws + WS_XG), D, args.in[I_BDN] + (size_t)l * NE * D, D, bexp};
            GEMM_PHASE<pg8::EpiBf16P, pg8::MoeOrder>(stage, g, S, E);
        } SEAM(pb + 3);
        if (IN(pb + 4)) { FRESH(); ph_combine(F, l); } SEAM(pb + 4);
        if (l == 0) {
            if (IN(10)) { FRESH();
#pragma unroll 1
                for (int gi = 0; gi < 2; ++gi) {
                    pg8::Gemm g{(const bf16_t*)(F.ws + (gi ? WS_HA : WS_HB)), (const bf16_t*)(F.ws + (gi ? WS_WDQ : WS_WDKV)), NTOK, 512, D}; pg8::StaticOrder S; S.init(NTOK, 512, F.G, F.blk);
                    pg8::EpiF32P E{(float*)(F.ws + (gi ? WS_CQP : WS_LAT)), 512}; GEMM_PHASE<pg8::EpiF32P, pg8::StaticOrder>(stage, g, S, E);
                    __syncthreads(); }
            } SEAM(10);
            if (IN(11)) { FRESH(); ph_latpost(F); } SEAM(11);
            if (IN(12)) { FRESH();
#pragma unroll 1
                for (int gi = 0; gi < 3; ++gi) {
                    pg8::Gemm g{(const bf16_t*)(F.ws + (gi == 0 ? WS_CKV : gi == 1 ? WS_WUV : WS_CQ)), (const bf16_t*)(F.ws + (gi == 0 ? WS_WUK : gi == 1 ? WS_CKV : WS_WUQ)),
                                gi == 1 ? D : NTOK, gi == 0 ? D : gi == 1 ? NTOK : NH * DQK, gi == 2 ? QLORA : KVLORA};
                    pg8::StaticOrder S; S.init(g.M, g.N, F.G, F.blk);
                    pg8::EpiBf16P E{(bf16_t*)(F.ws + (gi == 0 ? WS_KN : gi == 1 ? WS_VT : WS_Q)), g.N, nullptr, 0, nullptr}; GEMM_PHASE<pg8::EpiBf16P, pg8::StaticOrder>(stage, g, S, E);
                    __syncthreads(); }
            } SEAM(12);
            if (IN(13)) { FRESH(); ph_attn(F); } SEAM(13);
            if (IN(14)) { FRESH();
                pg8::Gemm g{(const bf16_t*)(F.ws + WS_HC), (const bf16_t*)(F.ws + WS_WO), NTOK, D, D}; pg8::StaticOrder S; S.init(NTOK, D, F.G, F.blk);
                pg8::EpiResid E{(const float*)(F.ws + WS_X), (float*)(F.ws + WS_X), nullptr, MOD + (size_t)NB * 6 * D + 2 * D};
                GEMM_PHASE<pg8::EpiResid, pg8::StaticOrder>(stage, g, S, E);
            } SEAM(14);
        }
    }
#undef IN
#undef SEAM
#undef MOD
#undef FRESH
}

extern "C" void kernel_launch(void* const* d_in, const int* in_sizes, int n_in, void* d_out, int out_size, void* d_ws, size_t ws_size, hipStream_t stream) {
    static int grid = 0;
    if (grid == 0) {
        if (n_in != 31 || out_size != NTOK * D || ws_size < WS_END) { fprintf(stderr, "kernel_launch: unexpected shapes (n_in %d, out %d, ws %zu < %zu)\n", n_in, out_size, ws_size, (size_t)WS_END); grid = -1; return; }
        int dev = 0, cus = 0, per_cu = 0;
        if (hipGetDevice(&dev) != hipSuccess || hipDeviceGetAttribute(&cus, hipDeviceAttributeMultiprocessorCount, dev) != hipSuccess) { grid = -1; return; }
        if (hipFuncSetAttribute((const void*)yoco_fwd, hipFuncAttributeMaxDynamicSharedMemorySize, LDS_BYTES) != hipSuccess) { fprintf(stderr, "kernel_launch: hipFuncSetAttribute failed\n"); grid = -1; return; }
        if (hipOccupancyMaxActiveBlocksPerMultiprocessor(&per_cu, (const void*)yoco_fwd, NTHR, LDS_BYTES) != hipSuccess || per_cu < 1) fprintf(stderr, "kernel_launch: occupancy query says %d\n", per_cu);
        (void)hipGetLastError();
        grid = cus;
        if (grid != 256) fprintf(stderr, "kernel_launch: %d CUs (built for 256)\n", grid);
        if (grid > 256) grid = 256;
    }
    if (grid < 0) return;
    (void)hipMemsetAsync((char*)d_ws + WS_CTL, 0, XCD_BAR_WORDS * sizeof(unsigned), stream);
    Args a{};
    for (int i = 0; i < 31; ++i) a.in[i] = (const float*)d_in[i];
    a.out = (float*)d_out; a.ws = (unsigned char*)d_ws;
#if N_LAUNCH_MODE == 1
    a.ph_lo = 0; a.ph_hi = NPH;
    hipLaunchKernelGGL(yoco_fwd, dim3(grid), dim3(NTHR), LDS_BYTES, stream, a);
#else
    for (int p = 0; p < NPH; ++p) { a.ph_lo = p; a.ph_hi = p + 1; hipLaunchKernelGGL(yoco_fwd, dim3(grid), dim3(NTHR), LDS_BYTES, stream, a); }
#endif
}
```

```cpp
#include <hip/hip_runtime.h>
#include <cstdio>
#include <cstdint>

#ifndef N_LAUNCH_MODE
#define N_LAUNCH_MODE 1
#endif
#ifndef NAIVE_GEMM
#define NAIVE_GEMM 0
#endif
#ifndef NAIVE_ATTN
#define NAIVE_ATTN 0
#endif

#define LAS __attribute__((address_space(3)))
#define GAS __attribute__((address_space(1)))
__device__ __forceinline__ const void* assume_global_(const void* p) {
#if defined(__HIP_DEVICE_COMPILE__)
    __builtin_assume(!__builtin_amdgcn_is_shared(p) && !__builtin_amdgcn_is_private(p));
#endif
    return p; }
#define GPTR(T, p) ((T*)assume_global_((const void*)(p)))
typedef unsigned short bf16_t;
typedef short bf16x8 __attribute__((ext_vector_type(8)));
typedef float f32x4 __attribute__((ext_vector_type(4)));
typedef float f32x2 __attribute__((ext_vector_type(2)));
typedef float f32x16 __attribute__((ext_vector_type(16)));
typedef unsigned u32x4 __attribute__((ext_vector_type(4)));
typedef unsigned u32x2 __attribute__((ext_vector_type(2)));

constexpr int D = 1024, NB = 4, SEQ = 8192, NTOK = NB * SEQ;
constexpr int CONVW = 31, NH = 8, DNOPE = 128, DROPE = 64, DQK = 192, DV = 128, QLORA = 384, KVLORA = 256;
constexpr int NE = 32, TOPK = 4, DE = 1024, EBLK = 256;
constexpr int NASSIGN = NTOK * TOPK;
constexpr int NROWS = ((NASSIGN + NE * (EBLK - 1) + EBLK - 1) / EBLK) * EBLK;
constexpr int MAXBLK = NROWS / EBLK;
constexpr float EPS = 1e-6f;
constexpr int NTHR = 512, NWAVE = 8;
constexpr int LDS_BYTES = 163840;
constexpr int LDS_MISC = 163328;

constexpr size_t MiB = (size_t)1 << 20;
constexpr size_t WS_CTL = 0;
constexpr size_t WS_BLKCNT = 64 * 1024;
constexpr size_t WS_BEXP = 192 * 1024;
constexpr size_t WS_MOD = 1 * MiB;
constexpr size_t WS_TOPI = 2 * MiB;
constexpr size_t WS_GATE = WS_TOPI + 512 * 1024;
constexpr size_t WS_RANK = WS_GATE + 512 * 1024;
constexpr size_t WS_SLOT = WS_RANK + 512 * 1024;
constexpr size_t WS_CS = 4 * MiB;
constexpr size_t WS_RWF = 12 * MiB;
constexpr size_t WS_RBIAS = 13 * MiB;
constexpr size_t WS_WPW1 = 16 * MiB;
constexpr size_t WS_WPW2 = WS_WPW1 + 4 * MiB;
constexpr size_t WS_WDKV = WS_WPW2 + 2 * MiB;
constexpr size_t WS_WDQ = WS_WDKV + 1 * MiB;
constexpr size_t WS_WUK = WS_WDQ + 1 * MiB;
constexpr size_t WS_WUV = WS_WUK + MiB / 2;
constexpr size_t WS_WUQ = WS_WUV + MiB / 2;
constexpr size_t WS_WO = WS_WUQ + 2 * MiB;
constexpr size_t WS_WGU = 32 * MiB;
constexpr size_t WS_WDN = WS_WGU + 256 * MiB;
constexpr size_t WS_X = WS_WDN + 128 * MiB;
constexpr size_t WS_HA = WS_X + 128 * MiB;
constexpr size_t WS_HB = WS_HA + 64 * MiB;
constexpr size_t WS_HC = WS_HB + 64 * MiB;
constexpr size_t WS_XG = WS_HC + 64 * MiB;
constexpr size_t WS_ACT = WS_XG + 272 * MiB;
constexpr size_t WS_ROWTAB = WS_ACT + 272 * MiB;
constexpr size_t WS_X2 = WS_ROWTAB + 8 * MiB;
constexpr size_t WS_END = WS_X2 + 128 * MiB;
constexpr size_t WS_LAT = WS_XG;
constexpr size_t WS_SSPKV = WS_XG;
constexpr size_t WS_SSPQ = WS_XG + 2 * MiB;
constexpr size_t WS_CQP = WS_LAT + 64 * MiB;
constexpr size_t WS_CKV = WS_CQP + 64 * MiB;
constexpr size_t WS_KR = WS_CKV + 16 * MiB;
constexpr size_t WS_CQ = WS_KR + 4 * MiB;
constexpr size_t WS_KN = WS_CQ + 28 * MiB;
constexpr size_t WS_VT = WS_KN + 64 * MiB;
constexpr size_t WS_Q = WS_VT + 64 * MiB;
static_assert(WS_Q + 96 * MiB <= WS_END, "ws map");

struct Args {
    const float* in[31]; float* out; unsigned char* ws; int ph_lo, ph_hi;
};
enum { I_X = 0, I_C, I_POS, I_MODW, I_MODB, I_N1G, I_N2G, I_PW1W, I_PW1B, I_DWW, I_DWB, I_LNG, I_LNB, I_PW2W, I_PW2B, I_KVG, I_WDKV, I_CKVG, I_WUK, I_WUV,
       I_WDQ, I_CQG, I_WUQ, I_WO, I_RW, I_RB, I_WGU, I_BGU, I_WDN, I_BDN, I_FG };

__device__ __forceinline__ unsigned cvt_pk_bf16(float lo, float hi) { unsigned r; asm volatile("v_cvt_pk_bf16_f32 %0, %1, %2" : "=v"(r) : "v"(lo), "v"(hi)); return r; }
__device__ __forceinline__ float bf2f(unsigned short b) { return __uint_as_float(((unsigned)b) << 16); }
__device__ __forceinline__ float bflo(unsigned w) { return __uint_as_float(w << 16); }
__device__ __forceinline__ float bfhi(unsigned w) { return __uint_as_float(w & 0xffff0000u); }
__device__ __forceinline__ float wave_sum(float v) {
#pragma unroll
    for (int o = 32; o >= 1; o >>= 1) v += __shfl_xor(v, o);
    return v;
}
__device__ __forceinline__ float sigmoidf_(float x) { return __builtin_amdgcn_rcpf(1.0f + __builtin_amdgcn_exp2f(-1.4426950408889634f * x)); }
#define XB_TMO      128
#define XB_XCNT(j)  (256  + 64 * (j))
#define XB_XSUB(j)  (1280 + 64 * (j))
#define XB_XGEN(j)  (2304 + 64 * (j))
#define XB_TOP      3328
#define XB_TOPGEN   3392
#define XCD_BAR_WORDS 3456
#define XB_SPIN_CAP (1u << 18)

__device__ __forceinline__ unsigned xb_ld(unsigned* p)              { return __hip_atomic_load(p, __ATOMIC_RELAXED, __HIP_MEMORY_SCOPE_AGENT); }
__device__ __forceinline__ unsigned xb_add(unsigned* p, unsigned v) { return __hip_atomic_fetch_add(p, v, __ATOMIC_RELAXED, __HIP_MEMORY_SCOPE_AGENT); }
__device__ __forceinline__ unsigned xb_xcc_id() { return (unsigned)__builtin_amdgcn_s_getreg((3 << 11) | 20) & 0xFu; }
#define XB_SPIN(cond, bar) do { unsigned _sp = 0; while (cond) { __builtin_amdgcn_s_sleep(1); \
    if ((++_sp & 255u) == 0u) { if (xb_ld(&(bar)[XB_TMO])) break; if (_sp > XB_SPIN_CAP) { atomicAdd(&(bar)[XB_TMO], 1u); break; } } } } while (0)

struct XcdBarrier {
    unsigned* bar; unsigned x;
    volatile LAS unsigned* st;
};

__device__ __forceinline__ XcdBarrier xcd_barrier_post(unsigned* bar, volatile LAS unsigned* st) {
    XcdBarrier b; b.bar = bar; b.x = xb_xcc_id(); b.st = st;
    if (threadIdx.x == 0) (void)xb_add(&bar[XB_XCNT(b.x)], 1u);
    return b;
}
__device__ __forceinline__ void xcd_barrier_complete(unsigned* bar, unsigned x, unsigned& nloc, unsigned& nx) {
    const unsigned G = gridDim.x * gridDim.y * gridDim.z;
    unsigned sum, cnt, mine, sp = 0u;
    for (;;) {
        sum = 0u; cnt = 0u; mine = 0u;
#pragma unroll
        for (unsigned j = 0; j < 16; ++j) { const unsigned c = xb_ld(&bar[XB_XCNT(j)]); sum += c; cnt += (c > 0u) ? 1u : 0u; mine = (j == x) ? c : mine; }
        if (sum == G) break;
        __builtin_amdgcn_s_sleep(1);
        if ((++sp & 255u) == 0u) { if (xb_ld(&bar[XB_TMO])) break; if (sp > XB_SPIN_CAP) { atomicAdd(&bar[XB_TMO], 1u); break; } }
    }
    nloc = mine > 0u ? mine : 1u; nx = cnt > 0u ? cnt : 1u;
}

__device__ __forceinline__ void xcd_barrier(const XcdBarrier& b) {
    asm volatile("s_waitcnt vmcnt(0)" ::: "memory");
    __syncthreads();
    if (threadIdx.x == 0) {
        unsigned* bar = b.bar;
        __builtin_amdgcn_s_waitcnt(0);
        unsigned nloc = b.st[0], nx = b.st[1];
        if (nloc == 0u) { xcd_barrier_complete(bar, b.x, nloc, nx); b.st[0] = nloc; b.st[1] = nx; }
        const unsigned old = xb_add(&bar[XB_XSUB(b.x)], 1u);
        const unsigned gen = old / nloc;
        if (old + 1u == (gen + 1u) * nloc) {
            __builtin_amdgcn_fence(__ATOMIC_RELEASE, "agent");
            asm volatile("s_waitcnt vmcnt(0)" ::: "memory");
            const unsigned og = xb_add(&bar[XB_TOP], 1u);
            const unsigned tg = og / nx;
            if (og + 1u == (tg + 1u) * nx) xb_add(&bar[XB_TOPGEN], 1u);
            else XB_SPIN(xb_ld(&bar[XB_TOPGEN]) == tg, bar);
            __builtin_amdgcn_fence(__ATOMIC_ACQUIRE, "agent");
            xb_add(&bar[XB_XGEN(b.x)], 1u);
            asm volatile("s_waitcnt vmcnt(0)" ::: "memory");
        } else {
            XB_SPIN(xb_ld(&bar[XB_XGEN(b.x)]) == gen, bar);
            __builtin_amdgcn_fence(__ATOMIC_ACQUIRE, "agent");
            asm volatile("s_waitcnt vmcnt(0)" ::: "memory");
        }
    }
    __syncthreads();
}
namespace pg8 {
#define PG8_LAS __attribute__((address_space(3)))
constexpr int BM = 256, BK = 64, HALF = 128, HTB = HALF * BK * 2  , STAGE_BYTES = 8 * HTB, NXCD = 8, WGM = 8;

__host__ __device__ __forceinline__ int lds_byte(int r, int c) { const int st = (r >> 4) * 2 + (c >> 5), rr = r & 15, cc = c & 31, ob = rr * 64 + cc * 2; return st * 1024 + (ob ^ (((ob >> 9) & 1) << 5)); }
__host__ __device__ __forceinline__ void stage_rc(int b, int& R, int& C) { const int st = b / 1024, sb = b % 1024, swz = sb ^ (((sb >> 9) & 1) << 5); R = (st >> 1) * 16 + swz / 64; C = (st & 1) * 32 + (swz % 64) / 2; }
__host__ __device__ __forceinline__ int perm32(int rho) { const int n = rho >> 4, i = rho & 15; return 8 * (i >> 2) + 4 * n + (i & 3); }

struct Unit { int pm, pn; };
struct Gemm { const bf16_t* A; const bf16_t* Bt; int M, N, K; };

struct StaticOrder {
    static constexpr bool GATHER = false;
    int nM, nN, nwg, G, c;
    __host__ __device__ void init(int M, int N, int G_, int c_) { nM = M / BM; nN = N / BM; nwg = nM * nN; G = G_; c = c_; }
    __host__ __device__ bool next(int i, Unit& u) const {
        const long L = (long)i * G + c; if (L >= nwg) return false;
        int wgid = (int)L; { const int q = nwg / NXCD, r = nwg % NXCD, xcd = wgid % NXCD, off = wgid / NXCD; wgid = (xcd < r ? xcd * (q + 1) : r * (q + 1) + (xcd - r) * q) + off; }
        const int nig = WGM * nN, gid = wgid / nig, fm = gid * WGM, gsz = (nM - fm) < WGM ? (nM - fm) : WGM;
        u.pm = fm + ((wgid % nig) % gsz); u.pn = (wgid % nig) / gsz; return true;
    }
    __device__ __forceinline__ void a_ready(const Unit&) const {}
    __device__ __forceinline__ size_t boff(const Unit& u, size_t tstep) const { return (size_t)u.pn * tstep; }
    __device__ __forceinline__ void done(const Unit&) const {}
};
template <class Epi, class Sched>
__device__ __forceinline__ void gemm_phase(PG8_LAS unsigned char* lds, const Gemm g, const Sched& S, const Epi& E) {
    constexpr bool STAMP = false; unsigned long long* stamps = nullptr;
    int tid_ = threadIdx.x; asm volatile("" : "+v"(tid_));
    const int tid = tid_, wid = __builtin_amdgcn_readfirstlane(tid >> 6), lane = tid & 63, wr = wid >> 2, wc = wid & 3, fr = lane & 15, fq = lane >> 4;
    const int K = g.K, nt = K / BK;
    int ts_lo = 0, ts_hi = 0, nts = 0; const unsigned long long rt_entry = STAMP ? (unsigned long long)wall_clock64() : 0ull;
#define PG8_STAMP() do { if (STAMP && wid == 0 && nts < 64) { const unsigned long long _c = (unsigned long long)clock64(); \
        ts_lo = (lane == nts) ? (int)(unsigned)_c : ts_lo; ts_hi = (lane == nts) ? (int)(unsigned)(_c >> 32) : ts_hi; ++nts; } } while (0)
    PG8_STAMP();
    unsigned voffA[2], voffB[2];
#pragma unroll
    for (int i = 0; i < 2; ++i) { int R, C; stage_rc(tid * 16 + i * 8192, R, C); const int Rb = Epi::PERM ? ((R & ~31) + perm32(R & 31)) : R;
        voffA[i] = (unsigned)(R * K + C) * 2u; voffB[i] = (unsigned)(Rb * K + C) * 2u; }
    unsigned gc[2][2], gn[2][2], gnn[2][2];
#define PG8_LOOKUP_LD(t4_, u) t4_ = *(const u32x4*)(S.rowtab + ((size_t)(u).pm * 512 + tid) * 4)
#define PG8_LOOKUP_FIN(dst, t4_) do { const unsigned tk_[4] = {t4_.x, t4_.y, t4_.z, t4_.w}; \
        _Pragma("unroll") for (int h_ = 0; h_ < 2; ++h_) _Pragma("unroll") for (int i_ = 0; i_ < 2; ++i_) { int R_, C_; stage_rc(tid * 16 + i_ * 8192, R_, C_); \
        const unsigned tc_ = tk_[h_ * 2 + i_] < S.nrows_src ? tk_[h_ * 2 + i_] : S.nrows_src - 1u; dst[h_][i_] = (tc_ * (unsigned)K + (unsigned)C_) * 2u; } } while (0)
#define PG8_LOOKUP(dst, u) do { u32x4 t4x_; PG8_LOOKUP_LD(t4x_, u); PG8_LOOKUP_FIN(dst, t4x_); } while (0)
#define PG8_STAGE_G(bufoff, kbytes, off2) do { _Pragma("unroll") for (int _i = 0; _i < 2; ++_i) \
        __builtin_amdgcn_global_load_lds((const unsigned*)((const char*)g.A + (kbytes) + (off2)[_i]), (PG8_LAS unsigned*)(lds + (bufoff) + ldsw + _i * 8192), 16, 0, 0); } while (0)
    const size_t kstep = (size_t)(BK * 2);
    const size_t hstep = (size_t)HALF * K * 2;
    const size_t tstep = 2 * hstep;
    const unsigned ldsw = (unsigned)wid * 1024u;
    const int aoff = lds_byte(wr * 64 + fr, fq * 8), boff = lds_byte(wc * 32 + fr, fq * 8);
#define PG8_SA(b, h) (((b) * 2 + (h)) * HTB)
#define PG8_SB(b, h) ((4 + (b) * 2 + (h)) * HTB)
#define PG8_STAGE(bufoff, gbase, voff) do { _Pragma("unroll") for (int _i = 0; _i < 2; ++_i) \
        __builtin_amdgcn_global_load_lds((const unsigned*)((const char*)(gbase) + (voff)[_i]), (PG8_LAS unsigned*)(lds + (bufoff) + ldsw + _i * 8192), 16, 0, 0); } while (0)
#define PG8_LDA(dst, b, h) do { _Pragma("unroll") for (int m = 0; m < 4; ++m) _Pragma("unroll") for (int k = 0; k < 2; ++k) dst[m][k] = *(const PG8_LAS bf16x8*)(lds + PG8_SA(b, h) + aoff + m * 2048 + k * 1024); } while (0)
#define PG8_LDB(dst, b, h) do { _Pragma("unroll") for (int n = 0; n < 2; ++n) _Pragma("unroll") for (int k = 0; k < 2; ++k) dst[n][k] = *(const PG8_LAS bf16x8*)(lds + PG8_SB(b, h) + boff + n * 2048 + k * 1024); } while (0)
#define PG8_MMA(ai, bj, At, Bt) do { __builtin_amdgcn_s_setprio(1); _Pragma("unroll") for (int m = 0; m < 4; ++m) _Pragma("unroll") for (int n = 0; n < 2; ++n) _Pragma("unroll") for (int k = 0; k < 2; ++k) \
        acc[ai][bj][m][n] = __builtin_amdgcn_mfma_f32_16x16x32_bf16(Bt[n][k], At[m][k], acc[ai][bj][m][n], 0, 0, 0); __builtin_amdgcn_s_setprio(0); } while (0)
#define PG8_WAIT_V(n) asm volatile("s_waitcnt vmcnt(" #n ")" ::: "memory")
#define PG8_WAIT_L(n) asm volatile("s_waitcnt lgkmcnt(" #n ")" ::: "memory")
#define PG8_BAR __builtin_amdgcn_s_barrier()
#define PG8_SCHED __builtin_amdgcn_sched_barrier(0)
    Unit cur, nxt; int ui = 0;
    if (!S.next(0, cur)) return;
    f32x4 acc[2][2][4][2];
#pragma unroll
    for (int a = 0; a < 2; ++a)
#pragma unroll
        for (int b = 0; b < 2; ++b)
#pragma unroll
            for (int m = 0; m < 4; ++m)
#pragma unroll
                for (int n = 0; n < 2; ++n) acc[a][b][m][n] = (f32x4){0.f, 0.f, 0.f, 0.f};
    bf16x8 At[4][2], B0[2][2], B1[2][2];
    const char* cA = (const char*)g.A + (size_t)cur.pm * tstep; const char* cB = (const char*)g.Bt + S.boff(cur, tstep);
    S.a_ready(cur);
    if constexpr (Sched::GATHER) { PG8_LOOKUP(gc, cur); Unit u1_; if (S.next(1, u1_)) PG8_LOOKUP(gn, u1_); else { _Pragma("unroll") for (int h_ = 0; h_ < 2; ++h_) _Pragma("unroll") for (int i_ = 0; i_ < 2; ++i_) gn[h_][i_] = gc[h_][i_]; } }
    PG8_STAGE(PG8_SB(0, 0), cB, voffB); if constexpr (Sched::GATHER) PG8_STAGE_G(PG8_SA(0, 0), 0, gc[0]); else PG8_STAGE(PG8_SA(0, 0), cA, voffA);
    PG8_STAGE(PG8_SB(0, 1), cB + hstep, voffB); if constexpr (Sched::GATHER) PG8_STAGE_G(PG8_SA(0, 1), 0, gc[1]); else PG8_STAGE(PG8_SA(0, 1), cA + hstep, voffA);
    if (wr == 1) PG8_BAR;
    PG8_WAIT_V(4); PG8_BAR;
    PG8_STAGE(PG8_SB(1, 0), cB + kstep, voffB); if constexpr (Sched::GATHER) PG8_STAGE_G(PG8_SA(1, 0), kstep, gc[0]); else PG8_STAGE(PG8_SA(1, 0), cA + kstep, voffA);
    PG8_STAGE(PG8_SB(1, 1), cB + hstep + kstep, voffB);
    PG8_WAIT_V(6); PG8_BAR;
    PG8_STAMP();
    for (;;) {
        const bool has_next = S.next(ui + 1, nxt);
        const char* nA = has_next ? (const char*)g.A + (size_t)nxt.pm * tstep : cA; const char* nB = has_next ? (const char*)g.Bt + S.boff(nxt, tstep) : cB;
        const typename Epi::Pre pre = E.pre(cur, wr, wc, fr, fq);
        if constexpr (Sched::GATHER) { if (!has_next) { _Pragma("unroll") for (int h_ = 0; h_ < 2; ++h_) _Pragma("unroll") for (int i_ = 0; i_ < 2; ++i_) gn[h_][i_] = gc[h_][i_]; } }
        for (int t = 0; t < nt; t += 2) {
            const bool last = (t == nt - 2);
            unsigned gs[2][2]; size_t k1 = 0, k2 = 0;
            if constexpr (Sched::GATHER) { k1 = (size_t)(t + 1) * kstep; k2 = last ? 0 : (size_t)(t + 2) * kstep;
                _Pragma("unroll") for (int h_ = 0; h_ < 2; ++h_) _Pragma("unroll") for (int i_ = 0; i_ < 2; ++i_) gs[h_][i_] = last ? gn[h_][i_] : gc[h_][i_]; }
            const char* a1 = cA + (size_t)(t + 1) * kstep;
            const char* a2 = last ? nA : cA + (size_t)(t + 2) * kstep; const char* b2 = last ? nB : cB + (size_t)(t + 2) * kstep;
            const char* a3 = a2 + kstep; const char* b3 = b2 + kstep;
            if (last && has_next) S.a_ready(nxt);
            PG8_LDB(B0, 0, 0); PG8_SCHED; PG8_LDA(At, 0, 0); if constexpr (Sched::GATHER) PG8_STAGE_G(PG8_SA(1, 1), k1, gc[1]); else PG8_STAGE(PG8_SA(1, 1), a1 + hstep, voffA);
            PG8_WAIT_L(8); PG8_BAR; PG8_WAIT_L(0); PG8_MMA(0, 0, At, B0); PG8_BAR; PG8_SCHED;
            PG8_LDB(B1, 0, 1); PG8_STAGE(PG8_SB(0, 0), b2, voffB);
            PG8_BAR; PG8_WAIT_L(0); PG8_MMA(0, 1, At, B1); PG8_BAR;
            PG8_LDA(At, 0, 1); if constexpr (Sched::GATHER) PG8_STAGE_G(PG8_SA(0, 0), k2, gs[0]); else PG8_STAGE(PG8_SA(0, 0), a2, voffA);
            PG8_BAR; PG8_WAIT_L(0); PG8_MMA(1, 0, At, B0); PG8_BAR; PG8_SCHED;
            PG8_STAGE(PG8_SB(0, 1), b2 + hstep, voffB);
            PG8_WAIT_V(6); PG8_BAR; PG8_MMA(1, 1, At, B1); PG8_BAR;
            PG8_LDB(B0, 1, 0); PG8_SCHED; PG8_LDA(At, 1, 0); if constexpr (Sched::GATHER) PG8_STAGE_G(PG8_SA(0, 1), k2, gs[1]); else PG8_STAGE(PG8_SA(0, 1), a2 + hstep, voffA);
            PG8_WAIT_L(8); PG8_BAR; PG8_WAIT_L(0); PG8_MMA(0, 0, At, B0); PG8_BAR; PG8_SCHED;
            PG8_LDB(B1, 1, 1); PG8_STAGE(PG8_SB(1, 0), b3, voffB);
            PG8_BAR; PG8_WAIT_L(0); PG8_MMA(0, 1, At, B1); PG8_BAR;
            PG8_LDA(At, 1, 1); if constexpr (Sched::GATHER) PG8_STAGE_G(PG8_SA(1, 0), k2 + kstep, gs[0]); else PG8_STAGE(PG8_SA(1, 0), a3, voffA);
            PG8_BAR; PG8_WAIT_L(0); PG8_MMA(1, 0, At, B0); PG8_BAR; PG8_SCHED;
            PG8_STAGE(PG8_SB(1, 1), b3 + hstep, voffB);
            PG8_WAIT_V(6); PG8_BAR; PG8_MMA(1, 1, At, B1); PG8_BAR;
        }
        PG8_STAMP();
        u32x4 t4n_ = {0u, 0u, 0u, 0u}; bool has_nn_ = false;
        if constexpr (Sched::GATHER) { Unit u2_; has_nn_ = S.next(ui + 2, u2_); if (has_nn_) PG8_LOOKUP_LD(t4n_, u2_); }
        if constexpr (!Epi::AFTER_DRAIN) { if (wr == 0) PG8_BAR; E(acc, cur, wr, wc, fr, fq, pre); S.done(cur); if (wr == 1) PG8_BAR; }
        if constexpr (Sched::GATHER) { if (has_nn_) PG8_LOOKUP_FIN(gnn, t4n_); else { _Pragma("unroll") for (int h_ = 0; h_ < 2; ++h_) _Pragma("unroll") for (int i_ = 0; i_ < 2; ++i_) gnn[h_][i_] = gn[h_][i_]; } }
        PG8_STAMP();
        if (!has_next) break;
#pragma unroll
        for (int a = 0; a < 2; ++a)
#pragma unroll
            for (int b = 0; b < 2; ++b)
#pragma unroll
                for (int m = 0; m < 4; ++m)
#pragma unroll
                    for (int n = 0; n < 2; ++n) acc[a][b][m][n] = (f32x4){0.f, 0.f, 0.f, 0.f};
        cur = nxt; cA = nA; cB = nB; ++ui;
        if constexpr (Sched::GATHER) { _Pragma("unroll") for (int h_ = 0; h_ < 2; ++h_) _Pragma("unroll") for (int i_ = 0; i_ < 2; ++i_) { gc[h_][i_] = gn[h_][i_]; gn[h_][i_] = gnn[h_][i_]; } }
    }
    PG8_WAIT_V(0);
    if (wr == 0) PG8_BAR;
    PG8_BAR;
    if constexpr (Epi::AFTER_DRAIN) { E.fused(acc, cur, wr, wc, fr, fq, lds, wid, lane); S.done(cur); }
    PG8_STAMP();
    if (STAMP && wid == 0) { stamps[lane] = lane < nts ? (((unsigned long long)(unsigned)ts_hi << 32) | (unsigned)ts_lo) : 0ull;
        if (lane == 62) stamps[62] = rt_entry; if (lane == 63) stamps[63] = (unsigned long long)wall_clock64(); }
#undef PG8_STAMP
#undef PG8_SA
#undef PG8_SB
#undef PG8_STAGE
#undef PG8_STAGE_G
#undef PG8_LOOKUP
#undef PG8_LOOKUP_LD
#undef PG8_LOOKUP_FIN
#undef PG8_LDA
#undef PG8_LDB
#undef PG8_MMA
#undef PG8_WAIT_V
#undef PG8_WAIT_L
#undef PG8_BAR
#undef PG8_SCHED
}
}
namespace pg8 {
struct MoeOrder : StaticOrder {
    static constexpr bool GATHER = false;
    const LAS int* bexp; size_t estride;
    bool rev = false; bool same = false;
    __device__ __forceinline__ bool next(int i, Unit& u) const { const bool ok = StaticOrder::next(i, u); if (ok && rev) u.pm = nM - 1 - u.pm; if (ok && same) { u.pm = 0; u.pn = 0; } return ok; }
    __device__ __forceinline__ size_t boff(const Unit& u, size_t tstep) const { return (size_t)__builtin_amdgcn_readfirstlane(bexp[1 + u.pm]) * estride + (size_t)u.pn * tstep; }
};

struct MoeGatherOrder : MoeOrder {
    static constexpr bool GATHER = true;
    const unsigned* rowtab; unsigned nrows_src;
};

template <int MODE> struct EpiGated {
    static constexpr bool PERM = true, AFTER_DRAIN = false;
    bf16_t* O; int ldo; const float* bias; int nh; const LAS int* bexp;
    struct Pre { f32x4 b0[2], b1[2]; };
    __device__ __forceinline__ Pre pre(const Unit& u, int wr, int wc, int fr, int fq) const {
        const int colh = u.pn * HALF + wc * 32 + 8 * fq; Pre p;
        const float* bp = bias; if (MODE == 1) bp += (size_t)__builtin_amdgcn_readfirstlane(bexp[1 + u.pm]) * (size_t)(2 * nh);
#pragma unroll
        for (int n = 0; n < 2; ++n) { p.b0[n] = *(const f32x4*)(bp + colh + 4 * n); p.b1[n] = *(const f32x4*)(bp + nh + colh + 4 * n); }
        return p; }
    __device__ __forceinline__ void operator()(const f32x4 (&acc)[2][2][4][2], const Unit& u, int wr, int wc, int fr, int fq, const Pre& P) const {
        const int row0 = u.pm * BM + wr * 64 + fr, colh = u.pn * HALF + wc * 32 + 8 * fq;
        f32x4 b0[2], b1[2];
#pragma unroll
        for (int n = 0; n < 2; ++n) { b0[n] = P.b0[n]; b1[n] = P.b1[n]; }
#pragma unroll
        for (int ai = 0; ai < 2; ++ai)
#pragma unroll
            for (int m = 0; m < 4; ++m) {
                float o[8];
#pragma unroll
                for (int n = 0; n < 2; ++n) { const f32x4 a = acc[ai][0][m][n] + b0[n], g = acc[ai][1][m][n] + b1[n];
#pragma unroll
                    for (int j = 0; j < 4; ++j) {
                        if (MODE == 0) o[4 * n + j] = a[j] * sigmoidf_(g[j]);
                        else { const float gg = fminf(a[j], 7.0f), uu = fminf(fmaxf(g[j], -7.0f), 7.0f); o[4 * n + j] = (uu + 1.0f) * gg * sigmoidf_(1.702f * gg); } } }
                u32x4 w; w.x = cvt_pk_bf16(o[0], o[1]); w.y = cvt_pk_bf16(o[2], o[3]); w.z = cvt_pk_bf16(o[4], o[5]); w.w = cvt_pk_bf16(o[6], o[7]);
                *(u32x4*)(O + (size_t)(row0 + ai * HALF + m * 16) * ldo + colh) = w; }
    }
};
struct EpiBf16P {
    static constexpr bool PERM = true, AFTER_DRAIN = false;
    bf16_t* O; int ldo; const float* bias; int nbias; const LAS int* bexp; int probe = 0;
    struct Pre { f32x4 bv[2][2]; };
    __device__ __forceinline__ Pre pre(const Unit& u, int wr, int wc, int fr, int fq) const {
        const int col0 = u.pn * BM + wc * 32 + 8 * fq; Pre p;
        const float* bp = bias; if (bias && bexp) bp += (size_t)__builtin_amdgcn_readfirstlane(bexp[1 + u.pm]) * (size_t)nbias;
#pragma unroll
        for (int bj = 0; bj < 2; ++bj)
#pragma unroll
            for (int n = 0; n < 2; ++n) p.bv[bj][n] = bias ? *(const f32x4*)(bp + col0 + bj * HALF + 4 * n) : (f32x4){0.f, 0.f, 0.f, 0.f};
        return p; }
    __device__ __forceinline__ void operator()(const f32x4 (&acc)[2][2][4][2], const Unit& u_, int wr, int wc, int fr, int fq, const Pre& P) const {
        if (probe == 1) return;
        Unit u = u_; if (probe >= 2) { u.pm = 0; }
        const int row0 = u.pm * BM + wr * 64 + fr, col0 = u.pn * BM + wc * 32 + 8 * fq;
        f32x4 bv[2][2];
#pragma unroll
        for (int bj = 0; bj < 2; ++bj)
#pragma unroll
            for (int n = 0; n < 2; ++n) bv[bj][n] = P.bv[bj][n];
#pragma unroll
        for (int ai = 0; ai < 2; ++ai)
#pragma unroll
            for (int m = 0; m < 4; ++m) { bf16_t* rowp = O + (size_t)(row0 + ai * HALF + m * 16) * ldo + col0;
#pragma unroll
                for (int bj = 0; bj < 2; ++bj) { const f32x4 v0 = acc[ai][bj][m][0] + bv[bj][0], v1 = acc[ai][bj][m][1] + bv[bj][1];
                    u32x4 w; w.x = cvt_pk_bf16(v0[0], v0[1]); w.y = cvt_pk_bf16(v0[2], v0[3]); w.z = cvt_pk_bf16(v1[0], v1[1]); w.w = cvt_pk_bf16(v1[2], v1[3]);
                    if (probe == 3 && (ai | m)) { asm volatile("" :: "v"(w)); continue; }
                    *(u32x4*)(rowp + bj * HALF) = w; } }
    }
};
struct EpiF32P {
    static constexpr bool PERM = false, AFTER_DRAIN = false;
    float* C; int ldc;
    struct Pre {};
    __device__ __forceinline__ Pre pre(const Unit&, int, int, int, int) const { return Pre{}; }
    __device__ __forceinline__ void operator()(const f32x4 (&acc)[2][2][4][2], const Unit& u, int wr, int wc, int fr, int fq, const Pre&) const {
        const int row0 = u.pm * BM + wr * 64 + fr, col0 = u.pn * BM + wc * 32 + 4 * fq;
#pragma unroll
        for (int ai = 0; ai < 2; ++ai)
#pragma unroll
            for (int m = 0; m < 4; ++m) { float* rowp = C + (size_t)(row0 + ai * HALF + m * 16) * ldc + col0;
#pragma unroll
                for (int bj = 0; bj < 2; ++bj)
#pragma unroll
                    for (int n = 0; n < 2; ++n) *(f32x4*)(rowp + bj * HALF + n * 16) = acc[ai][bj][m][n]; }
    }
};
struct EpiResid {
    static constexpr bool PERM = false, AFTER_DRAIN = false;
    const float* base; float* X; const float* bias; const float* gate;
    struct Pre {};
    __device__ __forceinline__ Pre pre(const Unit&, int, int, int, int) const { return Pre{}; }
    __device__ __forceinline__ void operator()(const f32x4 (&acc)[2][2][4][2], const Unit& u, int wr, int wc, int fr, int fq, const Pre&) const {
        const int row0 = u.pm * BM + wr * 64 + fr, col0 = u.pn * BM + wc * 32 + 4 * fq;
        const float* gp = gate + (size_t)((u.pm * BM) / SEQ) * (6 * D);
        f32x4 bv[2][2], gv[2][2];
#pragma unroll
        for (int bj = 0; bj < 2; ++bj)
#pragma unroll
            for (int n = 0; n < 2; ++n) { bv[bj][n] = bias ? *(const f32x4*)(bias + col0 + bj * HALF + n * 16) : (f32x4){0.f, 0.f, 0.f, 0.f}; gv[bj][n] = *(const f32x4*)(gp + col0 + bj * HALF + n * 16); }
#pragma unroll
        for (int ai = 0; ai < 2; ++ai)
#pragma unroll
            for (int m = 0; m < 4; ++m) { const size_t off = (size_t)(row0 + ai * HALF + m * 16) * D + col0;
                f32x4 bs[2][2];
#pragma unroll
                for (int bj = 0; bj < 2; ++bj)
#pragma unroll
                    for (int n = 0; n < 2; ++n) bs[bj][n] = *(const f32x4*)(base + off + bj * HALF + n * 16);
#pragma unroll
                for (int bj = 0; bj < 2; ++bj)
#pragma unroll
                    for (int n = 0; n < 2; ++n) *(f32x4*)(X + off + bj * HALF + n * 16) = bs[bj][n] + gv[bj][n] * (acc[ai][bj][m][n] + bv[bj][n]); }
    }
};
struct EpiQRope {
    static constexpr bool PERM = true, AFTER_DRAIN = false;
    bf16_t* O; const f32x2* cs;
    struct Pre {};
    __device__ __forceinline__ Pre pre(const Unit&, int, int, int, int) const { return Pre{}; }
    __device__ __forceinline__ void operator()(const f32x4 (&acc)[2][2][4][2], const Unit& u, int wr, int wc, int fr, int fq, const Pre&) const {
        const int row0 = u.pm * BM + wr * 64 + fr, col0 = u.pn * BM + wc * 32 + 8 * fq;
#pragma unroll
        for (int bj = 0; bj < 2; ++bj) {
            const int c = col0 + bj * HALF, w = c % DQK; const bool rope = w >= DNOPE; const int k4 = rope ? ((w - DNOPE) >> 3) * 4 : 0;
#pragma unroll
            for (int ai = 0; ai < 2; ++ai)
#pragma unroll
                for (int m = 0; m < 4; ++m) { const int row = row0 + ai * HALF + m * 16;
                    f32x4 v0 = acc[ai][bj][m][0], v1 = acc[ai][bj][m][1];
                    if (rope) { const f32x4 t0 = *(const f32x4*)(cs + (size_t)row * 32 + k4), t1 = *(const f32x4*)(cs + (size_t)row * 32 + k4 + 2);
                        const float co[4] = {t0[0], t0[2], t1[0], t1[2]}, si[4] = {t0[1], t0[3], t1[1], t1[3]};
#pragma unroll
                        for (int j = 0; j < 4; ++j) { const float x1 = v0[j], x2 = v1[j]; v0[j] = x1 * co[j] - x2 * si[j]; v1[j] = x2 * co[j] + x1 * si[j]; } }
                    u32x4 wv; wv.x = cvt_pk_bf16(v0[0], v0[1]); wv.y = cvt_pk_bf16(v0[2], v0[3]); wv.z = cvt_pk_bf16(v1[0], v1[1]); wv.w = cvt_pk_bf16(v1[2], v1[3]);
                    *(u32x4*)(O + (size_t)row * (NH * DQK) + c) = wv;
                    asm volatile("" ::: "memory"); } }
    }
};

template <bool BF> struct EpiResidB {
    static constexpr bool PERM = true, AFTER_DRAIN = false;
    const void* base; bf16_t* X; const float* bias; const float* gate;
    struct Pre {};
    __device__ __forceinline__ Pre pre(const Unit&, int, int, int, int) const { return Pre{}; }
    __device__ __forceinline__ void operator()(const f32x4 (&acc)[2][2][4][2], const Unit& u, int wr, int wc, int fr, int fq, const Pre&) const {
        const int row0 = u.pm * BM + wr * 64 + fr, col0 = u.pn * BM + wc * 32 + 8 * fq;
        const float* gp = gate + (size_t)((u.pm * BM) / SEQ) * (6 * D);
        f32x4 bv[2][2], gv[2][2];
#pragma unroll
        for (int bj = 0; bj < 2; ++bj)
#pragma unroll
            for (int n = 0; n < 2; ++n) { bv[bj][n] = bias ? *(const f32x4*)(bias + col0 + bj * HALF + 4 * n) : (f32x4){0.f, 0.f, 0.f, 0.f}; gv[bj][n] = *(const f32x4*)(gp + col0 + bj * HALF + 4 * n); }
#pragma unroll
        for (int ai = 0; ai < 2; ++ai)
#pragma unroll
            for (int m = 0; m < 4; ++m) { const size_t off = (size_t)(row0 + ai * HALF + m * 16) * D + col0;
                f32x4 b0[2], b1[2];
#pragma unroll
                for (int bj = 0; bj < 2; ++bj) {
                    if (BF) { const u32x4 w = *(const u32x4*)((const bf16_t*)base + off + bj * HALF); b0[bj] = (f32x4){bflo(w.x), bfhi(w.x), bflo(w.y), bfhi(w.y)}; b1[bj] = (f32x4){bflo(w.z), bfhi(w.z), bflo(w.w), bfhi(w.w)}; }
                    else { b0[bj] = *(const f32x4*)((const float*)base + off + bj * HALF); b1[bj] = *(const f32x4*)((const float*)base + off + bj * HALF + 4); } }
#pragma unroll
                for (int bj = 0; bj < 2; ++bj) { const f32x4 v0 = b0[bj] + gv[bj][0] * (acc[ai][bj][m][0] + bv[bj][0]), v1 = b1[bj] + gv[bj][1] * (acc[ai][bj][m][1] + bv[bj][1]);
                    u32x4 w; w.x = cvt_pk_bf16(v0[0], v0[1]); w.y = cvt_pk_bf16(v0[2], v0[3]); w.z = cvt_pk_bf16(v1[0], v1[1]); w.w = cvt_pk_bf16(v1[2], v1[3]);
                    *(u32x4*)(X + off + bj * HALF) = w; } }
    }
};
struct EpiLatQ {
    static constexpr bool PERM = true, AFTER_DRAIN = false;
    bf16_t* O0; int ld0, n0; bf16_t* KR; const f32x2* cs; float* ssp;
    struct Pre {};
    __device__ __forceinline__ Pre pre(const Unit&, int, int, int, int) const { return Pre{}; }
    __device__ __forceinline__ void operator()(const f32x4 (&acc)[2][2][4][2], const Unit& u, int wr, int wc, int fr, int fq, const Pre&) const {
        const int row0 = u.pm * BM + wr * 64 + fr, col0 = u.pn * BM + wc * 32 + 8 * fq;
#pragma unroll
        for (int ai = 0; ai < 2; ++ai)
#pragma unroll
            for (int m = 0; m < 4; ++m) { const int row = row0 + ai * HALF + m * 16; float ss = 0.f;
#pragma unroll
                for (int bj = 0; bj < 2; ++bj) { const int c = col0 + bj * HALF; f32x4 v0 = acc[ai][bj][m][0], v1 = acc[ai][bj][m][1];
                    if (c < n0) {
                        ss += (v0[0] * v0[0] + v0[1] * v0[1]) + (v0[2] * v0[2] + v0[3] * v0[3]) + (v1[0] * v1[0] + v1[1] * v1[1]) + (v1[2] * v1[2] + v1[3] * v1[3]);
                        u32x4 w; w.x = cvt_pk_bf16(v0[0], v0[1]); w.y = cvt_pk_bf16(v0[2], v0[3]); w.z = cvt_pk_bf16(v1[0], v1[1]); w.w = cvt_pk_bf16(v1[2], v1[3]);
                        *(u32x4*)(O0 + (size_t)row * ld0 + c) = w;
                    } else if (KR && c < n0 + DROPE) { const int k4 = ((c - n0) >> 3) * 4; const f32x4 t0 = *(const f32x4*)(cs + (size_t)row * 32 + k4), t1 = *(const f32x4*)(cs + (size_t)row * 32 + k4 + 2);
                        const float co[4] = {t0[0], t0[2], t1[0], t1[2]}, si[4] = {t0[1], t0[3], t1[1], t1[3]};
#pragma unroll
                        for (int j = 0; j < 4; ++j) { const float x1 = v0[j], x2 = v1[j]; v0[j] = x1 * co[j] - x2 * si[j]; v1[j] = x2 * co[j] + x1 * si[j]; }
                        u32x4 w; w.x = cvt_pk_bf16(v0[0], v0[1]); w.y = cvt_pk_bf16(v0[2], v0[3]); w.z = cvt_pk_bf16(v1[0], v1[1]); w.w = cvt_pk_bf16(v1[2], v1[3]);
                        *(u32x4*)(KR + (size_t)row * DROPE + (c - n0)) = w; } }
                ss += __shfl_xor(ss, 16); ss += __shfl_xor(ss, 32);
                if (fq == 0) ssp[(size_t)row * 8 + u.pn * 4 + wc] = ss;
                asm volatile("" ::: "memory"); }
    }
};
struct EpiScaled {
    static constexpr bool PERM = true, AFTER_DRAIN = false;
    bf16_t* O; int ldo; const float* ssp; int mode, np; float inv_nd;
    struct Pre {};
    __device__ __forceinline__ Pre pre(const Unit&, int, int, int, int) const { return Pre{}; }
    __device__ __forceinline__ float rstd_of(int t) const { const f32x4 a = *(const f32x4*)(ssp + (size_t)t * 8); float s = (a[0] + a[1]) + (a[2] + a[3]);
        if (np == 8) { const f32x4 b = *(const f32x4*)(ssp + (size_t)t * 8 + 4); s += (b[0] + b[1]) + (b[2] + b[3]); } return rsqrtf(s * inv_nd + EPS); }
    __device__ __forceinline__ void operator()(const f32x4 (&acc)[2][2][4][2], const Unit& u, int wr, int wc, int fr, int fq, const Pre&) const {
        const int row0 = u.pm * BM + wr * 64 + fr, col0 = u.pn * BM + wc * 32 + 8 * fq;
        if (mode == 1) {
#pragma unroll
            for (int bj = 0; bj < 2; ++bj) { const int c = col0 + bj * HALF; float rc[8];
#pragma unroll
                for (int j = 0; j < 8; ++j) rc[j] = rstd_of(c + j);
#pragma unroll
                for (int ai = 0; ai < 2; ++ai)
#pragma unroll
                    for (int m = 0; m < 4; ++m) { const f32x4 v0 = acc[ai][bj][m][0], v1 = acc[ai][bj][m][1];
                        u32x4 w; w.x = cvt_pk_bf16(v0[0] * rc[0], v0[1] * rc[1]); w.y = cvt_pk_bf16(v0[2] * rc[2], v0[3] * rc[3]); w.z = cvt_pk_bf16(v1[0] * rc[4], v1[1] * rc[5]); w.w = cvt_pk_bf16(v1[2] * rc[6], v1[3] * rc[7]);
                        *(u32x4*)(O + (size_t)(row0 + ai * HALF + m * 16) * ldo + c) = w; }
                asm volatile("" ::: "memory"); }
        } else {
#pragma unroll
            for (int ai = 0; ai < 2; ++ai)
#pragma unroll
                for (int m = 0; m < 4; ++m) { const int row = row0 + ai * HALF + m * 16; const float r = rstd_of(row);
#pragma unroll
                    for (int bj = 0; bj < 2; ++bj) { const f32x4 v0 = acc[ai][bj][m][0] * r, v1 = acc[ai][bj][m][1] * r;
                        u32x4 w; w.x = cvt_pk_bf16(v0[0], v0[1]); w.y = cvt_pk_bf16(v0[2], v0[3]); w.z = cvt_pk_bf16(v1[0], v1[1]); w.w = cvt_pk_bf16(v1[2], v1[3]);
                        *(u32x4*)(O + (size_t)row * ldo + col0 + bj * HALF) = w; }
                    asm volatile("" ::: "memory"); }
        }
    }
};

#if NAIVE_GEMM
template <class Epi, class Sched>
__device__ __forceinline__ void gemm_phase_naive(PG8_LAS unsigned char*, const Gemm g, const Sched& S, const Epi& E) {
    const int tid = threadIdx.x, wid = tid >> 6, lane = tid & 63, wr = wid >> 2, wc = wid & 3, fr = lane & 15, fq = lane >> 4;
    const size_t tstep = (size_t)BM * g.K * 2;
    Unit u;
    for (int i = 0; S.next(i, u); ++i) {
        f32x4 acc[2][2][4][2];
        const bf16_t* Bb = (const bf16_t*)((const char*)g.Bt + S.boff(u, tstep));
#pragma unroll 1
        for (int ai = 0; ai < 2; ++ai)
#pragma unroll 1
            for (int m = 0; m < 4; ++m) {
                const bf16_t* ar = g.A + (size_t)(u.pm * BM + ai * HALF + wr * 64 + m * 16 + fr) * g.K;
#pragma unroll
                for (int bj = 0; bj < 2; ++bj)
#pragma unroll
                    for (int n = 0; n < 2; ++n) {
                        const int cs = Epi::PERM ? (bj * HALF + wc * 32 + 8 * fq + 4 * n) : (bj * HALF + wc * 32 + 16 * n + 4 * fq);
                        float s[4] = {0.f, 0.f, 0.f, 0.f};
                        for (int k = 0; k < g.K; k += 8) {
                            const u32x4 av = *(const u32x4*)(ar + k);
#pragma unroll
                            for (int j = 0; j < 4; ++j) { const u32x4 bv = *(const u32x4*)(Bb + (size_t)(cs + j) * g.K + k);
                                s[j] += bflo(av.x) * bflo(bv.x) + bfhi(av.x) * bfhi(bv.x) + bflo(av.y) * bflo(bv.y) + bfhi(av.y) * bfhi(bv.y)
                                      + bflo(av.z) * bflo(bv.z) + bfhi(av.z) * bfhi(bv.z) + bflo(av.w) * bflo(bv.w) + bfhi(av.w) * bfhi(bv.w); } }
                        f32x4 r = {s[0], s[1], s[2], s[3]};
#pragma unroll
                        for (int a2 = 0; a2 < 2; ++a2)
#pragma unroll
                            for (int m2 = 0; m2 < 4; ++m2) if (a2 == ai && m2 == m) acc[a2][bj][m2][n] = r;
                    }
            }
        E(acc, u, wr, wc, fr, fq, E.pre(u, wr, wc, fr, fq));
    }
}
#endif
}

#if NAIVE_GEMM
#define GEMM_PHASE pg8::gemm_phase_naive
#else
#define GEMM_PHASE pg8::gemm_phase
#endif
struct Frame {
    LAS unsigned char* lds; GAS unsigned char* ws; const Args* a;
    int tid, lane, wave, G, blk;
};
__device__ __forceinline__ const float* modp(const Frame& F, int l, int b, int part) { return (const float*)(F.ws + WS_MOD) + ((size_t)(l * NB + b) * 6 + part) * D; }

enum { CM_ID = 0, CM_GLU = 1, CM_UQ = 2, CM_DKV = 3 };
__device__ __forceinline__ int cvt_srccol(int mode, int n, int nvalid, int nh) {
    if (mode == CM_GLU) { const int pn = n >> 8, r = n & 255; return r < 128 ? pn * 128 + r : nh + pn * 128 + (r - 128); }
    if (mode == CM_UQ) { const int h = n / DQK, w = n - h * DQK; if (w < DNOPE) return n; const int p = w - DNOPE, blk = p >> 3, wi = p & 7, i = 4 * blk + (wi & 3); return h * DQK + (wi < 4 ? DNOPE + i : DNOPE + 32 + i); }
    if (mode == CM_DKV) { if (n < KVLORA) return n; if (n >= KVLORA + DROPE) return -1; const int p = n - KVLORA, blk = p >> 3, wi = p & 7, i = 4 * blk + (wi & 3); return KVLORA + (wi < 4 ? i : 32 + i); }
    return n < nvalid ? n : -1;
}
struct CvtJob { const float* src; bf16_t* dst; int K, ld, ndst, nvalid, mode, batch; size_t sstride, dstride; float scale; const float* kgain; };
__device__ __forceinline__ int cvt_tiles(const CvtJob& j) { return j.batch * (j.ndst / 128) * (j.K / 128); }
struct CvtTile { const float* src; bf16_t* dst; int n0, k0, sc; };
__device__ __forceinline__ CvtTile cvt_locate(const Frame& F, const CvtJob& J, int t) {
    const int nkt = J.K / 128, nnt = J.ndst / 128, per = nkt * nnt, bi = t / per, r = t - bi * per, nt = r / nkt, kt = r - nt * nkt;
    CvtTile T; T.src = J.src + (size_t)bi * J.sstride; T.dst = J.dst + (size_t)bi * J.dstride; T.n0 = nt * 128; T.k0 = kt * 128;
    T.sc = cvt_srccol(J.mode, T.n0 + 4 * (F.tid & 31), J.nvalid, J.ndst / 2); return T;
}
__device__ __forceinline__ void cvt_load(const Frame& F, const CvtJob& J, const CvtTile& T, f32x4 (&v)[8]) {
    const int kg = F.tid >> 5;
#pragma unroll
    for (int i = 0; i < 8; ++i) v[i] = T.sc >= 0 ? *(const f32x4*)(T.src + (size_t)(T.k0 + 8 * kg + i) * J.ld + T.sc) : (f32x4){0.f, 0.f, 0.f, 0.f};
}
__device__ __forceinline__ void cvt_to_lds(const Frame& F, const CvtJob& J, const CvtTile& T, const f32x4 (&v)[8], LAS unsigned char* img) {
    const int nq = F.tid & 31, kg = F.tid >> 5; float sc[8];
#pragma unroll
    for (int i = 0; i < 8; ++i) sc[i] = J.kgain ? J.scale * J.kgain[T.k0 + 8 * kg + i] : J.scale;
#pragma unroll
    for (int j = 0; j < 4; ++j) {
        u32x4 w; w.x = cvt_pk_bf16(v[0][j] * sc[0], v[1][j] * sc[1]); w.y = cvt_pk_bf16(v[2][j] * sc[2], v[3][j] * sc[3]); w.z = cvt_pk_bf16(v[4][j] * sc[4], v[5][j] * sc[5]); w.w = cvt_pk_bf16(v[6][j] * sc[6], v[7][j] * sc[7]);
        *(LAS u32x4*)(img + (4 * nq + j) * 256 + ((kg ^ (nq & 7)) << 4)) = w; }
}
__device__ __forceinline__ void cvt_from_lds(const Frame& F, const CvtJob& J, const CvtTile& T, const LAS unsigned char* img) {
#pragma unroll
    for (int p = 0; p < 4; ++p) { const int row = p * 32 + (F.tid >> 4), c = F.tid & 15;
        const u32x4 w = *(const LAS u32x4*)(img + row * 256 + ((c ^ ((row >> 2) & 7)) << 4));
        *(u32x4*)(T.dst + (size_t)(T.n0 + row) * J.K + T.k0 + c * 8) = w; }
}
__device__ __forceinline__ void cvt_job(const Frame& F, const CvtJob& J, int t0, int nt) {
    for (int t = t0; t < nt; t += 2 * F.G) {
        const bool two = t + F.G < nt;
        const CvtTile A = cvt_locate(F, J, t), B = cvt_locate(F, J, two ? t + F.G : t);
        f32x4 va[8], vb[8];
        cvt_load(F, J, A, va); if (two) cvt_load(F, J, B, vb);
        cvt_to_lds(F, J, A, va, F.lds); if (two) cvt_to_lds(F, J, B, vb, F.lds + 32768);
        __syncthreads();
        cvt_from_lds(F, J, A, F.lds); if (two) cvt_from_lds(F, J, B, F.lds + 32768);
        __syncthreads();
    }
}
__device__ __forceinline__ void sincos_small(float r, float& s, float& c) {
    const float q = rintf(r * 0.63661977236758134f); const float y = fmaf(q, -1.5707963267948966f, r) + q * 4.371139e-8f; const int qi = (int)q & 3;
    const float y2 = y * y;
    const float sp = y + y * y2 * (-1.6666654611e-1f + y2 * (8.3321608736e-3f + y2 * (-1.9515295891e-4f)));
    const float cp = 1.0f - 0.5f * y2 + y2 * y2 * (4.166664568298827e-2f + y2 * (-1.388731625493765e-3f + y2 * 2.443315711809948e-5f));
    s = (qi == 0) ? sp : (qi == 1) ? cp : (qi == 2) ? -sp : -cp;
    c = (qi == 0) ? cp : (qi == 1) ? -sp : (qi == 2) ? -cp : sp;
}
__device__ __forceinline__ void ph_prologue(const Frame& F) {
    const Args& A = *F.a; GAS unsigned char* ws = F.ws;
    const float qscale = 0.07216878364870322f * 1.4426950408889634f;
    CvtJob J[10];
    J[0] = {GPTR(const float, A.in[I_PW1W]), (bf16_t*)(ws + WS_WPW1), 1024, 2048, 2048, 2048, CM_GLU, 1, 0, 0, 1.f, nullptr};
    J[1] = {GPTR(const float, A.in[I_PW2W]), (bf16_t*)(ws + WS_WPW2), 1024, 1024, 1024, 1024, CM_ID, 1, 0, 0, 1.f, nullptr};
    J[2] = {GPTR(const float, A.in[I_WDKV]), (bf16_t*)(ws + WS_WDKV), 1024, 320, 512, 320, CM_DKV, 1, 0, 0, 1.f, nullptr};
    J[3] = {GPTR(const float, A.in[I_WDQ]), (bf16_t*)(ws + WS_WDQ), 1024, 384, 512, 384, CM_ID, 1, 0, 0, 1.f, nullptr};
    J[4] = {GPTR(const float, A.in[I_WUK]), (bf16_t*)(ws + WS_WUK), 256, 1024, 1024, 1024, CM_ID, 1, 0, 0, 1.f, GPTR(const float, A.in[I_CKVG])};
    J[5] = {GPTR(const float, A.in[I_WUV]), (bf16_t*)(ws + WS_WUV), 256, 1024, 1024, 1024, CM_ID, 1, 0, 0, 1.f, GPTR(const float, A.in[I_CKVG])};
    J[6] = {GPTR(const float, A.in[I_WUQ]), (bf16_t*)(ws + WS_WUQ), 384, 1536, 1536, 1536, CM_UQ, 1, 0, 0, qscale, GPTR(const float, A.in[I_CQG])};
    J[7] = {GPTR(const float, A.in[I_WO]), (bf16_t*)(ws + WS_WO), 1024, 1024, 1024, 1024, CM_ID, 1, 0, 0, 1.f, nullptr};
    J[8] = {GPTR(const float, A.in[I_WGU]), (bf16_t*)(ws + WS_WGU), 1024, 2048, 2048, 2048, CM_GLU, 64, (size_t)1024 * 2048, (size_t)2048 * 1024, 1.f, nullptr};
    J[9] = {GPTR(const float, A.in[I_WDN]), (bf16_t*)(ws + WS_WDN), 1024, 1024, 1024, 1024, CM_ID, 64, (size_t)1024 * 1024, (size_t)1024 * 1024, 1.f, nullptr};
    int base = 0;
#pragma unroll
    for (int j = 0; j < 10; ++j) { const int nt = cvt_tiles(J[j]);
        int t = F.blk - (base % F.G); if (t < 0) t += F.G;
        cvt_job(F, J[j], t, nt);
        base += nt; }
    {
        LAS float* cact = (LAS float*)F.lds;
        LAS float* red = cact + 4096;
        for (int i = F.tid; i < NB * D; i += NTHR) { const float c = GPTR(const float, A.in[I_C])[i]; cact[i] = c * sigmoidf_(c); }
        __syncthreads();
        for (int it = F.blk; it < 2 * 96; it += F.G) {
            const int l = it / 96, j0 = (it - l * 96) * 64, col = F.tid & 63, dg = F.tid >> 6;
            const float* wp = GPTR(const float, A.in[I_MODW]) + (size_t)l * D * 6 * D + (size_t)(dg * 128) * (6 * D) + j0 + col;
            float a0 = 0.f, a1 = 0.f, a2 = 0.f, a3 = 0.f;
#pragma unroll 32
            for (int d = 0; d < 128; ++d) { const float w = wp[(size_t)d * (6 * D)]; const int dd = dg * 128 + d;
                a0 += w * cact[dd]; a1 += w * cact[1024 + dd]; a2 += w * cact[2048 + dd]; a3 += w * cact[3072 + dd]; }
            red[(dg * 4 + 0) * 64 + col] = a0; red[(dg * 4 + 1) * 64 + col] = a1; red[(dg * 4 + 2) * 64 + col] = a2; red[(dg * 4 + 3) * 64 + col] = a3;
            __syncthreads();
            if (F.tid < 256) { const int b = F.tid >> 6, c2 = F.tid & 63; float s = GPTR(const float, A.in[I_MODB])[l * 6 * D + j0 + c2];
#pragma unroll
                for (int g = 0; g < 8; ++g) s += red[(g * 4 + b) * 64 + c2];
                ((float*)(ws + WS_MOD))[(size_t)(l * NB + b) * (6 * D) + j0 + c2] = s; }
            __syncthreads();
        }
    }
    {
        const int* pos = (const int*)GPTR(const float, A.in[I_POS]); f32x2* cs = (f32x2*)(ws + WS_CS);
        for (int idx = F.blk * NTHR + F.tid; idx < NTOK * 32; idx += F.G * NTHR) {
            const int tok = idx >> 5, i = idx & 31;
            const double inv = exp(-(2.0 * 9.210340371976184 / 64.0) * (double)i);
            const double ang = (double)pos[tok] * inv, rev = ang * 0.15915494309189535, fr = rev - rint(rev);
            float s, c; sincos_small((float)(fr * 6.283185307179586), s, c);
            cs[idx] = (f32x2){c, s};
        }
    }
}

__device__ __forceinline__ void row_ld16(const float* p, int lane, f32x4 (&v)[4]) {
#pragma unroll
    for (int i = 0; i < 4; ++i) v[i] = *(const f32x4*)(p + i * 256 + lane * 4);
}
__device__ __forceinline__ void row_st16_bf16(bf16_t* p, int lane, const f32x4 (&v)[4]) {
#pragma unroll
    for (int i = 0; i < 4; ++i) { u32x2 w; w.x = cvt_pk_bf16(v[i][0], v[i][1]); w.y = cvt_pk_bf16(v[i][2], v[i][3]); *(u32x2*)(p + i * 256 + lane * 4) = w; }
}
__device__ __forceinline__ float row_rstd(const f32x4 (&v)[4]) {
    float s = 0.f;
#pragma unroll
    for (int i = 0; i < 4; ++i) s += v[i][0] * v[i][0] + v[i][1] * v[i][1] + v[i][2] * v[i][2] + v[i][3] * v[i][3];
    s = wave_sum(s);
    return rsqrtf(s * (1.0f / D) + EPS);
}

__device__ __forceinline__ void ph_norm1(const Frame& F) {
    const Args& A = *F.a; bf16_t* HA = (bf16_t*)(F.ws + WS_HA); const float* g = GPTR(const float, A.in[I_N1G]);
    for (int row = F.blk * NWAVE + F.wave; row < NTOK; row += F.G * NWAVE) {
        const int b = row / SEQ; f32x4 v[4], gv[4], sh[4], sc[4];
        row_ld16(GPTR(const float, A.in[I_X]) + (size_t)row * D, F.lane, v); row_ld16(g, F.lane, gv); row_ld16(modp(F, 0, b, 0), F.lane, sh); row_ld16(modp(F, 0, b, 1), F.lane, sc);
        const float rs = row_rstd(v);
#pragma unroll
        for (int i = 0; i < 4; ++i) v[i] = v[i] * rs * gv[i] * (sc[i] + 1.0f) + sh[i];
        row_st16_bf16(HA + (size_t)row * D, F.lane, v);
    }
}

__device__ __forceinline__ void ph_conv(const Frame& F) {
    const Args& A = *F.a; const bf16_t* U = (const bf16_t*)(F.ws + WS_HB); bf16_t* O = (bf16_t*)(F.ws + WS_HC);
    LAS unsigned char* tile = F.lds;
    LAS f32x2* part = (LAS f32x2*)(F.lds + 62 * 2048);
    LAS f32x2* red = part + 8 * NTHR;
    const int c2 = F.tid * 2;
    f32x2 w[CONVW];
#pragma unroll
    for (int j = 0; j < CONVW; ++j) w[j] = *(const f32x2*)(GPTR(const float, A.in[I_DWW]) + j * D + c2);
    const f32x2 db = *(const f32x2*)(GPTR(const float, A.in[I_DWB]) + c2), lg = *(const f32x2*)(GPTR(const float, A.in[I_LNG]) + c2), lb = *(const f32x2*)(GPTR(const float, A.in[I_LNB]) + c2);
    for (int t = F.blk; t < NTOK / 32; t += F.G) {
        const int tok0 = t * 32, s0 = tok0 % SEQ;
        for (int ch = F.tid; ch < 62 * 128; ch += NTHR) { const int r = ch >> 7, cc = ch & 127; u32x4 v = {0u, 0u, 0u, 0u};
            if (s0 + r - 30 >= 0) v = *(const u32x4*)(U + (size_t)(tok0 + r - 30) * D + cc * 8);
            *(LAS u32x4*)(tile + r * 2048 + cc * 16) = v; }
        __syncthreads();
#pragma unroll 1
        for (int g = 0; g < 4; ++g) {
            f32x2 acc[8];
#pragma unroll
            for (int r = 0; r < 8; ++r) acc[r] = db;
#pragma unroll
            for (int j = 0; j < 38; ++j) { const unsigned u = *(const LAS unsigned*)(tile + (g * 8 + j) * 2048 + F.tid * 4); const f32x2 x = {bflo(u), bfhi(u)};
#pragma unroll
                for (int r = 0; r < 8; ++r) { const int tap = j - r; if (tap >= 0 && tap < CONVW) acc[r] += x * w[tap]; } }
#pragma unroll
            for (int r = 0; r < 8; ++r) part[r * NTHR + F.tid] = (f32x2){acc[r][0] + acc[r][1], acc[r][0] * acc[r][0] + acc[r][1] * acc[r][1]};
            __syncthreads();
            { float s = 0.f, q = 0.f;
#pragma unroll
              for (int i = 0; i < 8; ++i) { const f32x2 p = part[F.wave * NTHR + i * 64 + F.lane]; s += p[0]; q += p[1]; }
              s = wave_sum(s); q = wave_sum(q);
              if (F.lane == 0) { const float mean = s * (1.0f / D), var = fmaxf(q * (1.0f / D) - mean * mean, 0.f); red[F.wave] = (f32x2){mean, rsqrtf(var + EPS)}; } }
            __syncthreads();
#pragma unroll
            for (int r = 0; r < 8; ++r) { const f32x2 st = red[r]; const float mean = st[0], rs = st[1];
                const float y0 = (acc[r][0] - mean) * rs * lg[0] + lb[0], y1 = (acc[r][1] - mean) * rs * lg[1] + lb[1];
                *(unsigned*)(O + (size_t)(tok0 + g * 8 + r) * D + c2) = cvt_pk_bf16(y0 * sigmoidf_(y0), y1 * sigmoidf_(y1)); }
            __syncthreads();
        }
    }
}

__device__ __forceinline__ void ph_router_prep(const Frame& F) {
    const Args& A = *F.a; bf16_t* rwf = (bf16_t*)(F.ws + WS_RWF); float* rbias = (float*)(F.ws + WS_RBIAS);
    for (int it = F.blk; it < 8 * 64; it += F.G) {
        const int lb = it >> 6, s = it & 63, l = lb >> 2, b = lb & 3, hh = F.tid >> 8, e = (F.tid >> 3) & 31, j = F.tid & 7, k = 16 * s + 8 * hh + j;
        const float v = GPTR(const float, A.in[I_N2G])[l * D + k] * (1.0f + modp(F, l, b, 4)[k]) * GPTR(const float, A.in[I_RW])[(size_t)l * D * NE + k * NE + e];
        const unsigned hi = cvt_pk_bf16(v, 0.f) & 0xffffu; const float rem = v - bflo(hi); const unsigned lo = cvt_pk_bf16(rem, 0.f) & 0xffffu;
        const size_t o = ((size_t)lb * 2 * 64 * 2 * 32 + ((size_t)s * 2 + hh) * 32 + e) * 8 + j;
        rwf[o] = (bf16_t)hi; rwf[o + (size_t)64 * 2 * 32 * 8] = (bf16_t)lo;
    }
    if (F.blk < 8) { const int l = F.blk >> 2, b = F.blk & 3, e = F.tid >> 4, q = F.tid & 15; float s = 0.f;
        for (int k = q; k < D; k += 16) s += modp(F, l, b, 3)[k] * GPTR(const float, A.in[I_RW])[(size_t)l * D * NE + k * NE + e];
        s += __shfl_xor(s, 8); s += __shfl_xor(s, 4); s += __shfl_xor(s, 2); s += __shfl_xor(s, 1);
        if (q == 0) rbias[F.blk * NE + e] = s + GPTR(const float, A.in[I_RB])[l * NE + e]; }
}

__device__ __forceinline__ void ph_router(const Frame& F, int l) {
    const Args& A = *F.a; const bf16_t* X = (const bf16_t*)(F.ws + WS_X); bf16_t* HA = (bf16_t*)(F.ws + WS_HA);
    const int ntok_blk = NTOK / F.G, tok0 = F.blk * ntok_blk, b = tok0 / SEQ;
    LAS unsigned char* wl_ = F.lds;
    LAS int* cnt = (LAS int*)(F.lds + 131072 + 2304);
    LAS float* cx = (LAS float*)(F.lds + 135168);
    LAS float* sq = (LAS float*)(F.lds + 135168 + 16384);
    { const u32x4* src = (const u32x4*)(F.ws + WS_RWF + (size_t)(l * NB + b) * 131072);
      for (int i = F.tid; i < 131072 / 16; i += NTHR) *(LAS u32x4*)(wl_ + i * 16) = src[i]; }
    if (F.tid < NE) cnt[F.tid] = 0;
    __syncthreads();
    const int w = F.wave, lane = F.lane, grp = w & 3, kh = w >> 2, r = lane & 31, hi = lane >> 5;
    {
        const bf16_t* xr = X + (size_t)(tok0 + grp * 32 + r) * D + kh * 512 + hi * 8;
        const LAS unsigned char* bw = wl_ + ((kh * 32 * 2 + hi) * 32 + r) * 16;
        f32x16 acc;
#pragma unroll
        for (int i = 0; i < 16; ++i) acc[i] = 0.f;
        float ssq = 0.f;
        u32x4 xa[8], xb[8];
#define RT_LD(dst, s0) do { _Pragma("unroll") for (int u = 0; u < 8; ++u) dst[u] = *(const u32x4*)(xr + ((s0) + u) * 16); } while (0)
#define RT_DO(src, s0) do { _Pragma("unroll") for (int u = 0; u < 8; ++u) { const u32x4 xw = src[u]; \
            { const float a0 = bflo(xw.x), a1 = bfhi(xw.x), a2 = bflo(xw.y), a3 = bfhi(xw.y), a4 = bflo(xw.z), a5 = bfhi(xw.z), a6 = bflo(xw.w), a7 = bfhi(xw.w); \
              ssq += (a0 * a0 + a1 * a1) + (a2 * a2 + a3 * a3) + (a4 * a4 + a5 * a5) + (a6 * a6 + a7 * a7); } \
            const bf16x8 ah = *(const bf16x8*)&xw; \
            const bf16x8 bh = *(const LAS bf16x8*)(bw + ((s0) + u) * 1024), bl = *(const LAS bf16x8*)(bw + ((s0) + u) * 1024 + 65536); \
            acc = __builtin_amdgcn_mfma_f32_32x32x16_bf16(ah, bh, acc, 0, 0, 0); acc = __builtin_amdgcn_mfma_f32_32x32x16_bf16(ah, bl, acc, 0, 0, 0); } } while (0)
        RT_LD(xa, 0);
#pragma unroll 1
        for (int s0 = 0; s0 < 32; s0 += 16) { RT_LD(xb, s0 + 8); RT_DO(xa, s0); if (s0 + 16 < 32) RT_LD(xa, s0 + 16); RT_DO(xb, s0 + 8); }
#undef RT_LD
#undef RT_DO
        sq[(grp * 32 + r) * 4 + kh * 2 + hi] = ssq;
        if (kh == 1) { LAS float* c = cx + (grp * 64 + lane) * 16;
#pragma unroll
            for (int i = 0; i < 4; ++i) *(LAS f32x4*)(c + i * 4) = (f32x4){acc[4 * i], acc[4 * i + 1], acc[4 * i + 2], acc[4 * i + 3]}; }
        __syncthreads();
        if (kh == 0) { const LAS float* c = cx + (grp * 64 + lane) * 16;
#pragma unroll
            for (int i = 0; i < 4; ++i) { const f32x4 p = *(const LAS f32x4*)(c + i * 4); acc[4 * i] += p[0]; acc[4 * i + 1] += p[1]; acc[4 * i + 2] += p[2]; acc[4 * i + 3] += p[3]; } }
        __syncthreads();
        if (kh == 0) {
#pragma unroll
            for (int i = 0; i < 16; ++i) cx[(grp * 32 + (i & 3) + 8 * (i >> 2) + 4 * hi) * 32 + r] = acc[i]; }
        __syncthreads();
    }
    int* topi = (int*)(F.ws + WS_TOPI); float* gate = (float*)(F.ws + WS_GATE); int* rank = (int*)(F.ws + WS_RANK);
    if (F.tid < 128) {
        const int row = tok0 + F.tid; const f32x4 q4 = *(const LAS f32x4*)(sq + F.tid * 4);
        const float rs = rsqrtf(((q4[0] + q4[1]) + (q4[2] + q4[3])) * (1.0f / D) + EPS); sq[512 + F.tid] = rs;
        const float* bias = (const float*)(F.ws + WS_RBIAS) + (l * NB + b) * NE;
        float lg[NE];
#pragma unroll
        for (int i = 0; i < 8; ++i) { const f32x4 c = *(const LAS f32x4*)(cx + F.tid * 32 + i * 4), bb = *(const f32x4*)(bias + i * 4);
            lg[4 * i] = c[0] * rs + bb[0]; lg[4 * i + 1] = c[1] * rs + bb[1]; lg[4 * i + 2] = c[2] * rs + bb[2]; lg[4 * i + 3] = c[3] * rs + bb[3]; }
        float tv[4]; int ti[4];
#pragma unroll
        for (int k = 0; k < 4; ++k) { float bv = lg[0]; int bi = 0;
#pragma unroll
            for (int e2 = 1; e2 < NE; ++e2) { if (lg[e2] > bv) { bv = lg[e2]; bi = e2; } }
            tv[k] = bv; ti[k] = bi;
#pragma unroll
            for (int e2 = 0; e2 < NE; ++e2) lg[e2] = (e2 == bi) ? -__builtin_inff() : lg[e2]; }
        const float e1 = __expf(tv[1] - tv[0]), e2 = __expf(tv[2] - tv[0]), e3 = __expf(tv[3] - tv[0]), inv = 1.0f / (1.0f + e1 + e2 + e3);
        *(f32x4*)(gate + (size_t)row * 4) = (f32x4){inv, e1 * inv, e2 * inv, e3 * inv};
        int4 tq, rq; tq.x = ti[0]; tq.y = ti[1]; tq.z = ti[2]; tq.w = ti[3];
        rq.x = __hip_atomic_fetch_add(&cnt[ti[0]], 1, __ATOMIC_RELAXED, __HIP_MEMORY_SCOPE_WORKGROUP); rq.y = __hip_atomic_fetch_add(&cnt[ti[1]], 1, __ATOMIC_RELAXED, __HIP_MEMORY_SCOPE_WORKGROUP);
        rq.z = __hip_atomic_fetch_add(&cnt[ti[2]], 1, __ATOMIC_RELAXED, __HIP_MEMORY_SCOPE_WORKGROUP); rq.w = __hip_atomic_fetch_add(&cnt[ti[3]], 1, __ATOMIC_RELAXED, __HIP_MEMORY_SCOPE_WORKGROUP);
        *(int4*)(topi + (size_t)row * 4) = tq; *(int4*)(rank + (size_t)row * 4) = rq;
    }
    __syncthreads();
    if (F.tid < NE) ((int*)(F.ws + WS_BLKCNT))[(l * 256 + F.blk) * NE + F.tid] = cnt[F.tid];
    { const float* g = GPTR(const float, A.in[I_N2G]) + l * D; f32x4 gv[4], sh[4], sc[4];
      row_ld16(g, F.lane, gv); row_ld16(modp(F, l, b, 3), F.lane, sh); row_ld16(modp(F, l, b, 4), F.lane, sc);
#pragma unroll
      for (int i = 0; i < 4; ++i) gv[i] = gv[i] * (sc[i] + 1.0f);
      for (int it = F.wave; it < ntok_blk; it += 2 * NWAVE) { const bool two = it + NWAVE < ntok_blk;
          u32x2 w0[4], w1[4];
#pragma unroll
          for (int i = 0; i < 4; ++i) { w0[i] = *(const u32x2*)(X + (size_t)(tok0 + it) * D + i * 256 + F.lane * 4); if (two) w1[i] = *(const u32x2*)(X + (size_t)(tok0 + it + NWAVE) * D + i * 256 + F.lane * 4); }
          const float r0 = sq[512 + it], r1 = two ? sq[512 + it + NWAVE] : 0.f;
          f32x4 v0[4], v1[4];
#pragma unroll
          for (int i = 0; i < 4; ++i) v0[i] = (f32x4){bflo(w0[i].x), bfhi(w0[i].x), bflo(w0[i].y), bfhi(w0[i].y)} * r0 * gv[i] + sh[i];
          row_st16_bf16(HA + (size_t)(tok0 + it) * D, F.lane, v0);
          if (two) {
#pragma unroll
              for (int i = 0; i < 4; ++i) v1[i] = (f32x4){bflo(w1[i].x), bfhi(w1[i].x), bflo(w1[i].y), bfhi(w1[i].y)} * r1 * gv[i] + sh[i];
              row_st16_bf16(HA + (size_t)(tok0 + it + NWAVE) * D, F.lane, v1); } } }
    __syncthreads();
}

__device__ __forceinline__ void ph_scatter(const Frame& F, int l) {
    LAS int* part = (LAS int*)F.lds;
    LAS int* basee = part + 1024;
    const int* bc = (const int*)(F.ws + WS_BLKCNT) + l * 256 * NE;
    { const int e = F.tid & 31, pt = F.tid >> 5; int pre = 0, tot = 0;
      for (int b = pt * 16; b < pt * 16 + 16 && b < F.G; ++b) { const int c = bc[b * NE + e]; tot += c; if (b < F.blk) pre += c; }
      part[pt * 32 + e] = pre; part[512 + pt * 32 + e] = tot; }
    __syncthreads();
    if (F.tid < NE) { int pre = 0, tot = 0;
        for (int pt = 0; pt < 16; ++pt) { pre += part[pt * 32 + F.tid]; tot += part[512 + pt * 32 + F.tid]; }
        part[F.tid] = pre; part[512 + F.tid] = tot; }
    __syncthreads();
    if (F.tid == 0) { int ps = 0; int* bexp = (int*)(F.ws + WS_BEXP) + l * 1024;
        for (int e = 0; e < NE; ++e) { const int padded = (part[512 + e] + EBLK - 1) / EBLK * EBLK; basee[e] = ps + part[e];
            if (F.blk == 0) for (int i = ps / EBLK; i < (ps + padded) / EBLK; ++i) bexp[1 + i] = e;
            ps += padded; }
        if (F.blk == 0) bexp[0] = ps / EBLK; }
    __syncthreads();
    const int* topi = (const int*)(F.ws + WS_TOPI); const int* rank = (const int*)(F.ws + WS_RANK); int* slot = (int*)(F.ws + WS_SLOT); int* rowtab = (int*)(F.ws + WS_ROWTAB);
    const int ntok_blk = NTOK / F.G;
    for (int it = F.tid; it < ntok_blk * 4 * 8; it += NTHR) {
        const int idx = F.blk * ntok_blk * 4 + (it >> 3), c8 = it & 7, s = basee[topi[idx]] + rank[idx];
        if (c8 == 0) slot[idx] = s;
        const int pm = s >> 8, r = s & 255, hh = r >> 7, R = r & 127, b = pg8::lds_byte(R, c8 * 8), pi = b >> 13, lt = (b & 8191) >> 4;
        rowtab[(((size_t)pm * 512 + lt) * 2 + hh) * 2 + pi] = idx >> 2;
    }
}

__device__ __forceinline__ void ph_combine(const Frame& F, int l) {
    const Args& A = *F.a; const bf16_t* X = (const bf16_t*)(F.ws + WS_X); bf16_t* XO = (bf16_t*)(F.ws + WS_X2); const bf16_t* Y = (const bf16_t*)(F.ws + WS_XG);
    const int* slot = (const int*)(F.ws + WS_SLOT); const float* gate = (const float*)(F.ws + WS_GATE);
    const int stride = F.G * NWAVE; int row = F.blk * NWAVE + F.wave;
    if (row >= NTOK) return;
    int4 sq_c = *(const int4*)(slot + (size_t)row * 4); f32x4 gq_c = *(const f32x4*)(gate + (size_t)row * 4);
    int4 sq_n = sq_c; f32x4 gq_n = gq_c;
    if (row + stride < NTOK) { sq_n = *(const int4*)(slot + (size_t)(row + stride) * 4); gq_n = *(const f32x4*)(gate + (size_t)(row + stride) * 4); }
    u32x4 yc[4][2], yn[4][2]; f32x4 xc[4], xn[4];
#define CMB_LOAD(yv, xq, sq, r_) do { const int ss_[4] = {sq.x, sq.y, sq.z, sq.w}; \
        _Pragma("unroll") for (int k = 0; k < 4; ++k) _Pragma("unroll") for (int i = 0; i < 2; ++i) yv[k][i] = *(const u32x4*)(Y + (size_t)ss_[k] * D + i * 512 + F.lane * 8); \
        _Pragma("unroll") for (int i = 0; i < 2; ++i) { const u32x4 xw_ = *(const u32x4*)(X + (size_t)(r_) * D + i * 512 + F.lane * 8); \
            xq[i * 2] = (f32x4){bflo(xw_.x), bfhi(xw_.x), bflo(xw_.y), bfhi(xw_.y)}; xq[i * 2 + 1] = (f32x4){bflo(xw_.z), bfhi(xw_.z), bflo(xw_.w), bfhi(xw_.w)}; } } while (0)
    CMB_LOAD(yc, xc, sq_c, row);
    for (; row < NTOK; row += stride) {
        const int b = row / SEQ; const bool has_n = row + stride < NTOK;
        const f32x4 gq = gq_c;
        if (has_n) CMB_LOAD(yn, xn, sq_n, row + stride);
        int4 sq_nn = sq_n; f32x4 gq_nn = gq_n;
        if (row + 2 * stride < NTOK) { sq_nn = *(const int4*)(slot + (size_t)(row + 2 * stride) * 4); gq_nn = *(const f32x4*)(gate + (size_t)(row + 2 * stride) * 4); }
        float acc[16];
#pragma unroll
        for (int i = 0; i < 16; ++i) acc[i] = 0.f;
#pragma unroll
        for (int k = 0; k < 4; ++k) { const float gk = gq[k];
#pragma unroll
            for (int i = 0; i < 2; ++i) { const u32x4 w = yc[k][i];
                acc[i * 8 + 0] += gk * bflo(w.x); acc[i * 8 + 1] += gk * bfhi(w.x); acc[i * 8 + 2] += gk * bflo(w.y); acc[i * 8 + 3] += gk * bfhi(w.y);
                acc[i * 8 + 4] += gk * bflo(w.z); acc[i * 8 + 5] += gk * bfhi(w.z); acc[i * 8 + 6] += gk * bflo(w.w); acc[i * 8 + 7] += gk * bfhi(w.w); } }
        const float* g2 = modp(F, l, b, 5);
        float xv[16]; float ssq = 0.f;
#pragma unroll
        for (int i = 0; i < 2; ++i)
#pragma unroll
            for (int h = 0; h < 2; ++h) { const int c = i * 512 + F.lane * 8 + h * 4; const f32x4 x0 = xc[i * 2 + h], gg = *(const f32x4*)(g2 + c);
#pragma unroll
                for (int j = 0; j < 4; ++j) { const float x = x0[j] + gg[j] * acc[i * 8 + h * 4 + j]; xv[i * 8 + h * 4 + j] = x; ssq += x * x; } }
        ssq = wave_sum(ssq); const float rs = rsqrtf(ssq * (1.0f / D) + EPS);
        if (l == 0) {
            bf16_t* HB = (bf16_t*)(F.ws + WS_HB); bf16_t* HA = (bf16_t*)(F.ws + WS_HA);
            const float* kvg = GPTR(const float, A.in[I_KVG]); const float* g1 = GPTR(const float, A.in[I_N1G]) + D; const float* sh = modp(F, 1, b, 0); const float* sc = modp(F, 1, b, 1);
#pragma unroll
            for (int i = 0; i < 2; ++i) { const int c = i * 512 + F.lane * 8; float o1[8], o2[8];
#pragma unroll
                for (int h = 0; h < 2; ++h) { const f32x4 kg = *(const f32x4*)(kvg + c + h * 4), gg = *(const f32x4*)(g1 + c + h * 4), s1 = *(const f32x4*)(sh + c + h * 4), s2 = *(const f32x4*)(sc + c + h * 4);
#pragma unroll
                    for (int j = 0; j < 4; ++j) { const float xh = xv[i * 8 + h * 4 + j] * rs; o1[h * 4 + j] = xh * kg[j]; o2[h * 4 + j] = xh * gg[j] * (s2[j] + 1.0f) + s1[j]; } }
                u32x4 w1, w2; w1.x = cvt_pk_bf16(o1[0], o1[1]); w1.y = cvt_pk_bf16(o1[2], o1[3]); w1.z = cvt_pk_bf16(o1[4], o1[5]); w1.w = cvt_pk_bf16(o1[6], o1[7]);
                w2.x = cvt_pk_bf16(o2[0], o2[1]); w2.y = cvt_pk_bf16(o2[2], o2[3]); w2.z = cvt_pk_bf16(o2[4], o2[5]); w2.w = cvt_pk_bf16(o2[6], o2[7]);
                u32x4 w0; w0.x = cvt_pk_bf16(xv[i * 8], xv[i * 8 + 1]); w0.y = cvt_pk_bf16(xv[i * 8 + 2], xv[i * 8 + 3]); w0.z = cvt_pk_bf16(xv[i * 8 + 4], xv[i * 8 + 5]); w0.w = cvt_pk_bf16(xv[i * 8 + 6], xv[i * 8 + 7]);
                *(u32x4*)(XO + (size_t)row * D + c) = w0; *(u32x4*)(HB + (size_t)row * D + c) = w1; *(u32x4*)(HA + (size_t)row * D + c) = w2; }
        } else {
            const float* fg = GPTR(const float, A.in[I_FG]);
#pragma unroll
            for (int i = 0; i < 2; ++i)
#pragma unroll
                for (int h = 0; h < 2; ++h) { const int c = i * 512 + F.lane * 8 + h * 4; const f32x4 gg = *(const f32x4*)(fg + c);
                    *(f32x4*)(GPTR(float, A.out) + (size_t)row * D + c) = (f32x4){xv[i * 8 + h * 4] * rs * gg[0], xv[i * 8 + h * 4 + 1] * rs * gg[1], xv[i * 8 + h * 4 + 2] * rs * gg[2], xv[i * 8 + h * 4 + 3] * rs * gg[3]}; }
        }
#pragma unroll
        for (int k = 0; k < 4; ++k) { yc[k][0] = yn[k][0]; yc[k][1] = yn[k][1]; xc[k] = xn[k]; }
        sq_c = sq_n; gq_c = gq_n; sq_n = sq_nn; gq_n = gq_nn;
    }
#undef CMB_LOAD
}

__device__ __forceinline__ void ph_latpost(const Frame& F) {
    const Args& A = *F.a; const float* LAT = (const float*)(F.ws + WS_LAT); const float* CQP = (const float*)(F.ws + WS_CQP);
    bf16_t* CKV = (bf16_t*)(F.ws + WS_CKV); bf16_t* KR = (bf16_t*)(F.ws + WS_KR); bf16_t* CQ = (bf16_t*)(F.ws + WS_CQ); const f32x2* cs = (const f32x2*)(F.ws + WS_CS);
    for (int row = F.blk * NWAVE + F.wave; row < NTOK; row += F.G * NWAVE) {
        const float* lr = LAT + (size_t)row * 512;
        { const f32x4 v = *(const f32x4*)(lr + F.lane * 4), g = *(const f32x4*)(GPTR(const float, A.in[I_CKVG]) + F.lane * 4);
          float s = wave_sum(v[0] * v[0] + v[1] * v[1] + v[2] * v[2] + v[3] * v[3]); const float rs = rsqrtf(s * (1.0f / KVLORA) + EPS);
          u32x2 w; w.x = cvt_pk_bf16(v[0] * rs * g[0], v[1] * rs * g[1]); w.y = cvt_pk_bf16(v[2] * rs * g[2], v[3] * rs * g[3]); *(u32x2*)(CKV + (size_t)row * KVLORA + F.lane * 4) = w; }
        if (F.lane < 32) { const int i = F.lane; const float x1 = lr[KVLORA + i], x2 = lr[KVLORA + 32 + i]; const f32x2 t = cs[(size_t)row * 32 + i];
          const float r1 = x1 * t[0] - x2 * t[1], r2 = x2 * t[0] + x1 * t[1]; const int p = (i >> 2) * 8 + (i & 3);
          KR[(size_t)row * DROPE + p] = (bf16_t)(cvt_pk_bf16(r1, r1) & 0xffffu); KR[(size_t)row * DROPE + p + 4] = (bf16_t)(cvt_pk_bf16(r2, r2) & 0xffffu); }
        { const float* qr = CQP + (size_t)row * 512; f32x2 v[3]; float s = 0.f;
#pragma unroll
          for (int i = 0; i < 3; ++i) { v[i] = *(const f32x2*)(qr + i * 128 + F.lane * 2); s += v[i][0] * v[i][0] + v[i][1] * v[i][1]; }
          s = wave_sum(s); const float rs = rsqrtf(s * (1.0f / QLORA) + EPS);
#pragma unroll
          for (int i = 0; i < 3; ++i) { const f32x2 g = *(const f32x2*)(GPTR(const float, A.in[I_CQG]) + i * 128 + F.lane * 2);
              *(unsigned*)(CQ + (size_t)row * QLORA + i * 128 + F.lane * 2) = cvt_pk_bf16(v[i][0] * rs * g[0], v[i][1] * rs * g[1]); } }
    }
}
constexpr int AT_KB = 24576, AT_VB0 = 49152, AT_VB = 16384;
#define AT_UPTR(p) ({ const GAS char* p_ = (const GAS char*)(p); asm volatile("" : "+s"(p_)); p_; })
#define AT_BAR() do { asm volatile("s_waitcnt lgkmcnt(0)" ::: "memory"); __builtin_amdgcn_s_barrier(); asm volatile("" ::: "memory"); } while (0)
#define AT_SB() __builtin_amdgcn_sched_barrier(0x6)
__device__ __forceinline__ void at_glds16(unsigned voff, const GAS char* sbase, unsigned lds_dst) {
    unsigned keep;
    asm volatile("s_mov_b32 %0, m0\n\ts_mov_b32 m0, %3\n\ts_nop 0\n\tglobal_load_lds_dwordx4 %1, %2\n\ts_mov_b32 m0, %0" : "=&s"(keep) : "v"(voff), "s"(sbase), "s"(lds_dst) : "memory");
}
#define AT_GLDS(sbase, voff, dstoff) at_glds16((voff), (sbase), ldsb_ + (unsigned)(dstoff))

__device__ __forceinline__ int swap23(int k) { return (k & ~0xC) | ((k & 4) << 1) | ((k & 8) >> 1); }

#if !NAIVE_ATTN
template <int VAR>
__device__ __forceinline__ void ph_attn(const Frame& F) {
    const char* Qg = (const char*)(F.ws + WS_Q); const char* KNg = (const char*)(F.ws + WS_KN); const char* KRg = (const char*)(F.ws + WS_KR); const char* VTg = (const char*)(F.ws + WS_VT);
    bf16_t* Og = (bf16_t*)(F.ws + (VAR == 0 ? WS_HC : WS_HB));
    const int lane = F.lane, w = F.wave, r32 = lane & 31, hi = lane >> 5;
    const unsigned ldsb_ = (unsigned)(size_t)F.lds;
    unsigned offK[3], offVt[2];
#pragma unroll
    for (int i = 0; i < 3; ++i) { const int g = (i * 8 + w) * 64 + lane, d0 = g >> 7, rho = (g & 127) >> 1, hh = (g & 1) ^ ((rho >> 3) & 1), key = swap23(rho);
        offK[i] = d0 < 8 ? (unsigned)key * 2048u + (unsigned)(d0 * 32 + hh * 16) : (unsigned)key * 128u + (unsigned)((d0 - 8) * 32 + hh * 16); }
#pragma unroll
    for (int i = 0; i < 2; ++i) { const int g = (i * 8 + w) * 64 + lane, ks = g >> 8, d = (g & 255) >> 1, hh = (g & 1) ^ ((d >> 3) & 1);
        offVt[i] = (unsigned)d * (unsigned)(NTOK * 2) + (unsigned)(ks * 32 + hh * 16); }
    const int rdoff = r32 * 32 + ((hi ^ ((r32 >> 3) & 1)) << 4);
    for (int item = F.blk; item < 512; item += F.G) {
        const int xcd = item & 7, kk = item >> 3, bh = xcd * 4 + (kk >> 4), x = kk & 15, b = bh >> 3, h = bh & 7;
#pragma unroll 1
        for (int pass = 0; pass < 2; ++pass) {
            const int j = pass ? 31 - x : x, NT = 4 * j + 4, cw = 4 * j + (w >> 1);
            const size_t tokb = (size_t)b * SEQ;
            const char* knb = KNg + tokb * 2048 + h * 256; const char* krb = KRg + tokb * 128; const char* vtb = VTg + ((size_t)h * 128 * NTOK + tokb) * 2;
            bf16x8 qr[12];
            { const GAS char* qp = AT_UPTR(Qg + (tokb + (size_t)j * 256 + w * 32) * (NH * DQK * 2) + h * (DQK * 2)) + (unsigned)(r32 * (NH * DQK * 2) + hi * 16);
#pragma unroll
              for (int d0 = 0; d0 < 12; ++d0) qr[d0] = *(const bf16x8*)(qp + d0 * 32);
              const float* csr = (const float*)(AT_UPTR((const float*)(F.ws + WS_CS) + (tokb + (size_t)j * 256 + w * 32) * 64) + (unsigned)(r32 * 256));
#pragma unroll
              for (int dd = 0; dd < 4; ++dd) { const int k4 = (dd * 2 + hi) * 4; const f32x4 t0 = *(const f32x4*)(csr + 2 * k4), t1 = *(const f32x4*)(csr + 2 * k4 + 4);
                  const u32x4 wq = *(const u32x4*)&qr[8 + dd];
                  const float x1[4] = {bflo(wq.x), bfhi(wq.x), bflo(wq.y), bfhi(wq.y)}, x2[4] = {bflo(wq.z), bfhi(wq.z), bflo(wq.w), bfhi(wq.w)};
                  const float co[4] = {t0[0], t0[2], t1[0], t1[2]}, si[4] = {t0[1], t0[3], t1[1], t1[3]}; float r1[4], r2[4];
#pragma unroll
                  for (int jj = 0; jj < 4; ++jj) { r1[jj] = x1[jj] * co[jj] - x2[jj] * si[jj]; r2[jj] = x2[jj] * co[jj] + x1[jj] * si[jj]; }
                  u32x4 wo = {cvt_pk_bf16(r1[0], r1[1]), cvt_pk_bf16(r1[2], r1[3]), cvt_pk_bf16(r2[0], r2[1]), cvt_pk_bf16(r2[2], r2[3])}; qr[8 + dd] = *(bf16x8*)&wo; } }
            f32x16 o[4];
#pragma unroll
            for (int d0 = 0; d0 < 4; ++d0)
#pragma unroll
                for (int r = 0; r < 16; ++r) o[d0][r] = 0.f;
            float m_run = -1e30f, l_run = 0.f;
#define AT_ISSUE_K(t, st) do { const int t_ = (t); \
                const GAS char* kp_ = AT_UPTR(knb + (size_t)t_ * (64 * 2048)); const GAS char* rp_ = AT_UPTR(krb + (size_t)t_ * (64 * 128)); \
                AT_GLDS(kp_, offK[0], (st) + w * 1024); AT_GLDS(kp_, offK[1], (st) + (8 + w) * 1024); \
                AT_GLDS(rp_, offK[2], (st) + (16 + w) * 1024); } while (0)
#define AT_ISSUE_V(t, st) do { const int t_ = (t); \
                const GAS char* vp_ = AT_UPTR(vtb + (size_t)t_ * 128); \
                AT_GLDS(vp_, offVt[0], AT_VB0 + (st) + w * 1024); AT_GLDS(vp_, offVt[1], AT_VB0 + (st) + (8 + w) * 1024); } while (0)
#define AT_DSRD(dst, ad, off) asm volatile("ds_read_b128 %0, %1 offset:%2" : "=v"(dst) : "v"(ad), "i"(off))
#define AT_LGKM(n) asm volatile("s_waitcnt lgkmcnt(%0)" :: "i"(n))
#define AT_SB0() __builtin_amdgcn_sched_barrier(0)
#define AT_KR(d_, x0, x1) do { AT_DSRD(x0, kad_, (d_) * 2048); AT_DSRD(x1, kad_, (d_) * 2048 + 1024); } while (0)
#define AT_MM(x0, x1, q_, PN0, PN1) do { AT_SB0(); __builtin_amdgcn_s_setprio(1); PN0 = __builtin_amdgcn_mfma_f32_32x32x16_bf16(x0, q_, PN0, 0, 0, 0); PN1 = __builtin_amdgcn_mfma_f32_32x32x16_bf16(x1, q_, PN1, 0, 0, 0); __builtin_amdgcn_s_setprio(0); AT_SB0(); } while (0)
#define AT_E1(PC0, PC1, e_) do { if ((e_) < 16) { PC0[(e_) & 15] = __builtin_amdgcn_exp2f(PC0[(e_) & 15] - m_run); ps_ += PC0[(e_) & 15]; } else if ((e_) < 32) { PC1[(e_) & 15] = __builtin_amdgcn_exp2f(PC1[(e_) & 15] - m_run); ps_ += PC1[(e_) & 15]; } } while (0)
#define AT_EX(PC0, PC1, i_) do { if (SM) { AT_E1(PC0, PC1, 3 * (i_)); AT_E1(PC0, PC1, 3 * (i_) + 1); AT_E1(PC0, PC1, 3 * (i_) + 2); } } while (0)
#define AT_QKX(st, P0, P1) do { \
                const unsigned kad_ = (unsigned)(size_t)((const LAS char*)F.lds + (st) + rdoff); \
                bf16x8 ka0, ka1, kb0, kb1, kc0, kc1; \
                AT_KR(0, ka0, ka1); AT_KR(1, kb0, kb1); \
                _Pragma("unroll") for (int r = 0; r < 16; ++r) { P0[r] = 0.f; P1[r] = 0.f; } \
                AT_KR(2, kc0, kc1); AT_LGKM(4); AT_MM(ka0, ka1, qr[0], P0, P1); \
                AT_KR(3, ka0, ka1); AT_LGKM(4); AT_MM(kb0, kb1, qr[1], P0, P1); \
                AT_KR(4, kb0, kb1); AT_LGKM(4); AT_MM(kc0, kc1, qr[2], P0, P1); \
                AT_KR(5, kc0, kc1); AT_LGKM(4); AT_MM(ka0, ka1, qr[3], P0, P1); \
                AT_KR(6, ka0, ka1); AT_LGKM(4); AT_MM(kb0, kb1, qr[4], P0, P1); \
                AT_KR(7, kb0, kb1); AT_LGKM(4); AT_MM(kc0, kc1, qr[5], P0, P1); \
                AT_KR(8, kc0, kc1); AT_LGKM(4); AT_MM(ka0, ka1, qr[6], P0, P1); \
                AT_KR(9, ka0, ka1); AT_LGKM(4); AT_MM(kb0, kb1, qr[7], P0, P1); \
                AT_KR(10, kb0, kb1); AT_LGKM(4); AT_MM(kc0, kc1, qr[8], P0, P1); \
                AT_KR(11, kc0, kc1); AT_LGKM(4); AT_MM(ka0, ka1, qr[9], P0, P1); \
                AT_LGKM(2); AT_MM(kb0, kb1, qr[10], P0, P1); \
                AT_LGKM(0); AT_MM(kc0, kc1, qr[11], P0, P1); } while (0)
#define AT_VR(ks_, v0, v1, v2, v3) do { AT_DSRD(v0, vad_, (ks_) * 4096); AT_DSRD(v1, vad_, (ks_) * 4096 + 1024); AT_DSRD(v2, vad_, (ks_) * 4096 + 2048); AT_DSRD(v3, vad_, (ks_) * 4096 + 3072); } while (0)
#define AT_PF(PX, b8) ({ u32x4 tp_ = {cvt_pk_bf16(PX[b8], PX[b8 + 1]), cvt_pk_bf16(PX[b8 + 2], PX[b8 + 3]), cvt_pk_bf16(PX[b8 + 4], PX[b8 + 5]), cvt_pk_bf16(PX[b8 + 6], PX[b8 + 7])}; *(bf16x8*)&tp_; })
#define AT_M4(pf_, v0, v1, v2, v3) do { AT_SB0(); __builtin_amdgcn_s_setprio(1); o[0] = __builtin_amdgcn_mfma_f32_32x32x16_bf16(v0, pf_, o[0], 0, 0, 0); o[1] = __builtin_amdgcn_mfma_f32_32x32x16_bf16(v1, pf_, o[1], 0, 0, 0); \
                o[2] = __builtin_amdgcn_mfma_f32_32x32x16_bf16(v2, pf_, o[2], 0, 0, 0); o[3] = __builtin_amdgcn_mfma_f32_32x32x16_bf16(v3, pf_, o[3], 0, 0, 0); __builtin_amdgcn_s_setprio(0); AT_SB0(); } while (0)
#define AT_MX8(PX, b8) do { _Pragma("unroll") for (int r = 0; r < 8; ++r) mxn_ = fmaxf(mxn_, PX[(b8) + r]); } while (0)
#define AT_PVX(st, PC0, PC1) do { const unsigned vad_ = (unsigned)(size_t)((const LAS char*)F.lds + AT_VB0 + (st) + rdoff); \
                bf16x8 va0, va1, va2, va3, vb0, vb1, vb2, vb3, pf_; \
                AT_VR(0, va0, va1, va2, va3); AT_VR(1, vb0, vb1, vb2, vb3); pf_ = AT_PF(PC0, 0); AT_LGKM(4); AT_M4(pf_, va0, va1, va2, va3); \
                AT_VR(2, va0, va1, va2, va3); pf_ = AT_PF(PC0, 8); AT_LGKM(4); AT_M4(pf_, vb0, vb1, vb2, vb3); \
                AT_VR(3, vb0, vb1, vb2, vb3); pf_ = AT_PF(PC1, 0); AT_LGKM(4); AT_M4(pf_, va0, va1, va2, va3); \
                pf_ = AT_PF(PC1, 8); AT_LGKM(0); AT_M4(pf_, vb0, vb1, vb2, vb3); } while (0)
#define AT_SMAX(P0, P1) do { \
                float mx = P0[0]; _Pragma("unroll") for (int r = 1; r < 16; ++r) mx = fmaxf(mx, P0[r]); _Pragma("unroll") for (int r = 0; r < 16; ++r) mx = fmaxf(mx, P1[r]); \
                mx = fmaxf(mx, __shfl_xor(mx, 32)); \
                if (!__all(mx - m_run <= 11.0f)) { const float mn = fmaxf(m_run, mx), al = __builtin_amdgcn_exp2f(m_run - mn); m_run = mn; l_run *= al; \
                    _Pragma("unroll") for (int d0 = 0; d0 < 4; ++d0) _Pragma("unroll") for (int r = 0; r < 16; ++r) o[d0][r] *= al; } } while (0)
#define AT_SEXP(P0, P1) do { \
                float ps = 0.f; \
                _Pragma("unroll") for (int r = 0; r < 16; ++r) { P0[r] = __builtin_amdgcn_exp2f(P0[r] - m_run); P1[r] = __builtin_amdgcn_exp2f(P1[r] - m_run); ps += P0[r] + P1[r]; } \
                l_run += ps; } while (0)
#define AT_STEP(t, st) do { \
                if (VAR != 1 && VAR != 6 && VAR != 7 && (t) + 1 < NT) { AT_ISSUE_K((t) + 1, (1 - (st)) * AT_KB); AT_ISSUE_V((t) + 1, (1 - (st)) * AT_VB); } \
                if (VAR != 2 && (t) <= cw) { f32x16 p0, p1; if (VAR != 5 && VAR != 7) AT_QKX((st) * AT_KB, p0, p1); else { _Pragma("unroll") for (int r = 0; r < 16; ++r) { p0[r] = m_run; p1[r] = l_run; } } \
                    if (VAR == 0 || VAR == 1) { AT_SMAX(p0, p1); AT_SEXP(p0, p1); } if (VAR != 4 && VAR != 6) AT_PVX((st) * AT_VB, p0, p1); else { m_run += p0[3] + p1[5]; } } \
                asm volatile("s_waitcnt vmcnt(0)" ::: "memory"); AT_BAR(); } while (0)
            AT_ISSUE_K(0, 0); AT_ISSUE_V(0, 0);
            asm volatile("s_waitcnt vmcnt(0)" ::: "memory"); AT_BAR();
#pragma unroll 1
            for (int t = 0; t < NT; t += 2) {
                AT_STEP(t, 0);
                AT_STEP(t + 1, 1);
            }
#undef AT_ISSUE_K
#undef AT_ISSUE_V
#undef AT_STEP
            const float lt = l_run + __shfl_xor(l_run, 32), inv = 1.0f / lt;
            bf16_t* op = (bf16_t*)(AT_UPTR(Og + (tokb + (size_t)j * 256 + w * 32) * D + h * DV) + (unsigned)(r32 * (D * 2) + 8 * hi));
#pragma unroll
            for (int d0 = 0; d0 < 4; ++d0)
#pragma unroll
                for (int g4 = 0; g4 < 4; ++g4) { u32x2 wv; wv.x = cvt_pk_bf16(o[d0][4 * g4] * inv, o[d0][4 * g4 + 1] * inv); wv.y = cvt_pk_bf16(o[d0][4 * g4 + 2] * inv, o[d0][4 * g4 + 3] * inv);
                    *(u32x2*)(op + d0 * 32 + 8 * g4) = wv; }
        }
    }
}
#else
template <int VAR>
__device__ __forceinline__ void ph_attn(const Frame& F) {
    const bf16_t* Qg = (const bf16_t*)(F.ws + WS_Q); const bf16_t* KNg = (const bf16_t*)(F.ws + WS_KN); const bf16_t* KRg = (const bf16_t*)(F.ws + WS_KR); const bf16_t* VTg = (const bf16_t*)(F.ws + WS_VT);
    bf16_t* Og = (bf16_t*)(F.ws + WS_HC);
    for (int it = F.blk * NWAVE + F.wave; it < NTOK * NH; it += F.G * NWAVE) {
        const int n = it >> 3, h = it & 7, b = n / SEQ, s = n - b * SEQ, nkb = s / 64 + 1; const size_t tokb = (size_t)b * SEQ;
        const bf16_t* q = Qg + (size_t)n * (NH * DQK) + h * DQK;
        float m = -1e30f, l = 0.f, o0 = 0.f, o1 = 0.f;
        for (int kb = 0; kb < nkb; ++kb) {
            const size_t key = tokb + kb * 64 + F.lane; float sc = 0.f;
            for (int d = 0; d < DNOPE; d += 8) { const u32x4 kv = *(const u32x4*)(KNg + key * D + h * DNOPE + d), qv = *(const u32x4*)(q + d);
                sc += bflo(kv.x) * bflo(qv.x) + bfhi(kv.x) * bfhi(qv.x) + bflo(kv.y) * bflo(qv.y) + bfhi(kv.y) * bfhi(qv.y) + bflo(kv.z) * bflo(qv.z) + bfhi(kv.z) * bfhi(qv.z) + bflo(kv.w) * bflo(qv.w) + bfhi(kv.w) * bfhi(qv.w); }
            for (int d = 0; d < DROPE; d += 8) { const u32x4 kv = *(const u32x4*)(KRg + key * DROPE + d), qv = *(const u32x4*)(q + DNOPE + d);
                sc += bflo(kv.x) * bflo(qv.x) + bfhi(kv.x) * bfhi(qv.x) + bflo(kv.y) * bflo(qv.y) + bfhi(kv.y) * bfhi(qv.y) + bflo(kv.z) * bflo(qv.z) + bfhi(kv.z) * bfhi(qv.z) + bflo(kv.w) * bflo(qv.w) + bfhi(kv.w) * bfhi(qv.w); }
            float mx = sc;
#pragma unroll
            for (int of = 32; of >= 1; of >>= 1) mx = fmaxf(mx, __shfl_xor(mx, of));
            const float mn = fmaxf(m, mx), al = exp2f(m - mn), p = exp2f(sc - mn); m = mn;
            l = l * al + wave_sum(p); o0 *= al; o1 *= al;
            for (int d = 0; d < DV; ++d) { const float v = bf2f(VTg[(size_t)(h * DV + d) * NTOK + key]); const float tot = wave_sum(p * v);
                if (F.lane == (d & 63)) { if (d < 64) o0 += tot; else o1 += tot; } }
        }
        const float inv = 1.0f / l;
        Og[(size_t)n * D + h * DV + F.lane] = (bf16_t)(cvt_pk_bf16(o0 * inv, 0.f) & 0xffffu);
        Og[(size_t)n * D + h * DV + 64 + F.lane] = (bf16_t)(cvt_pk_bf16(o1 * inv, 0.f) & 0xffffu);
    }
}
#endif
constexpr int NPH = 20;
__global__ void __launch_bounds__(NTHR, 2) yoco_fwd(Args args) {
    extern __shared__ __attribute__((aligned(16))) unsigned char lds_raw[];
    Frame F; F.lds = (LAS unsigned char*)lds_raw; F.ws = (GAS unsigned char*)args.ws; F.a = &args;
    F.tid = threadIdx.x; F.lane = F.tid & 63; F.wave = __builtin_amdgcn_readfirstlane(F.tid >> 6); F.G = gridDim.x; F.blk = blockIdx.x;
    volatile LAS unsigned* misc = (volatile LAS unsigned*)(F.lds + LDS_MISC);
    if (F.tid < 16) misc[F.tid] = 0u;
    __syncthreads();
    const int lo = args.ph_lo, hi = args.ph_hi;
    XcdBarrier bar; bar.bar = (unsigned*)(F.ws + WS_CTL); bar.x = 0; bar.st = misc;
    if (hi - lo > 1) bar = xcd_barrier_post((unsigned*)(F.ws + WS_CTL), misc);
#ifndef PH_MASK
#define PH_MASK 0xFFFFFu
#endif
#define IN(k) (((PH_MASK >> ((k) % 20 >= 15 ? (k) - 10 : (k))) & 1u) && lo <= (k) && (k) < hi)
#define FRESH() do { F.tid = threadIdx.x; asm volatile("" : "+v"(F.tid)); F.lane = F.tid & 63; F.wave = __builtin_amdgcn_readfirstlane(F.tid >> 6); F.ws = (GAS unsigned char*)args.ws; asm volatile("" : "+s"(F.ws)); } while (0)
#ifndef REPEAT_MASK
#define REPEAT_MASK 0u
#endif
#define PHBIT(k) ((k) >= 15 ? (k) - 10 : (k))
#define REPEAT(k) _Pragma("unroll 1") for (int rep_ = 0, nrep_ = ((REPEAT_MASK >> PHBIT(k)) & 1u) ? 2 : 1; rep_ < nrep_; ++rep_, (void)((rep_ < nrep_) ? (xcd_barrier(bar), 0) : 0))
#define SEAM(k) do { if (IN(k) && IN((k) + 1)) xcd_barrier(bar); } while (0)
    LAS unsigned char* stage = F.lds;
#define MOD ((const float*)(F.ws + WS_MOD))

    if (IN(0)) REPEAT(0) { FRESH(); ph_prologue(F); } SEAM(0);
    if (IN(1)) REPEAT(1) { FRESH(); ph_norm1(F); ph_router_prep(F); } SEAM(1);
    if (IN(2)) REPEAT(2) { FRESH();
        pg8::Gemm g{(const bf16_t*)(F.ws + WS_HA), (const bf16_t*)(F.ws + WS_WPW1), NTOK, 2 * D, D}; pg8::StaticOrder S; S.init(NTOK, 2 * D, F.G, F.blk);
        pg8::EpiGated<0> E{(bf16_t*)(F.ws + WS_HB), D, GPTR(const float, args.in[I_PW1B]), D, nullptr};
        GEMM_PHASE<pg8::EpiGated<0>, pg8::StaticOrder>(stage, g, S, E);
    } SEAM(2);
    if (IN(3)) REPEAT(3) { FRESH(); ph_conv(F); } SEAM(3);
    if (IN(4)) REPEAT(4) { FRESH();
        pg8::Gemm g{(const bf16_t*)(F.ws + WS_HC), (const bf16_t*)(F.ws + WS_WPW2), NTOK, D, D}; pg8::StaticOrder S; S.init(NTOK, D, F.G, F.blk);
        pg8::EpiResidB<false> E{GPTR(const float, args.in[I_X]), (bf16_t*)(F.ws + WS_X), GPTR(const float, args.in[I_PW2B]), MOD + 2 * D};
        GEMM_PHASE<pg8::EpiResidB<false>, pg8::StaticOrder>(stage, g, S, E);
    } SEAM(4);
#pragma unroll 1
    for (int l = 0; l < 2; ++l) {
        const int pb = 5 + 10 * l;
        if (IN(pb)) REPEAT(pb) { FRESH(); ph_router(F, l); } SEAM(pb);
        if (IN(pb + 1)) REPEAT(pb + 1) { FRESH(); ph_scatter(F, l); } SEAM(pb + 1);
        const int* bexp = (const int*)(F.ws + WS_BEXP) + l * 1024;
        const LAS int* lbexp = (const LAS int*)(F.lds + 131072);
#define FILL_LBEXP(nb) do { for (int i_ = F.tid; i_ <= (nb); i_ += NTHR) ((LAS int*)(F.lds + 131072))[i_] = bexp[i_]; __syncthreads(); } while (0)
        if (IN(pb + 2)) REPEAT(pb + 2) { FRESH();
            const int nblk = __builtin_amdgcn_readfirstlane(bexp[0]); FILL_LBEXP(nblk);
            pg8::Gemm g{(const bf16_t*)(F.ws + WS_HA), (const bf16_t*)(F.ws + WS_WGU) + (size_t)l * NE * 2 * DE * D, nblk * 256, 2 * DE, D};
            pg8::MoeGatherOrder S; S.init(nblk * 256, 2 * DE, F.G, F.blk); S.bexp = lbexp; S.estride = (size_t)2 * DE * D * 2; S.rowtab = (const unsigned*)(F.ws + WS_ROWTAB); S.nrows_src = NTOK;
            pg8::EpiGated<1> E{(bf16_t*)(F.ws + WS_ACT), DE, GPTR(const float, args.in[I_BGU]) + (size_t)l * NE * 2 * DE, DE, lbexp};
            GEMM_PHASE<pg8::EpiGated<1>, pg8::MoeGatherOrder>(stage, g, S, E);
        } SEAM(pb + 2);
        if (IN(pb + 3)) REPEAT(pb + 3) { FRESH();
            const int nblk = __builtin_amdgcn_readfirstlane(bexp[0]); FILL_LBEXP(nblk);
            pg8::Gemm g{(const bf16_t*)(F.ws + WS_ACT), (const bf16_t*)(F.ws + WS_WDN) + (size_t)l * NE * DE * D, nblk * 256, D, DE};
            pg8::MoeOrder S; S.init(nblk * 256, D, F.G, F.blk); S.bexp = lbexp; S.estride = (size_t)DE * D * 2; S.rev = true;
            pg8::EpiBf16P E{(bf16_t*)(F.ws + WS_XG), D, GPTR(const float, args.in[I_BDN]) + (size_t)l * NE * D, D, lbexp};
            GEMM_PHASE<pg8::EpiBf16P, pg8::MoeOrder>(stage, g, S, E);
#ifdef MOE_PROBE
            xcd_barrier(bar); FRESH(); { const int nb2 = __builtin_amdgcn_readfirstlane(bexp[0]); FILL_LBEXP(nb2);
              pg8::Gemm g2{(const bf16_t*)(F.ws + WS_ACT), (const bf16_t*)(F.ws + WS_WDN) + (size_t)l * NE * DE * D, nb2 * 256, D, DE};
              pg8::MoeOrder S2; S2.init(nb2 * 256, D, F.G, F.blk); S2.bexp = lbexp; S2.estride = (size_t)DE * D * 2; S2.rev = true; S2.same = (MOE_PROBE == 2);
              pg8::EpiBf16P E2{(bf16_t*)(F.ws + WS_HB), D, MOE_PROBE == 4 ? nullptr : GPTR(const float, args.in[I_BDN]) + (size_t)l * NE * D, D, lbexp, MOE_PROBE == 1 ? 1 : MOE_PROBE == 3 ? 3 : 2};
              GEMM_PHASE<pg8::EpiBf16P, pg8::MoeOrder>(stage, g2, S2, E2); }
#endif
        } SEAM(pb + 3);
        if (IN(pb + 4)) REPEAT(pb + 4) { FRESH(); ph_combine(F, l); } SEAM(pb + 4);
        if (l == 0) {
            if (IN(10)) REPEAT(10) { FRESH();
#pragma unroll 1
                for (int gi = 0; gi < 2; ++gi) {
                    pg8::Gemm g{(const bf16_t*)(F.ws + (gi ? WS_HA : WS_HB)), (const bf16_t*)(F.ws + (gi ? WS_WDQ : WS_WDKV)), NTOK, 512, D}; pg8::StaticOrder S; S.init(NTOK, 512, F.G, F.blk);
                    pg8::EpiLatQ E{(bf16_t*)(F.ws + (gi ? WS_CQ : WS_CKV)), gi ? QLORA : KVLORA, gi ? QLORA : KVLORA, gi ? (bf16_t*)nullptr : (bf16_t*)(F.ws + WS_KR), (const f32x2*)(F.ws + WS_CS), (float*)(F.ws + (gi ? WS_SSPQ : WS_SSPKV))};
                    GEMM_PHASE<pg8::EpiLatQ, pg8::StaticOrder>(stage, g, S, E);
                    __syncthreads(); }
            } do { if (IN(10) && IN(12)) xcd_barrier(bar); } while (0);
            if (IN(12)) REPEAT(12) { FRESH();
#pragma unroll 1
                for (int gi = 0; gi < 3; ++gi) {
                    pg8::Gemm g{(const bf16_t*)(F.ws + (gi == 0 ? WS_CKV : gi == 1 ? WS_WUV : WS_CQ)), (const bf16_t*)(F.ws + (gi == 0 ? WS_WUK : gi == 1 ? WS_CKV : WS_WUQ)),
                                gi == 1 ? D : NTOK, gi == 0 ? D : gi == 1 ? NTOK : NH * DQK, gi == 2 ? QLORA : KVLORA};
                    pg8::StaticOrder S; S.init(g.M, g.N, F.G, F.blk);
                    pg8::EpiScaled E{(bf16_t*)(F.ws + (gi == 0 ? WS_KN : gi == 1 ? WS_VT : WS_Q)), g.N, (const float*)(F.ws + (gi == 2 ? WS_SSPQ : WS_SSPKV)), gi == 1 ? 1 : 0, gi == 2 ? 8 : 4, gi == 2 ? 1.0f / QLORA : 1.0f / KVLORA};
                    GEMM_PHASE<pg8::EpiScaled, pg8::StaticOrder>(stage, g, S, E);
                    __syncthreads(); }
            } SEAM(12);
            if (IN(13)) REPEAT(13) { FRESH(); ph_attn<0>(F);
#ifdef ATTN_PROBE
                xcd_barrier(bar); FRESH(); ph_attn<ATTN_PROBE>(F);
#endif
            } SEAM(13);
            if (IN(14)) REPEAT(14) { FRESH();
                pg8::Gemm g{(const bf16_t*)(F.ws + WS_HC), (const bf16_t*)(F.ws + WS_WO), NTOK, D, D}; pg8::StaticOrder S; S.init(NTOK, D, F.G, F.blk);
                pg8::EpiResidB<true> E{(const bf16_t*)(F.ws + WS_X2), (bf16_t*)(F.ws + WS_X), nullptr, MOD + (size_t)NB * 6 * D + 2 * D};
                GEMM_PHASE<pg8::EpiResidB<true>, pg8::StaticOrder>(stage, g, S, E);
            } SEAM(14);
        }
    }
#undef IN
#undef SEAM
#undef MOD
#undef FRESH
}

extern "C" void kernel_launch(void* const* d_in, const int* in_sizes, int n_in, void* d_out, int out_size, void* d_ws, size_t ws_size, hipStream_t stream) {
    static int grid = 0;
    if (grid == 0) {
        if (n_in != 31 || out_size != NTOK * D || ws_size < WS_END) { fprintf(stderr, "kernel_launch: unexpected shapes (n_in %d, out %d, ws %zu < %zu)\n", n_in, out_size, ws_size, (size_t)WS_END); grid = -1; return; }
        int dev = 0, cus = 0, per_cu = 0;
        if (hipGetDevice(&dev) != hipSuccess || hipDeviceGetAttribute(&cus, hipDeviceAttributeMultiprocessorCount, dev) != hipSuccess) { grid = -1; return; }
        if (hipFuncSetAttribute((const void*)yoco_fwd, hipFuncAttributeMaxDynamicSharedMemorySize, LDS_BYTES) != hipSuccess) { fprintf(stderr, "kernel_launch: hipFuncSetAttribute failed\n"); grid = -1; return; }
        if (hipOccupancyMaxActiveBlocksPerMultiprocessor(&per_cu, (const void*)yoco_fwd, NTHR, LDS_BYTES) != hipSuccess || per_cu < 1) fprintf(stderr, "kernel_launch: occupancy query says %d\n", per_cu);
        (void)hipGetLastError();
        grid = cus;
        if (grid != 256) fprintf(stderr, "kernel_launch: %d CUs (built for 256)\n", grid);
        if (grid > 256) grid = 256;
    }
    if (grid < 0) return;
    (void)hipMemsetAsync((char*)d_ws + WS_CTL, 0, XCD_BAR_WORDS * sizeof(unsigned), stream);
    Args a{};
    for (int i = 0; i < 31; ++i) a.in[i] = (const float*)d_in[i];
    a.out = (float*)d_out; a.ws = (unsigned char*)d_ws;
#if N_LAUNCH_MODE == 1
    a.ph_lo = 0; a.ph_hi = NPH;
    hipLaunchKernelGGL(yoco_fwd, dim3(grid), dim3(NTHR), LDS_BYTES, stream, a);
#else
    for (int p = 0; p < NPH; ++p) { a.ph_lo = p; a.ph_hi = p + 1; hipLaunchKernelGGL(yoco_fwd, dim3(grid), dim3(NTHR), LDS_BYTES, stream, a); }
#endif
}
```

```cpp
#include <hip/hip_runtime.h>
#include <cstdio>
#include <cstdint>

#ifndef N_LAUNCH_MODE
#define N_LAUNCH_MODE 1
#endif
#ifndef NAIVE_GEMM
#define NAIVE_GEMM 0
#endif
#ifndef NAIVE_ATTN
#define NAIVE_ATTN 0
#endif

#define LAS __attribute__((address_space(3)))
#define GAS __attribute__((address_space(1)))
__device__ __forceinline__ const void* assume_global_(const void* p) {
#if defined(__HIP_DEVICE_COMPILE__)
    __builtin_assume(!__builtin_amdgcn_is_shared(p) && !__builtin_amdgcn_is_private(p));
#endif
    return p; }
#define GPTR(T, p) ((T*)assume_global_((const void*)(p)))
typedef unsigned short bf16_t;
typedef short bf16x8 __attribute__((ext_vector_type(8)));
typedef float f32x4 __attribute__((ext_vector_type(4)));
typedef float f32x2 __attribute__((ext_vector_type(2)));
typedef float f32x16 __attribute__((ext_vector_type(16)));
typedef unsigned u32x4 __attribute__((ext_vector_type(4)));
typedef unsigned u32x2 __attribute__((ext_vector_type(2)));

constexpr int D = 1024, NB = 4, SEQ = 8192, NTOK = NB * SEQ;
constexpr int CONVW = 31, NH = 8, DNOPE = 128, DROPE = 64, DQK = 192, DV = 128, QLORA = 384, KVLORA = 256;
constexpr int NE = 32, TOPK = 4, DE = 1024, EBLK = 256;
constexpr int NASSIGN = NTOK * TOPK;
constexpr int NROWS = ((NASSIGN + NE * (EBLK - 1) + EBLK - 1) / EBLK) * EBLK;
constexpr int MAXBLK = NROWS / EBLK;
constexpr float EPS = 1e-6f;
constexpr int NTHR = 512, NWAVE = 8;
constexpr int LDS_BYTES = 163840;
constexpr int LDS_MISC = 163328;

constexpr size_t MiB = (size_t)1 << 20;
constexpr size_t WS_CTL = 0;
constexpr size_t WS_BLKCNT = 64 * 1024;
constexpr size_t WS_BEXP = 192 * 1024;
constexpr size_t WS_MOD = 1 * MiB;
constexpr size_t WS_TOPI = 2 * MiB;
constexpr size_t WS_GATE = WS_TOPI + 512 * 1024;
constexpr size_t WS_RANK = WS_GATE + 512 * 1024;
constexpr size_t WS_SLOT = WS_RANK + 512 * 1024;
constexpr size_t WS_CS = 4 * MiB;
constexpr size_t WS_RWF = 12 * MiB;
constexpr size_t WS_RBIAS = 13 * MiB;
constexpr size_t WS_WPW1 = 16 * MiB;
constexpr size_t WS_WPW2 = WS_WPW1 + 4 * MiB;
constexpr size_t WS_WDKV = WS_WPW2 + 2 * MiB;
constexpr size_t WS_WDQ = WS_WDKV + 1 * MiB;
constexpr size_t WS_WUK = WS_WDQ + 1 * MiB;
constexpr size_t WS_WUV = WS_WUK + MiB / 2;
constexpr size_t WS_WUQ = WS_WUV + MiB / 2;
constexpr size_t WS_WO = WS_WUQ + 2 * MiB;
constexpr size_t WS_WGU = 32 * MiB;
constexpr size_t WS_WDN = WS_WGU + 256 * MiB;
constexpr size_t WS_X = WS_WDN + 128 * MiB;
constexpr size_t WS_HA = WS_X + 128 * MiB;
constexpr size_t WS_HB = WS_HA + 64 * MiB;
constexpr size_t WS_HC = WS_HB + 64 * MiB;
constexpr size_t WS_XG = WS_HC + 64 * MiB;
constexpr size_t WS_ACT = WS_XG + 272 * MiB;
constexpr size_t WS_ROWTAB = WS_ACT + 272 * MiB;
constexpr size_t WS_X2 = WS_ROWTAB + 8 * MiB;
constexpr size_t WS_END = WS_X2 + 128 * MiB;
constexpr size_t WS_LAT = WS_XG;
constexpr size_t WS_SSPKV = WS_XG;
constexpr size_t WS_SSPQ = WS_XG + 2 * MiB;
constexpr size_t WS_CQP = WS_LAT + 64 * MiB;
constexpr size_t WS_CKV = WS_CQP + 64 * MiB;
constexpr size_t WS_KR = WS_CKV + 16 * MiB;
constexpr size_t WS_CQ = WS_KR + 4 * MiB;
constexpr size_t WS_KN = WS_CQ + 28 * MiB;
constexpr size_t WS_VT = WS_KN + 64 * MiB;
constexpr size_t WS_Q = WS_VT + 64 * MiB;
static_assert(WS_Q + 96 * MiB <= WS_END, "ws map");

struct Args {
    const float* in[31]; float* out; unsigned char* ws; int ph_lo, ph_hi;
};
enum { I_X = 0, I_C, I_POS, I_MODW, I_MODB, I_N1G, I_N2G, I_PW1W, I_PW1B, I_DWW, I_DWB, I_LNG, I_LNB, I_PW2W, I_PW2B, I_KVG, I_WDKV, I_CKVG, I_WUK, I_WUV,
       I_WDQ, I_CQG, I_WUQ, I_WO, I_RW, I_RB, I_WGU, I_BGU, I_WDN, I_BDN, I_FG };

__device__ __forceinline__ unsigned cvt_pk_bf16(float lo, float hi) { unsigned r; asm volatile("v_cvt_pk_bf16_f32 %0, %1, %2" : "=v"(r) : "v"(lo), "v"(hi)); return r; }
__device__ __forceinline__ float bf2f(unsigned short b) { return __uint_as_float(((unsigned)b) << 16); }
__device__ __forceinline__ float bflo(unsigned w) { return __uint_as_float(w << 16); }
__device__ __forceinline__ float bfhi(unsigned w) { return __uint_as_float(w & 0xffff0000u); }
__device__ __forceinline__ float wave_sum(float v) {
#pragma unroll
    for (int o = 32; o >= 1; o >>= 1) v += __shfl_xor(v, o);
    return v;
}
__device__ __forceinline__ float sigmoidf_(float x) { return __builtin_amdgcn_rcpf(1.0f + __builtin_amdgcn_exp2f(-1.4426950408889634f * x)); }
#define XB_TMO      128
#define XB_XCNT(j)  (256  + 64 * (j))
#define XB_XSUB(j)  (1280 + 64 * (j))
#define XB_XGEN(j)  (2304 + 64 * (j))
#define XB_TOP      3328
#define XB_TOPGEN   3392
#define XCD_BAR_WORDS 3456
#define XB_SPIN_CAP (1u << 18)

__device__ __forceinline__ unsigned xb_ld(unsigned* p)              { return __hip_atomic_load(p, __ATOMIC_RELAXED, __HIP_MEMORY_SCOPE_AGENT); }
__device__ __forceinline__ unsigned xb_add(unsigned* p, unsigned v) { return __hip_atomic_fetch_add(p, v, __ATOMIC_RELAXED, __HIP_MEMORY_SCOPE_AGENT); }
__device__ __forceinline__ unsigned xb_xcc_id() { return (unsigned)__builtin_amdgcn_s_getreg((3 << 11) | 20) & 0xFu; }
#define XB_SPIN(cond, bar) do { unsigned _sp = 0; while (cond) { __builtin_amdgcn_s_sleep(1); \
    if ((++_sp & 255u) == 0u) { if (xb_ld(&(bar)[XB_TMO])) break; if (_sp > XB_SPIN_CAP) { atomicAdd(&(bar)[XB_TMO], 1u); break; } } } } while (0)

struct XcdBarrier {
    unsigned* bar; unsigned x;
    volatile LAS unsigned* st;
};

__device__ __forceinline__ XcdBarrier xcd_barrier_post(unsigned* bar, volatile LAS unsigned* st) {
    XcdBarrier b; b.bar = bar; b.x = xb_xcc_id(); b.st = st;
    if (threadIdx.x == 0) (void)xb_add(&bar[XB_XCNT(b.x)], 1u);
    return b;
}
__device__ __forceinline__ void xcd_barrier_complete(unsigned* bar, unsigned x, unsigned& nloc, unsigned& nx) {
    const unsigned G = gridDim.x * gridDim.y * gridDim.z;
    unsigned sum, cnt, mine, sp = 0u;
    for (;;) {
        sum = 0u; cnt = 0u; mine = 0u;
#pragma unroll
        for (unsigned j = 0; j < 16; ++j) { const unsigned c = xb_ld(&bar[XB_XCNT(j)]); sum += c; cnt += (c > 0u) ? 1u : 0u; mine = (j == x) ? c : mine; }
        if (sum == G) break;
        __builtin_amdgcn_s_sleep(1);
        if ((++sp & 255u) == 0u) { if (xb_ld(&bar[XB_TMO])) break; if (sp > XB_SPIN_CAP) { atomicAdd(&bar[XB_TMO], 1u); break; } }
    }
    nloc = mine > 0u ? mine : 1u; nx = cnt > 0u ? cnt : 1u;
}

__device__ __forceinline__ void xcd_barrier(const XcdBarrier& b) {
    asm volatile("s_waitcnt vmcnt(0)" ::: "memory");
    __syncthreads();
    if (threadIdx.x == 0) {
        unsigned* bar = b.bar;
        __builtin_amdgcn_s_waitcnt(0);
        unsigned nloc = b.st[0], nx = b.st[1];
        if (nloc == 0u) { xcd_barrier_complete(bar, b.x, nloc, nx); b.st[0] = nloc; b.st[1] = nx; }
        const unsigned old = xb_add(&bar[XB_XSUB(b.x)], 1u);
        const unsigned gen = old / nloc;
        if (old + 1u == (gen + 1u) * nloc) {
            __builtin_amdgcn_fence(__ATOMIC_RELEASE, "agent");
            asm volatile("s_waitcnt vmcnt(0)" ::: "memory");
            const unsigned og = xb_add(&bar[XB_TOP], 1u);
            const unsigned tg = og / nx;
            if (og + 1u == (tg + 1u) * nx) xb_add(&bar[XB_TOPGEN], 1u);
            else XB_SPIN(xb_ld(&bar[XB_TOPGEN]) == tg, bar);
            __builtin_amdgcn_fence(__ATOMIC_ACQUIRE, "agent");
            xb_add(&bar[XB_XGEN(b.x)], 1u);
            asm volatile("s_waitcnt vmcnt(0)" ::: "memory");
        } else {
            XB_SPIN(xb_ld(&bar[XB_XGEN(b.x)]) == gen, bar);
            __builtin_amdgcn_fence(__ATOMIC_ACQUIRE, "agent");
            asm volatile("s_waitcnt vmcnt(0)" ::: "memory");
        }
    }
    __syncthreads();
}
namespace pg8 {
#define PG8_LAS __attribute__((address_space(3)))
constexpr int BM = 256, BK = 64, HALF = 128, HTB = HALF * BK * 2  , STAGE_BYTES = 8 * HTB, NXCD = 8, WGM = 8;

__host__ __device__ __forceinline__ int lds_byte(int r, int c) { const int st = (r >> 4) * 2 + (c >> 5), rr = r & 15, cc = c & 31, ob = rr * 64 + cc * 2; return st * 1024 + (ob ^ (((ob >> 9) & 1) << 5)); }
__host__ __device__ __forceinline__ void stage_rc(int b, int& R, int& C) { const int st = b / 1024, sb = b % 1024, swz = sb ^ (((sb >> 9) & 1) << 5); R = (st >> 1) * 16 + swz / 64; C = (st & 1) * 32 + (swz % 64) / 2; }
__host__ __device__ __forceinline__ int perm32(int rho) { const int n = rho >> 4, i = rho & 15; return 8 * (i >> 2) + 4 * n + (i & 3); }

struct Unit { int pm, pn; };
struct Gemm { const bf16_t* A; const bf16_t* Bt; int M, N, K; };

struct StaticOrder {
    static constexpr bool GATHER = false;
    int nM, nN, nwg, G, c;
    __host__ __device__ void init(int M, int N, int G_, int c_) { nM = M / BM; nN = N / BM; nwg = nM * nN; G = G_; c = c_; }
    __host__ __device__ bool next(int i, Unit& u) const {
        const long L = (long)i * G + c; if (L >= nwg) return false;
        int wgid = (int)L; { const int q = nwg / NXCD, r = nwg % NXCD, xcd = wgid % NXCD, off = wgid / NXCD; wgid = (xcd < r ? xcd * (q + 1) : r * (q + 1) + (xcd - r) * q) + off; }
        const int nig = WGM * nN, gid = wgid / nig, fm = gid * WGM, gsz = (nM - fm) < WGM ? (nM - fm) : WGM;
        u.pm = fm + ((wgid % nig) % gsz); u.pn = (wgid % nig) / gsz; return true;
    }
    __device__ __forceinline__ void a_ready(const Unit&) const {}
    __device__ __forceinline__ size_t boff(const Unit& u, size_t tstep) const { return (size_t)u.pn * tstep; }
    __device__ __forceinline__ void done(const Unit&) const {}
};
template <class Epi, class Sched>
__device__ __forceinline__ void gemm_phase(PG8_LAS unsigned char* lds, const Gemm g, const Sched& S, const Epi& E) {
    constexpr bool STAMP = false; unsigned long long* stamps = nullptr;
    int tid_ = threadIdx.x; asm volatile("" : "+v"(tid_));
    const int tid = tid_, wid = __builtin_amdgcn_readfirstlane(tid >> 6), lane = tid & 63, wr = wid >> 2, wc = wid & 3, fr = lane & 15, fq = lane >> 4;
    const int K = g.K, nt = K / BK;
    int ts_lo = 0, ts_hi = 0, nts = 0; const unsigned long long rt_entry = STAMP ? (unsigned long long)wall_clock64() : 0ull;
#define PG8_STAMP() do { if (STAMP && wid == 0 && nts < 64) { const unsigned long long _c = (unsigned long long)clock64(); \
        ts_lo = (lane == nts) ? (int)(unsigned)_c : ts_lo; ts_hi = (lane == nts) ? (int)(unsigned)(_c >> 32) : ts_hi; ++nts; } } while (0)
    PG8_STAMP();
    unsigned voffA[2], voffB[2];
#pragma unroll
    for (int i = 0; i < 2; ++i) { int R, C; stage_rc(tid * 16 + i * 8192, R, C); const int Rb = Epi::PERM ? ((R & ~31) + perm32(R & 31)) : R;
        voffA[i] = (unsigned)(R * K + C) * 2u; voffB[i] = (unsigned)(Rb * K + C) * 2u; }
    unsigned gc[2][2], gn[2][2], gnn[2][2];
#define PG8_LOOKUP_LD(t4_, u) t4_ = *(const u32x4*)(S.rowtab + ((size_t)(u).pm * 512 + tid) * 4)
#define PG8_LOOKUP_FIN(dst, t4_) do { const unsigned tk_[4] = {t4_.x, t4_.y, t4_.z, t4_.w}; \
        _Pragma("unroll") for (int h_ = 0; h_ < 2; ++h_) _Pragma("unroll") for (int i_ = 0; i_ < 2; ++i_) { int R_, C_; stage_rc(tid * 16 + i_ * 8192, R_, C_); \
        const unsigned tc_ = tk_[h_ * 2 + i_] < S.nrows_src ? tk_[h_ * 2 + i_] : S.nrows_src - 1u; dst[h_][i_] = (tc_ * (unsigned)K + (unsigned)C_) * 2u; } } while (0)
#define PG8_LOOKUP(dst, u) do { u32x4 t4x_; PG8_LOOKUP_LD(t4x_, u); PG8_LOOKUP_FIN(dst, t4x_); } while (0)
#define PG8_STAGE_G(bufoff, kbytes, off2) do { _Pragma("unroll") for (int _i = 0; _i < 2; ++_i) \
        __builtin_amdgcn_global_load_lds((const unsigned*)((const char*)g.A + (kbytes) + (off2)[_i]), (PG8_LAS unsigned*)(lds + (bufoff) + ldsw + _i * 8192), 16, 0, 0); } while (0)
    const size_t kstep = (size_t)(BK * 2);
    const size_t hstep = (size_t)HALF * K * 2;
    const size_t tstep = 2 * hstep;
    const unsigned ldsw = (unsigned)wid * 1024u;
    const int aoff = lds_byte(wr * 64 + fr, fq * 8), boff = lds_byte(wc * 32 + fr, fq * 8);
#define PG8_SA(b, h) (((b) * 2 + (h)) * HTB)
#define PG8_SB(b, h) ((4 + (b) * 2 + (h)) * HTB)
#define PG8_STAGE(bufoff, gbase, voff) do { _Pragma("unroll") for (int _i = 0; _i < 2; ++_i) \
        __builtin_amdgcn_global_load_lds((const unsigned*)((const char*)(gbase) + (voff)[_i]), (PG8_LAS unsigned*)(lds + (bufoff) + ldsw + _i * 8192), 16, 0, 0); } while (0)
#define PG8_LDA(dst, b, h) do { _Pragma("unroll") for (int m = 0; m < 4; ++m) _Pragma("unroll") for (int k = 0; k < 2; ++k) dst[m][k] = *(const PG8_LAS bf16x8*)(lds + PG8_SA(b, h) + aoff + m * 2048 + k * 1024); } while (0)
#define PG8_LDB(dst, b, h) do { _Pragma("unroll") for (int n = 0; n < 2; ++n) _Pragma("unroll") for (int k = 0; k < 2; ++k) dst[n][k] = *(const PG8_LAS bf16x8*)(lds + PG8_SB(b, h) + boff + n * 2048 + k * 1024); } while (0)
#define PG8_MMA(ai, bj, At, Bt) do { __builtin_amdgcn_s_setprio(1); _Pragma("unroll") for (int m = 0; m < 4; ++m) _Pragma("unroll") for (int n = 0; n < 2; ++n) _Pragma("unroll") for (int k = 0; k < 2; ++k) \
        acc[ai][bj][m][n] = __builtin_amdgcn_mfma_f32_16x16x32_bf16(Bt[n][k], At[m][k], acc[ai][bj][m][n], 0, 0, 0); __builtin_amdgcn_s_setprio(0); } while (0)
#define PG8_WAIT_V(n) asm volatile("s_waitcnt vmcnt(" #n ")" ::: "memory")
#define PG8_WAIT_L(n) asm volatile("s_waitcnt lgkmcnt(" #n ")" ::: "memory")
#define PG8_BAR __builtin_amdgcn_s_barrier()
#define PG8_SCHED __builtin_amdgcn_sched_barrier(0)
    Unit cur, nxt; int ui = 0;
    if (!S.next(0, cur)) return;
    f32x4 acc[2][2][4][2];
#pragma unroll
    for (int a = 0; a < 2; ++a)
#pragma unroll
        for (int b = 0; b < 2; ++b)
#pragma unroll
            for (int m = 0; m < 4; ++m)
#pragma unroll
                for (int n = 0; n < 2; ++n) acc[a][b][m][n] = (f32x4){0.f, 0.f, 0.f, 0.f};
    bf16x8 At[4][2], B0[2][2], B1[2][2];
    const char* cA = (const char*)g.A + (size_t)cur.pm * tstep; const char* cB = (const char*)g.Bt + S.boff(cur, tstep);
    S.a_ready(cur);
    if constexpr (Sched::GATHER) { PG8_LOOKUP(gc, cur); Unit u1_; if (S.next(1, u1_)) PG8_LOOKUP(gn, u1_); else { _Pragma("unroll") for (int h_ = 0; h_ < 2; ++h_) _Pragma("unroll") for (int i_ = 0; i_ < 2; ++i_) gn[h_][i_] = gc[h_][i_]; } }
    PG8_STAGE(PG8_SB(0, 0), cB, voffB); if constexpr (Sched::GATHER) PG8_STAGE_G(PG8_SA(0, 0), 0, gc[0]); else PG8_STAGE(PG8_SA(0, 0), cA, voffA);
    PG8_STAGE(PG8_SB(0, 1), cB + hstep, voffB); if constexpr (Sched::GATHER) PG8_STAGE_G(PG8_SA(0, 1), 0, gc[1]); else PG8_STAGE(PG8_SA(0, 1), cA + hstep, voffA);
    if (wr == 1) PG8_BAR;
    PG8_WAIT_V(4); PG8_BAR;
    PG8_STAGE(PG8_SB(1, 0), cB + kstep, voffB); if constexpr (Sched::GATHER) PG8_STAGE_G(PG8_SA(1, 0), kstep, gc[0]); else PG8_STAGE(PG8_SA(1, 0), cA + kstep, voffA);
    PG8_STAGE(PG8_SB(1, 1), cB + hstep + kstep, voffB);
    PG8_WAIT_V(6); PG8_BAR;
    PG8_STAMP();
    for (;;) {
        const bool has_next = S.next(ui + 1, nxt);
        const char* nA = has_next ? (const char*)g.A + (size_t)nxt.pm * tstep : cA; const char* nB = has_next ? (const char*)g.Bt + S.boff(nxt, tstep) : cB;
        const typename Epi::Pre pre = E.pre(cur, wr, wc, fr, fq);
        if constexpr (Sched::GATHER) { if (!has_next) { _Pragma("unroll") for (int h_ = 0; h_ < 2; ++h_) _Pragma("unroll") for (int i_ = 0; i_ < 2; ++i_) gn[h_][i_] = gc[h_][i_]; } }
        for (int t = 0; t < nt; t += 2) {
            const bool last = (t == nt - 2);
            unsigned gs[2][2]; size_t k1 = 0, k2 = 0;
            if constexpr (Sched::GATHER) { k1 = (size_t)(t + 1) * kstep; k2 = last ? 0 : (size_t)(t + 2) * kstep;
                _Pragma("unroll") for (int h_ = 0; h_ < 2; ++h_) _Pragma("unroll") for (int i_ = 0; i_ < 2; ++i_) gs[h_][i_] = last ? gn[h_][i_] : gc[h_][i_]; }
            const char* a1 = cA + (size_t)(t + 1) * kstep;
            const char* a2 = last ? nA : cA + (size_t)(t + 2) * kstep; const char* b2 = last ? nB : cB + (size_t)(t + 2) * kstep;
            const char* a3 = a2 + kstep; const char* b3 = b2 + kstep;
            if (last && has_next) S.a_ready(nxt);
            PG8_LDB(B0, 0, 0); PG8_SCHED; PG8_LDA(At, 0, 0); if constexpr (Sched::GATHER) PG8_STAGE_G(PG8_SA(1, 1), k1, gc[1]); else PG8_STAGE(PG8_SA(1, 1), a1 + hstep, voffA);
            PG8_WAIT_L(8); PG8_BAR; PG8_WAIT_L(0); PG8_MMA(0, 0, At, B0); PG8_BAR; PG8_SCHED;
            PG8_LDB(B1, 0, 1); PG8_STAGE(PG8_SB(0, 0), b2, voffB);
            PG8_BAR; PG8_WAIT_L(0); PG8_MMA(0, 1, At, B1); PG8_BAR;
            PG8_LDA(At, 0, 1); if constexpr (Sched::GATHER) PG8_STAGE_G(PG8_SA(0, 0), k2, gs[0]); else PG8_STAGE(PG8_SA(0, 0), a2, voffA);
            PG8_BAR; PG8_WAIT_L(0); PG8_MMA(1, 0, At, B0); PG8_BAR; PG8_SCHED;
            PG8_STAGE(PG8_SB(0, 1), b2 + hstep, voffB);
            PG8_WAIT_V(6); PG8_BAR; PG8_MMA(1, 1, At, B1); PG8_BAR;
            PG8_LDB(B0, 1, 0); PG8_SCHED; PG8_LDA(At, 1, 0); if constexpr (Sched::GATHER) PG8_STAGE_G(PG8_SA(0, 1), k2, gs[1]); else PG8_STAGE(PG8_SA(0, 1), a2 + hstep, voffA);
            PG8_WAIT_L(8); PG8_BAR; PG8_WAIT_L(0); PG8_MMA(0, 0, At, B0); PG8_BAR; PG8_SCHED;
            PG8_LDB(B1, 1, 1); PG8_STAGE(PG8_SB(1, 0), b3, voffB);
            PG8_BAR; PG8_WAIT_L(0); PG8_MMA(0, 1, At, B1); PG8_BAR;
            PG8_LDA(At, 1, 1); if constexpr (Sched::GATHER) PG8_STAGE_G(PG8_SA(1, 0), k2 + kstep, gs[0]); else PG8_STAGE(PG8_SA(1, 0), a3, voffA);
            PG8_BAR; PG8_WAIT_L(0); PG8_MMA(1, 0, At, B0); PG8_BAR; PG8_SCHED;
            PG8_STAGE(PG8_SB(1, 1), b3 + hstep, voffB);
            PG8_WAIT_V(6); PG8_BAR; PG8_MMA(1, 1, At, B1); PG8_BAR;
        }
        PG8_STAMP();
        u32x4 t4n_ = {0u, 0u, 0u, 0u}; bool has_nn_ = false;
        if constexpr (Sched::GATHER) { Unit u2_; has_nn_ = S.next(ui + 2, u2_); if (has_nn_) PG8_LOOKUP_LD(t4n_, u2_); }
        if constexpr (!Epi::AFTER_DRAIN) { if (wr == 0) PG8_BAR; E(acc, cur, wr, wc, fr, fq, pre); S.done(cur); if (wr == 1) PG8_BAR; }
        if constexpr (Sched::GATHER) { if (has_nn_) PG8_LOOKUP_FIN(gnn, t4n_); else { _Pragma("unroll") for (int h_ = 0; h_ < 2; ++h_) _Pragma("unroll") for (int i_ = 0; i_ < 2; ++i_) gnn[h_][i_] = gn[h_][i_]; } }
        PG8_STAMP();
        if (!has_next) break;
#pragma unroll
        for (int a = 0; a < 2; ++a)
#pragma unroll
            for (int b = 0; b < 2; ++b)
#pragma unroll
                for (int m = 0; m < 4; ++m)
#pragma unroll
                    for (int n = 0; n < 2; ++n) acc[a][b][m][n] = (f32x4){0.f, 0.f, 0.f, 0.f};
        cur = nxt; cA = nA; cB = nB; ++ui;
        if constexpr (Sched::GATHER) { _Pragma("unroll") for (int h_ = 0; h_ < 2; ++h_) _Pragma("unroll") for (int i_ = 0; i_ < 2; ++i_) { gc[h_][i_] = gn[h_][i_]; gn[h_][i_] = gnn[h_][i_]; } }
    }
    PG8_WAIT_V(0);
    if (wr == 0) PG8_BAR;
    PG8_BAR;
    if constexpr (Epi::AFTER_DRAIN) { E.fused(acc, cur, wr, wc, fr, fq, lds, wid, lane); S.done(cur); }
    PG8_STAMP();
    if (STAMP && wid == 0) { stamps[lane] = lane < nts ? (((unsigned long long)(unsigned)ts_hi << 32) | (unsigned)ts_lo) : 0ull;
        if (lane == 62) stamps[62] = rt_entry; if (lane == 63) stamps[63] = (unsigned long long)wall_clock64(); }
#undef PG8_STAMP
#undef PG8_SA
#undef PG8_SB
#undef PG8_STAGE
#undef PG8_STAGE_G
#undef PG8_LOOKUP
#undef PG8_LOOKUP_LD
#undef PG8_LOOKUP_FIN
#undef PG8_LDA
#undef PG8_LDB
#undef PG8_MMA
#undef PG8_WAIT_V
#undef PG8_WAIT_L
#undef PG8_BAR
#undef PG8_SCHED
}
}
namespace pg8 {
struct MoeOrder : StaticOrder {
    static constexpr bool GATHER = false;
    const LAS int* bexp; size_t estride;
    bool rev = false; bool same = false;
    __device__ __forceinline__ bool next(int i, Unit& u) const { const bool ok = StaticOrder::next(i, u); if (ok && rev) u.pm = nM - 1 - u.pm; if (ok && same) { u.pm = 0; u.pn = 0; } return ok; }
    __device__ __forceinline__ size_t boff(const Unit& u, size_t tstep) const { return (size_t)__builtin_amdgcn_readfirstlane(bexp[1 + u.pm]) * estride + (size_t)u.pn * tstep; }
};

struct MoeGatherOrder : MoeOrder {
    static constexpr bool GATHER = true;
    const unsigned* rowtab; unsigned nrows_src;
};

template <int MODE> struct EpiGated {
    static constexpr bool PERM = true, AFTER_DRAIN = false;
    bf16_t* O; int ldo; const float* bias; int nh; const LAS int* bexp;
    struct Pre { f32x4 b0[2], b1[2]; };
    __device__ __forceinline__ Pre pre(const Unit& u, int wr, int wc, int fr, int fq) const {
        const int colh = u.pn * HALF + wc * 32 + 8 * fq; Pre p;
        const float* bp = bias; if (MODE == 1) bp += (size_t)__builtin_amdgcn_readfirstlane(bexp[1 + u.pm]) * (size_t)(2 * nh);
#pragma unroll
        for (int n = 0; n < 2; ++n) { p.b0[n] = *(const f32x4*)(bp + colh + 4 * n); p.b1[n] = *(const f32x4*)(bp + nh + colh + 4 * n); }
        return p; }
    __device__ __forceinline__ void operator()(const f32x4 (&acc)[2][2][4][2], const Unit& u, int wr, int wc, int fr, int fq, const Pre& P) const {
        const int row0 = u.pm * BM + wr * 64 + fr, colh = u.pn * HALF + wc * 32 + 8 * fq;
        f32x4 b0[2], b1[2];
#pragma unroll
        for (int n = 0; n < 2; ++n) { b0[n] = P.b0[n]; b1[n] = P.b1[n]; }
#pragma unroll
        for (int ai = 0; ai < 2; ++ai)
#pragma unroll
            for (int m = 0; m < 4; ++m) {
                float o[8];
#pragma unroll
                for (int n = 0; n < 2; ++n) { const f32x4 a = acc[ai][0][m][n] + b0[n], g = acc[ai][1][m][n] + b1[n];
#pragma unroll
                    for (int j = 0; j < 4; ++j) {
                        if (MODE == 0) o[4 * n + j] = a[j] * sigmoidf_(g[j]);
                        else { const float gg = fminf(a[j], 7.0f), uu = fminf(fmaxf(g[j], -7.0f), 7.0f);
                            o[4 * n + j] = fmaf(uu, gg, gg) * __builtin_amdgcn_rcpf(1.0f + __builtin_amdgcn_exp2f(gg * (-1.702f * 1.4426950408889634f))); } } }
                u32x4 w; w.x = cvt_pk_bf16(o[0], o[1]); w.y = cvt_pk_bf16(o[2], o[3]); w.z = cvt_pk_bf16(o[4], o[5]); w.w = cvt_pk_bf16(o[6], o[7]);
                *(u32x4*)(O + (size_t)(row0 + ai * HALF + m * 16) * ldo + colh) = w; }
    }
};
struct EpiBf16P {
    static constexpr bool PERM = true, AFTER_DRAIN = false;
    bf16_t* O; int ldo; const float* bias; int nbias; const LAS int* bexp; int probe = 0;
    struct Pre { f32x4 bv[2][2]; };
    __device__ __forceinline__ Pre pre(const Unit& u, int wr, int wc, int fr, int fq) const {
        const int col0 = u.pn * BM + wc * 32 + 8 * fq; Pre p;
        const float* bp = bias; if (bias && bexp) bp += (size_t)__builtin_amdgcn_readfirstlane(bexp[1 + u.pm]) * (size_t)nbias;
#pragma unroll
        for (int bj = 0; bj < 2; ++bj)
#pragma unroll
            for (int n = 0; n < 2; ++n) p.bv[bj][n] = bias ? *(const f32x4*)(bp + col0 + bj * HALF + 4 * n) : (f32x4){0.f, 0.f, 0.f, 0.f};
        return p; }
    __device__ __forceinline__ void operator()(const f32x4 (&acc)[2][2][4][2], const Unit& u_, int wr, int wc, int fr, int fq, const Pre& P) const {
        if (probe == 1) return;
        Unit u = u_; if (probe >= 2) { u.pm = 0; }
        const int row0 = u.pm * BM + wr * 64 + fr, col0 = u.pn * BM + wc * 32 + 8 * fq;
        f32x4 bv[2][2];
#pragma unroll
        for (int bj = 0; bj < 2; ++bj)
#pragma unroll
            for (int n = 0; n < 2; ++n) bv[bj][n] = P.bv[bj][n];
#pragma unroll
        for (int ai = 0; ai < 2; ++ai)
#pragma unroll
            for (int m = 0; m < 4; ++m) { bf16_t* rowp = O + (size_t)(row0 + ai * HALF + m * 16) * ldo + col0;
#pragma unroll
                for (int bj = 0; bj < 2; ++bj) { const f32x4 v0 = acc[ai][bj][m][0] + bv[bj][0], v1 = acc[ai][bj][m][1] + bv[bj][1];
                    u32x4 w; w.x = cvt_pk_bf16(v0[0], v0[1]); w.y = cvt_pk_bf16(v0[2], v0[3]); w.z = cvt_pk_bf16(v1[0], v1[1]); w.w = cvt_pk_bf16(v1[2], v1[3]);
                    if (probe == 3 && (ai | m)) { asm volatile("" :: "v"(w)); continue; }
                    *(u32x4*)(rowp + bj * HALF) = w; } }
    }
};
struct EpiF32P {
    static constexpr bool PERM = false, AFTER_DRAIN = false;
    float* C; int ldc;
    struct Pre {};
    __device__ __forceinline__ Pre pre(const Unit&, int, int, int, int) const { return Pre{}; }
    __device__ __forceinline__ void operator()(const f32x4 (&acc)[2][2][4][2], const Unit& u, int wr, int wc, int fr, int fq, const Pre&) const {
        const int row0 = u.pm * BM + wr * 64 + fr, col0 = u.pn * BM + wc * 32 + 4 * fq;
#pragma unroll
        for (int ai = 0; ai < 2; ++ai)
#pragma unroll
            for (int m = 0; m < 4; ++m) { float* rowp = C + (size_t)(row0 + ai * HALF + m * 16) * ldc + col0;
#pragma unroll
                for (int bj = 0; bj < 2; ++bj)
#pragma unroll
                    for (int n = 0; n < 2; ++n) *(f32x4*)(rowp + bj * HALF + n * 16) = acc[ai][bj][m][n]; }
    }
};
struct EpiResid {
    static constexpr bool PERM = false, AFTER_DRAIN = false;
    const float* base; float* X; const float* bias; const float* gate;
    struct Pre {};
    __device__ __forceinline__ Pre pre(const Unit&, int, int, int, int) const { return Pre{}; }
    __device__ __forceinline__ void operator()(const f32x4 (&acc)[2][2][4][2], const Unit& u, int wr, int wc, int fr, int fq, const Pre&) const {
        const int row0 = u.pm * BM + wr * 64 + fr, col0 = u.pn * BM + wc * 32 + 4 * fq;
        const float* gp = gate + (size_t)((u.pm * BM) / SEQ) * (6 * D);
        f32x4 bv[2][2], gv[2][2];
#pragma unroll
        for (int bj = 0; bj < 2; ++bj)
#pragma unroll
            for (int n = 0; n < 2; ++n) { bv[bj][n] = bias ? *(const f32x4*)(bias + col0 + bj * HALF + n * 16) : (f32x4){0.f, 0.f, 0.f, 0.f}; gv[bj][n] = *(const f32x4*)(gp + col0 + bj * HALF + n * 16); }
#pragma unroll
        for (int ai = 0; ai < 2; ++ai)
#pragma unroll
            for (int m = 0; m < 4; ++m) { const size_t off = (size_t)(row0 + ai * HALF + m * 16) * D + col0;
                f32x4 bs[2][2];
#pragma unroll
                for (int bj = 0; bj < 2; ++bj)
#pragma unroll
                    for (int n = 0; n < 2; ++n) bs[bj][n] = *(const f32x4*)(base + off + bj * HALF + n * 16);
#pragma unroll
                for (int bj = 0; bj < 2; ++bj)
#pragma unroll
                    for (int n = 0; n < 2; ++n) *(f32x4*)(X + off + bj * HALF + n * 16) = bs[bj][n] + gv[bj][n] * (acc[ai][bj][m][n] + bv[bj][n]); }
    }
};
struct EpiQRope {
    static constexpr bool PERM = true, AFTER_DRAIN = false;
    bf16_t* O; const f32x2* cs;
    struct Pre {};
    __device__ __forceinline__ Pre pre(const Unit&, int, int, int, int) const { return Pre{}; }
    __device__ __forceinline__ void operator()(const f32x4 (&acc)[2][2][4][2], const Unit& u, int wr, int wc, int fr, int fq, const Pre&) const {
        const int row0 = u.pm * BM + wr * 64 + fr, col0 = u.pn * BM + wc * 32 + 8 * fq;
#pragma unroll
        for (int bj = 0; bj < 2; ++bj) {
            const int c = col0 + bj * HALF, w = c % DQK; const bool rope = w >= DNOPE; const int k4 = rope ? ((w - DNOPE) >> 3) * 4 : 0;
#pragma unroll
            for (int ai = 0; ai < 2; ++ai)
#pragma unroll
                for (int m = 0; m < 4; ++m) { const int row = row0 + ai * HALF + m * 16;
                    f32x4 v0 = acc[ai][bj][m][0], v1 = acc[ai][bj][m][1];
                    if (rope) { const f32x4 t0 = *(const f32x4*)(cs + (size_t)row * 32 + k4), t1 = *(const f32x4*)(cs + (size_t)row * 32 + k4 + 2);
                        const float co[4] = {t0[0], t0[2], t1[0], t1[2]}, si[4] = {t0[1], t0[3], t1[1], t1[3]};
#pragma unroll
                        for (int j = 0; j < 4; ++j) { const float x1 = v0[j], x2 = v1[j]; v0[j] = x1 * co[j] - x2 * si[j]; v1[j] = x2 * co[j] + x1 * si[j]; } }
                    u32x4 wv; wv.x = cvt_pk_bf16(v0[0], v0[1]); wv.y = cvt_pk_bf16(v0[2], v0[3]); wv.z = cvt_pk_bf16(v1[0], v1[1]); wv.w = cvt_pk_bf16(v1[2], v1[3]);
                    *(u32x4*)(O + (size_t)row * (NH * DQK) + c) = wv;
                    asm volatile("" ::: "memory"); } }
    }
};

template <bool BF> struct EpiResidB {
    static constexpr bool PERM = true, AFTER_DRAIN = false;
    const void* base; bf16_t* X; const float* bias; const float* gate;
    struct Pre {};
    __device__ __forceinline__ Pre pre(const Unit&, int, int, int, int) const { return Pre{}; }
    __device__ __forceinline__ void operator()(const f32x4 (&acc)[2][2][4][2], const Unit& u, int wr, int wc, int fr, int fq, const Pre&) const {
        const int row0 = u.pm * BM + wr * 64 + fr, col0 = u.pn * BM + wc * 32 + 8 * fq;
        const float* gp = gate + (size_t)((u.pm * BM) / SEQ) * (6 * D);
        f32x4 bv[2][2], gv[2][2];
#pragma unroll
        for (int bj = 0; bj < 2; ++bj)
#pragma unroll
            for (int n = 0; n < 2; ++n) { bv[bj][n] = bias ? *(const f32x4*)(bias + col0 + bj * HALF + 4 * n) : (f32x4){0.f, 0.f, 0.f, 0.f}; gv[bj][n] = *(const f32x4*)(gp + col0 + bj * HALF + 4 * n); }
#pragma unroll
        for (int ai = 0; ai < 2; ++ai)
#pragma unroll
            for (int m = 0; m < 4; ++m) { const size_t off = (size_t)(row0 + ai * HALF + m * 16) * D + col0;
                f32x4 b0[2], b1[2];
#pragma unroll
                for (int bj = 0; bj < 2; ++bj) {
                    if (BF) { const u32x4 w = *(const u32x4*)((const bf16_t*)base + off + bj * HALF); b0[bj] = (f32x4){bflo(w.x), bfhi(w.x), bflo(w.y), bfhi(w.y)}; b1[bj] = (f32x4){bflo(w.z), bfhi(w.z), bflo(w.w), bfhi(w.w)}; }
                    else { b0[bj] = *(const f32x4*)((const float*)base + off + bj * HALF); b1[bj] = *(const f32x4*)((const float*)base + off + bj * HALF + 4); } }
#pragma unroll
                for (int bj = 0; bj < 2; ++bj) { const f32x4 v0 = b0[bj] + gv[bj][0] * (acc[ai][bj][m][0] + bv[bj][0]), v1 = b1[bj] + gv[bj][1] * (acc[ai][bj][m][1] + bv[bj][1]);
                    u32x4 w; w.x = cvt_pk_bf16(v0[0], v0[1]); w.y = cvt_pk_bf16(v0[2], v0[3]); w.z = cvt_pk_bf16(v1[0], v1[1]); w.w = cvt_pk_bf16(v1[2], v1[3]);
                    *(u32x4*)(X + off + bj * HALF) = w; } }
    }
};
struct EpiLatQ {
    static constexpr bool PERM = true, AFTER_DRAIN = false;
    bf16_t* O0; int ld0, n0; bf16_t* KR; const f32x2* cs; float* ssp;
    struct Pre {};
    __device__ __forceinline__ Pre pre(const Unit&, int, int, int, int) const { return Pre{}; }
    __device__ __forceinline__ void operator()(const f32x4 (&acc)[2][2][4][2], const Unit& u, int wr, int wc, int fr, int fq, const Pre&) const {
        const int row0 = u.pm * BM + wr * 64 + fr, col0 = u.pn * BM + wc * 32 + 8 * fq;
#pragma unroll
        for (int ai = 0; ai < 2; ++ai)
#pragma unroll
            for (int m = 0; m < 4; ++m) { const int row = row0 + ai * HALF + m * 16; float ss = 0.f;
#pragma unroll
                for (int bj = 0; bj < 2; ++bj) { const int c = col0 + bj * HALF; f32x4 v0 = acc[ai][bj][m][0], v1 = acc[ai][bj][m][1];
                    if (c < n0) {
                        ss += (v0[0] * v0[0] + v0[1] * v0[1]) + (v0[2] * v0[2] + v0[3] * v0[3]) + (v1[0] * v1[0] + v1[1] * v1[1]) + (v1[2] * v1[2] + v1[3] * v1[3]);
                        u32x4 w; w.x = cvt_pk_bf16(v0[0], v0[1]); w.y = cvt_pk_bf16(v0[2], v0[3]); w.z = cvt_pk_bf16(v1[0], v1[1]); w.w = cvt_pk_bf16(v1[2], v1[3]);
                        *(u32x4*)(O0 + (size_t)row * ld0 + c) = w;
                    } else if (KR && c < n0 + DROPE) { const int k4 = ((c - n0) >> 3) * 4; const f32x4 t0 = *(const f32x4*)(cs + (size_t)row * 32 + k4), t1 = *(const f32x4*)(cs + (size_t)row * 32 + k4 + 2);
                        const float co[4] = {t0[0], t0[2], t1[0], t1[2]}, si[4] = {t0[1], t0[3], t1[1], t1[3]};
#pragma unroll
                        for (int j = 0; j < 4; ++j) { const float x1 = v0[j], x2 = v1[j]; v0[j] = x1 * co[j] - x2 * si[j]; v1[j] = x2 * co[j] + x1 * si[j]; }
                        u32x4 w; w.x = cvt_pk_bf16(v0[0], v0[1]); w.y = cvt_pk_bf16(v0[2], v0[3]); w.z = cvt_pk_bf16(v1[0], v1[1]); w.w = cvt_pk_bf16(v1[2], v1[3]);
                        *(u32x4*)(KR + (size_t)row * DROPE + (c - n0)) = w; } }
                ss += __shfl_xor(ss, 16); ss += __shfl_xor(ss, 32);
                if (fq == 0) ssp[(size_t)row * 8 + u.pn * 4 + wc] = ss;
                asm volatile("" ::: "memory"); }
    }
};
struct EpiScaled {
    static constexpr bool PERM = true, AFTER_DRAIN = false;
    bf16_t* O; int ldo; const float* ssp; int mode, np; float inv_nd;
    struct Pre {};
    __device__ __forceinline__ Pre pre(const Unit&, int, int, int, int) const { return Pre{}; }
    __device__ __forceinline__ float rstd_of(int t) const { const f32x4 a = *(const f32x4*)(ssp + (size_t)t * 8); float s = (a[0] + a[1]) + (a[2] + a[3]);
        if (np == 8) { const f32x4 b = *(const f32x4*)(ssp + (size_t)t * 8 + 4); s += (b[0] + b[1]) + (b[2] + b[3]); } return rsqrtf(s * inv_nd + EPS); }
    __device__ __forceinline__ void operator()(const f32x4 (&acc)[2][2][4][2], const Unit& u, int wr, int wc, int fr, int fq, const Pre&) const {
        const int row0 = u.pm * BM + wr * 64 + fr, col0 = u.pn * BM + wc * 32 + 8 * fq;
        if (mode == 1) {
#pragma unroll
            for (int bj = 0; bj < 2; ++bj) { const int c = col0 + bj * HALF; float rc[8];
#pragma unroll
                for (int j = 0; j < 8; ++j) rc[j] = rstd_of(c + j);
#pragma unroll
                for (int ai = 0; ai < 2; ++ai)
#pragma unroll
                    for (int m = 0; m < 4; ++m) { const f32x4 v0 = acc[ai][bj][m][0], v1 = acc[ai][bj][m][1];
                        u32x4 w; w.x = cvt_pk_bf16(v0[0] * rc[0], v0[1] * rc[1]); w.y = cvt_pk_bf16(v0[2] * rc[2], v0[3] * rc[3]); w.z = cvt_pk_bf16(v1[0] * rc[4], v1[1] * rc[5]); w.w = cvt_pk_bf16(v1[2] * rc[6], v1[3] * rc[7]);
                        *(u32x4*)(O + (size_t)(row0 + ai * HALF + m * 16) * ldo + c) = w; }
                asm volatile("" ::: "memory"); }
        } else {
#pragma unroll
            for (int ai = 0; ai < 2; ++ai)
#pragma unroll
                for (int m = 0; m < 4; ++m) { const int row = row0 + ai * HALF + m * 16; const float r = rstd_of(row);
#pragma unroll
                    for (int bj = 0; bj < 2; ++bj) { const f32x4 v0 = acc[ai][bj][m][0] * r, v1 = acc[ai][bj][m][1] * r;
                        u32x4 w; w.x = cvt_pk_bf16(v0[0], v0[1]); w.y = cvt_pk_bf16(v0[2], v0[3]); w.z = cvt_pk_bf16(v1[0], v1[1]); w.w = cvt_pk_bf16(v1[2], v1[3]);
                        *(u32x4*)(O + (size_t)row * ldo + col0 + bj * HALF) = w; }
                    asm volatile("" ::: "memory"); }
        }
    }
};

#if NAIVE_GEMM
template <class Epi, class Sched>
__device__ __forceinline__ void gemm_phase_naive(PG8_LAS unsigned char*, const Gemm g, const Sched& S, const Epi& E) {
    const int tid = threadIdx.x, wid = tid >> 6, lane = tid & 63, wr = wid >> 2, wc = wid & 3, fr = lane & 15, fq = lane >> 4;
    const size_t tstep = (size_t)BM * g.K * 2;
    Unit u;
    for (int i = 0; S.next(i, u); ++i) {
        f32x4 acc[2][2][4][2];
        const bf16_t* Bb = (const bf16_t*)((const char*)g.Bt + S.boff(u, tstep));
#pragma unroll 1
        for (int ai = 0; ai < 2; ++ai)
#pragma unroll 1
            for (int m = 0; m < 4; ++m) {
                const bf16_t* ar = g.A + (size_t)(u.pm * BM + ai * HALF + wr * 64 + m * 16 + fr) * g.K;
#pragma unroll
                for (int bj = 0; bj < 2; ++bj)
#pragma unroll
                    for (int n = 0; n < 2; ++n) {
                        const int cs = Epi::PERM ? (bj * HALF + wc * 32 + 8 * fq + 4 * n) : (bj * HALF + wc * 32 + 16 * n + 4 * fq);
                        float s[4] = {0.f, 0.f, 0.f, 0.f};
                        for (int k = 0; k < g.K; k += 8) {
                            const u32x4 av = *(const u32x4*)(ar + k);
#pragma unroll
                            for (int j = 0; j < 4; ++j) { const u32x4 bv = *(const u32x4*)(Bb + (size_t)(cs + j) * g.K + k);
                                s[j] += bflo(av.x) * bflo(bv.x) + bfhi(av.x) * bfhi(bv.x) + bflo(av.y) * bflo(bv.y) + bfhi(av.y) * bfhi(bv.y)
                                      + bflo(av.z) * bflo(bv.z) + bfhi(av.z) * bfhi(bv.z) + bflo(av.w) * bflo(bv.w) + bfhi(av.w) * bfhi(bv.w); } }
                        f32x4 r = {s[0], s[1], s[2], s[3]};
#pragma unroll
                        for (int a2 = 0; a2 < 2; ++a2)
#pragma unroll
                            for (int m2 = 0; m2 < 4; ++m2) if (a2 == ai && m2 == m) acc[a2][bj][m2][n] = r;
                    }
            }
        E(acc, u, wr, wc, fr, fq, E.pre(u, wr, wc, fr, fq));
    }
}
#endif
}

#if NAIVE_GEMM
#define GEMM_PHASE pg8::gemm_phase_naive
#else
#define GEMM_PHASE pg8::gemm_phase
#endif
struct Frame {
    LAS unsigned char* lds; GAS unsigned char* ws; const Args* a;
    int tid, lane, wave, G, blk;
};
__device__ __forceinline__ const float* modp(const Frame& F, int l, int b, int part) { return (const float*)(F.ws + WS_MOD) + ((size_t)(l * NB + b) * 6 + part) * D; }

enum { CM_ID = 0, CM_GLU = 1, CM_UQ = 2, CM_DKV = 3 };
__device__ __forceinline__ int cvt_srccol(int mode, int n, int nvalid, int nh) {
    if (mode == CM_GLU) { const int pn = n >> 8, r = n & 255; return r < 128 ? pn * 128 + r : nh + pn * 128 + (r - 128); }
    if (mode == CM_UQ) { const int h = n / DQK, w = n - h * DQK; if (w < DNOPE) return n; const int p = w - DNOPE, blk = p >> 3, wi = p & 7, i = 4 * blk + (wi & 3); return h * DQK + (wi < 4 ? DNOPE + i : DNOPE + 32 + i); }
    if (mode == CM_DKV) { if (n < KVLORA) return n; if (n >= KVLORA + DROPE) return -1; const int p = n - KVLORA, blk = p >> 3, wi = p & 7, i = 4 * blk + (wi & 3); return KVLORA + (wi < 4 ? i : 32 + i); }
    return n < nvalid ? n : -1;
}
struct CvtJob { const float* src; bf16_t* dst; int K, ld, ndst, nvalid, mode, batch; size_t sstride, dstride; float scale; const float* kgain; };
__device__ __forceinline__ int cvt_tiles(const CvtJob& j) { return j.batch * (j.ndst / 128) * (j.K / 128); }
struct CvtTile { const float* src; bf16_t* dst; int n0, k0, sc; };
__device__ __forceinline__ CvtTile cvt_locate(const Frame& F, const CvtJob& J, int t) {
    const int nkt = J.K / 128, nnt = J.ndst / 128, per = nkt * nnt, bi = t / per, r = t - bi * per, nt = r / nkt, kt = r - nt * nkt;
    CvtTile T; T.src = J.src + (size_t)bi * J.sstride; T.dst = J.dst + (size_t)bi * J.dstride; T.n0 = nt * 128; T.k0 = kt * 128;
    T.sc = cvt_srccol(J.mode, T.n0 + 4 * (F.tid & 31), J.nvalid, J.ndst / 2); return T;
}
__device__ __forceinline__ void cvt_load(const Frame& F, const CvtJob& J, const CvtTile& T, f32x4 (&v)[8]) {
    const int kg = F.tid >> 5;
#pragma unroll
    for (int i = 0; i < 8; ++i) v[i] = T.sc >= 0 ? *(const f32x4*)(T.src + (size_t)(T.k0 + 8 * kg + i) * J.ld + T.sc) : (f32x4){0.f, 0.f, 0.f, 0.f};
}
__device__ __forceinline__ void cvt_to_lds(const Frame& F, const CvtJob& J, const CvtTile& T, const f32x4 (&v)[8], LAS unsigned char* img) {
    const int nq = F.tid & 31, kg = F.tid >> 5; float sc[8];
#pragma unroll
    for (int i = 0; i < 8; ++i) sc[i] = J.kgain ? J.scale * J.kgain[T.k0 + 8 * kg + i] : J.scale;
#pragma unroll
    for (int j = 0; j < 4; ++j) {
        u32x4 w; w.x = cvt_pk_bf16(v[0][j] * sc[0], v[1][j] * sc[1]); w.y = cvt_pk_bf16(v[2][j] * sc[2], v[3][j] * sc[3]); w.z = cvt_pk_bf16(v[4][j] * sc[4], v[5][j] * sc[5]); w.w = cvt_pk_bf16(v[6][j] * sc[6], v[7][j] * sc[7]);
        *(LAS u32x4*)(img + (4 * nq + j) * 256 + ((kg ^ (nq & 7)) << 4)) = w; }
}
__device__ __forceinline__ void cvt_from_lds(const Frame& F, const CvtJob& J, const CvtTile& T, const LAS unsigned char* img) {
#pragma unroll
    for (int p = 0; p < 4; ++p) { const int row = p * 32 + (F.tid >> 4), c = F.tid & 15;
        const u32x4 w = *(const LAS u32x4*)(img + row * 256 + ((c ^ ((row >> 2) & 7)) << 4));
        *(u32x4*)(T.dst + (size_t)(T.n0 + row) * J.K + T.k0 + c * 8) = w; }
}
__device__ __forceinline__ void cvt_job(const Frame& F, const CvtJob& J, int t0, int nt) {
    for (int t = t0; t < nt; t += 2 * F.G) {
        const bool two = t + F.G < nt;
        const CvtTile A = cvt_locate(F, J, t), B = cvt_locate(F, J, two ? t + F.G : t);
        f32x4 va[8], vb[8];
        cvt_load(F, J, A, va); if (two) cvt_load(F, J, B, vb);
        cvt_to_lds(F, J, A, va, F.lds); if (two) cvt_to_lds(F, J, B, vb, F.lds + 32768);
        __syncthreads();
        cvt_from_lds(F, J, A, F.lds); if (two) cvt_from_lds(F, J, B, F.lds + 32768);
        __syncthreads();
    }
}
__device__ __forceinline__ void sincos_small(float r, float& s, float& c) {
    const float q = rintf(r * 0.63661977236758134f); const float y = fmaf(q, -1.5707963267948966f, r) + q * 4.371139e-8f; const int qi = (int)q & 3;
    const float y2 = y * y;
    const float sp = y + y * y2 * (-1.6666654611e-1f + y2 * (8.3321608736e-3f + y2 * (-1.9515295891e-4f)));
    const float cp = 1.0f - 0.5f * y2 + y2 * y2 * (4.166664568298827e-2f + y2 * (-1.388731625493765e-3f + y2 * 2.443315711809948e-5f));
    s = (qi == 0) ? sp : (qi == 1) ? cp : (qi == 2) ? -sp : -cp;
    c = (qi == 0) ? cp : (qi == 1) ? -sp : (qi == 2) ? -cp : sp;
}
__device__ __forceinline__ void ph_prologue(const Frame& F) {
    const Args& A = *F.a; GAS unsigned char* ws = F.ws;
    const float qscale = 0.07216878364870322f * 1.4426950408889634f;
    CvtJob J[10];
    J[0] = {GPTR(const float, A.in[I_PW1W]), (bf16_t*)(ws + WS_WPW1), 1024, 2048, 2048, 2048, CM_GLU, 1, 0, 0, 1.f, nullptr};
    J[1] = {GPTR(const float, A.in[I_PW2W]), (bf16_t*)(ws + WS_WPW2), 1024, 1024, 1024, 1024, CM_ID, 1, 0, 0, 1.f, nullptr};
    J[2] = {GPTR(const float, A.in[I_WDKV]), (bf16_t*)(ws + WS_WDKV), 1024, 320, 512, 320, CM_DKV, 1, 0, 0, 1.f, nullptr};
    J[3] = {GPTR(const float, A.in[I_WDQ]), (bf16_t*)(ws + WS_WDQ), 1024, 384, 512, 384, CM_ID, 1, 0, 0, 1.f, nullptr};
    J[4] = {GPTR(const float, A.in[I_WUK]), (bf16_t*)(ws + WS_WUK), 256, 1024, 1024, 1024, CM_ID, 1, 0, 0, 1.f, GPTR(const float, A.in[I_CKVG])};
    J[5] = {GPTR(const float, A.in[I_WUV]), (bf16_t*)(ws + WS_WUV), 256, 1024, 1024, 1024, CM_ID, 1, 0, 0, 1.f, GPTR(const float, A.in[I_CKVG])};
    J[6] = {GPTR(const float, A.in[I_WUQ]), (bf16_t*)(ws + WS_WUQ), 384, 1536, 1536, 1536, CM_UQ, 1, 0, 0, qscale, GPTR(const float, A.in[I_CQG])};
    J[7] = {GPTR(const float, A.in[I_WO]), (bf16_t*)(ws + WS_WO), 1024, 1024, 1024, 1024, CM_ID, 1, 0, 0, 1.f, nullptr};
    J[8] = {GPTR(const float, A.in[I_WGU]), (bf16_t*)(ws + WS_WGU), 1024, 2048, 2048, 2048, CM_GLU, 64, (size_t)1024 * 2048, (size_t)2048 * 1024, 1.f, nullptr};
    J[9] = {GPTR(const float, A.in[I_WDN]), (bf16_t*)(ws + WS_WDN), 1024, 1024, 1024, 1024, CM_ID, 64, (size_t)1024 * 1024, (size_t)1024 * 1024, 1.f, nullptr};
    int base = 0;
#pragma unroll
    for (int j = 0; j < 10; ++j) { const int nt = cvt_tiles(J[j]);
        int t = F.blk - (base % F.G); if (t < 0) t += F.G;
        cvt_job(F, J[j], t, nt);
        base += nt; }
    {
        LAS float* cact = (LAS float*)F.lds;
        LAS float* red = cact + 4096;
        for (int i = F.tid; i < NB * D; i += NTHR) { const float c = GPTR(const float, A.in[I_C])[i]; cact[i] = c * sigmoidf_(c); }
        __syncthreads();
        for (int it = F.blk; it < 2 * 96; it += F.G) {
            const int l = it / 96, j0 = (it - l * 96) * 64, col = F.tid & 63, dg = F.tid >> 6;
            const float* wp = GPTR(const float, A.in[I_MODW]) + (size_t)l * D * 6 * D + (size_t)(dg * 128) * (6 * D) + j0 + col;
            float a0 = 0.f, a1 = 0.f, a2 = 0.f, a3 = 0.f;
#pragma unroll 32
            for (int d = 0; d < 128; ++d) { const float w = wp[(size_t)d * (6 * D)]; const int dd = dg * 128 + d;
                a0 += w * cact[dd]; a1 += w * cact[1024 + dd]; a2 += w * cact[2048 + dd]; a3 += w * cact[3072 + dd]; }
            red[(dg * 4 + 0) * 64 + col] = a0; red[(dg * 4 + 1) * 64 + col] = a1; red[(dg * 4 + 2) * 64 + col] = a2; red[(dg * 4 + 3) * 64 + col] = a3;
            __syncthreads();
            if (F.tid < 256) { const int b = F.tid >> 6, c2 = F.tid & 63; float s = GPTR(const float, A.in[I_MODB])[l * 6 * D + j0 + c2];
#pragma unroll
                for (int g = 0; g < 8; ++g) s += red[(g * 4 + b) * 64 + c2];
                ((float*)(ws + WS_MOD))[(size_t)(l * NB + b) * (6 * D) + j0 + c2] = s; }
            __syncthreads();
        }
    }
    {
        const int* pos = (const int*)GPTR(const float, A.in[I_POS]); f32x2* cs = (f32x2*)(ws + WS_CS);
        for (int idx = F.blk * NTHR + F.tid; idx < NTOK * 32; idx += F.G * NTHR) {
            const int tok = idx >> 5, i = idx & 31;
            const double inv = exp(-(2.0 * 9.210340371976184 / 64.0) * (double)i);
            const double ang = (double)pos[tok] * inv, rev = ang * 0.15915494309189535, fr = rev - rint(rev);
            float s, c; sincos_small((float)(fr * 6.283185307179586), s, c);
            cs[idx] = (f32x2){c, s};
        }
    }
}

__device__ __forceinline__ void row_ld16(const float* p, int lane, f32x4 (&v)[4]) {
#pragma unroll
    for (int i = 0; i < 4; ++i) v[i] = *(const f32x4*)(p + i * 256 + lane * 4);
}
__device__ __forceinline__ void row_st16_bf16(bf16_t* p, int lane, const f32x4 (&v)[4]) {
#pragma unroll
    for (int i = 0; i < 4; ++i) { u32x2 w; w.x = cvt_pk_bf16(v[i][0], v[i][1]); w.y = cvt_pk_bf16(v[i][2], v[i][3]); *(u32x2*)(p + i * 256 + lane * 4) = w; }
}
__device__ __forceinline__ float row_rstd(const f32x4 (&v)[4]) {
    float s = 0.f;
#pragma unroll
    for (int i = 0; i < 4; ++i) s += v[i][0] * v[i][0] + v[i][1] * v[i][1] + v[i][2] * v[i][2] + v[i][3] * v[i][3];
    s = wave_sum(s);
    return rsqrtf(s * (1.0f / D) + EPS);
}

__device__ __forceinline__ void ph_norm1(const Frame& F) {
    const Args& A = *F.a; bf16_t* HA = (bf16_t*)(F.ws + WS_HA); const float* g = GPTR(const float, A.in[I_N1G]);
    for (int row = F.blk * NWAVE + F.wave; row < NTOK; row += F.G * NWAVE) {
        const int b = row / SEQ; f32x4 v[4], gv[4], sh[4], sc[4];
        row_ld16(GPTR(const float, A.in[I_X]) + (size_t)row * D, F.lane, v); row_ld16(g, F.lane, gv); row_ld16(modp(F, 0, b, 0), F.lane, sh); row_ld16(modp(F, 0, b, 1), F.lane, sc);
        const float rs = row_rstd(v);
#pragma unroll
        for (int i = 0; i < 4; ++i) v[i] = v[i] * rs * gv[i] * (sc[i] + 1.0f) + sh[i];
        row_st16_bf16(HA + (size_t)row * D, F.lane, v);
    }
}

__device__ __forceinline__ void ph_conv(const Frame& F) {
    const Args& A = *F.a; const bf16_t* U = (const bf16_t*)(F.ws + WS_HB); bf16_t* O = (bf16_t*)(F.ws + WS_HC);
    LAS unsigned char* tile = F.lds;
    LAS f32x2* part = (LAS f32x2*)(F.lds + 62 * 2048);
    LAS f32x2* red = part + 8 * NTHR;
    const int c2 = F.tid * 2;
    f32x2 w[CONVW];
#pragma unroll
    for (int j = 0; j < CONVW; ++j) w[j] = *(const f32x2*)(GPTR(const float, A.in[I_DWW]) + j * D + c2);
    const f32x2 db = *(const f32x2*)(GPTR(const float, A.in[I_DWB]) + c2), lg = *(const f32x2*)(GPTR(const float, A.in[I_LNG]) + c2), lb = *(const f32x2*)(GPTR(const float, A.in[I_LNB]) + c2);
    for (int t = F.blk; t < NTOK / 32; t += F.G) {
        const int tok0 = t * 32, s0 = tok0 % SEQ;
        for (int ch = F.tid; ch < 62 * 128; ch += NTHR) { const int r = ch >> 7, cc = ch & 127; u32x4 v = {0u, 0u, 0u, 0u};
            if (s0 + r - 30 >= 0) v = *(const u32x4*)(U + (size_t)(tok0 + r - 30) * D + cc * 8);
            *(LAS u32x4*)(tile + r * 2048 + cc * 16) = v; }
        __syncthreads();
#pragma unroll 1
        for (int g = 0; g < 4; ++g) {
            f32x2 acc[8];
#pragma unroll
            for (int r = 0; r < 8; ++r) acc[r] = db;
#pragma unroll
            for (int j = 0; j < 38; ++j) { const unsigned u = *(const LAS unsigned*)(tile + (g * 8 + j) * 2048 + F.tid * 4); const f32x2 x = {bflo(u), bfhi(u)};
#pragma unroll
                for (int r = 0; r < 8; ++r) { const int tap = j - r; if (tap >= 0 && tap < CONVW) acc[r] += x * w[tap]; } }
#pragma unroll
            for (int r = 0; r < 8; ++r) part[r * NTHR + F.tid] = (f32x2){acc[r][0] + acc[r][1], acc[r][0] * acc[r][0] + acc[r][1] * acc[r][1]};
            __syncthreads();
            { float s = 0.f, q = 0.f;
#pragma unroll
              for (int i = 0; i < 8; ++i) { const f32x2 p = part[F.wave * NTHR + i * 64 + F.lane]; s += p[0]; q += p[1]; }
              s = wave_sum(s); q = wave_sum(q);
              if (F.lane == 0) { const float mean = s * (1.0f / D), var = fmaxf(q * (1.0f / D) - mean * mean, 0.f); red[F.wave] = (f32x2){mean, rsqrtf(var + EPS)}; } }
            __syncthreads();
#pragma unroll
            for (int r = 0; r < 8; ++r) { const f32x2 st = red[r]; const float mean = st[0], rs = st[1];
                const float y0 = (acc[r][0] - mean) * rs * lg[0] + lb[0], y1 = (acc[r][1] - mean) * rs * lg[1] + lb[1];
                *(unsigned*)(O + (size_t)(tok0 + g * 8 + r) * D + c2) = cvt_pk_bf16(y0 * sigmoidf_(y0), y1 * sigmoidf_(y1)); }
            __syncthreads();
        }
    }
}

__device__ __forceinline__ void ph_router_prep(const Frame& F) {
    const Args& A = *F.a; bf16_t* rwf = (bf16_t*)(F.ws + WS_RWF); float* rbias = (float*)(F.ws + WS_RBIAS);
    for (int it = F.blk; it < 8 * 64; it += F.G) {
        const int lb = it >> 6, s = it & 63, l = lb >> 2, b = lb & 3, hh = F.tid >> 8, e = (F.tid >> 3) & 31, j = F.tid & 7, k = 16 * s + 8 * hh + j;
        const float v = GPTR(const float, A.in[I_N2G])[l * D + k] * (1.0f + modp(F, l, b, 4)[k]) * GPTR(const float, A.in[I_RW])[(size_t)l * D * NE + k * NE + e];
        const unsigned hi = cvt_pk_bf16(v, 0.f) & 0xffffu; const float rem = v - bflo(hi); const unsigned lo = cvt_pk_bf16(rem, 0.f) & 0xffffu;
        const size_t o = ((size_t)lb * 2 * 64 * 2 * 32 + ((size_t)s * 2 + hh) * 32 + e) * 8 + j;
        rwf[o] = (bf16_t)hi; rwf[o + (size_t)64 * 2 * 32 * 8] = (bf16_t)lo;
    }
    if (F.blk < 8) { const int l = F.blk >> 2, b = F.blk & 3, e = F.tid >> 4, q = F.tid & 15; float s = 0.f;
        for (int k = q; k < D; k += 16) s += modp(F, l, b, 3)[k] * GPTR(const float, A.in[I_RW])[(size_t)l * D * NE + k * NE + e];
        s += __shfl_xor(s, 8); s += __shfl_xor(s, 4); s += __shfl_xor(s, 2); s += __shfl_xor(s, 1);
        if (q == 0) rbias[F.blk * NE + e] = s + GPTR(const float, A.in[I_RB])[l * NE + e]; }
}

__device__ __forceinline__ void ph_router(const Frame& F, int l) {
    const Args& A = *F.a; const bf16_t* X = (const bf16_t*)(F.ws + WS_X); bf16_t* HA = (bf16_t*)(F.ws + WS_HA);
    const int ntok_blk = NTOK / F.G, tok0 = F.blk * ntok_blk, b = tok0 / SEQ;
    LAS unsigned char* wl_ = F.lds;
    LAS int* cnt = (LAS int*)(F.lds + 131072 + 2304);
    LAS float* cx = (LAS float*)(F.lds + 135168);
    LAS float* sq = (LAS float*)(F.lds + 135168 + 16384);
    { const u32x4* src = (const u32x4*)(F.ws + WS_RWF + (size_t)(l * NB + b) * 131072);
      for (int i = F.tid; i < 131072 / 16; i += NTHR) *(LAS u32x4*)(wl_ + i * 16) = src[i]; }
    if (F.tid < NE) cnt[F.tid] = 0;
    __syncthreads();
    const int w = F.wave, lane = F.lane, grp = w & 3, kh = w >> 2, r = lane & 31, hi = lane >> 5;
    {
        const bf16_t* xr = X + (size_t)(tok0 + grp * 32 + r) * D + kh * 512 + hi * 8;
        const LAS unsigned char* bw = wl_ + ((kh * 32 * 2 + hi) * 32 + r) * 16;
        f32x16 acc;
#pragma unroll
        for (int i = 0; i < 16; ++i) acc[i] = 0.f;
        float ssq = 0.f;
        u32x4 xa[8], xb[8];
#define RT_LD(dst, s0) do { _Pragma("unroll") for (int u = 0; u < 8; ++u) dst[u] = *(const u32x4*)(xr + ((s0) + u) * 16); } while (0)
#define RT_DO(src, s0) do { _Pragma("unroll") for (int u = 0; u < 8; ++u) { const u32x4 xw = src[u]; \
            { const float a0 = bflo(xw.x), a1 = bfhi(xw.x), a2 = bflo(xw.y), a3 = bfhi(xw.y), a4 = bflo(xw.z), a5 = bfhi(xw.z), a6 = bflo(xw.w), a7 = bfhi(xw.w); \
              ssq += (a0 * a0 + a1 * a1) + (a2 * a2 + a3 * a3) + (a4 * a4 + a5 * a5) + (a6 * a6 + a7 * a7); } \
            const bf16x8 ah = *(const bf16x8*)&xw; \
            const bf16x8 bh = *(const LAS bf16x8*)(bw + ((s0) + u) * 1024), bl = *(const LAS bf16x8*)(bw + ((s0) + u) * 1024 + 65536); \
            acc = __builtin_amdgcn_mfma_f32_32x32x16_bf16(ah, bh, acc, 0, 0, 0); acc = __builtin_amdgcn_mfma_f32_32x32x16_bf16(ah, bl, acc, 0, 0, 0); } } while (0)
        RT_LD(xa, 0);
#pragma unroll 1
        for (int s0 = 0; s0 < 32; s0 += 16) { RT_LD(xb, s0 + 8); RT_DO(xa, s0); if (s0 + 16 < 32) RT_LD(xa, s0 + 16); RT_DO(xb, s0 + 8); }
#undef RT_LD
#undef RT_DO
        sq[(grp * 32 + r) * 4 + kh * 2 + hi] = ssq;
        if (kh == 1) { LAS float* c = cx + (grp * 64 + lane) * 16;
#pragma unroll
            for (int i = 0; i < 4; ++i) *(LAS f32x4*)(c + i * 4) = (f32x4){acc[4 * i], acc[4 * i + 1], acc[4 * i + 2], acc[4 * i + 3]}; }
        __syncthreads();
        if (kh == 0) { const LAS float* c = cx + (grp * 64 + lane) * 16;
#pragma unroll
            for (int i = 0; i < 4; ++i) { const f32x4 p = *(const LAS f32x4*)(c + i * 4); acc[4 * i] += p[0]; acc[4 * i + 1] += p[1]; acc[4 * i + 2] += p[2]; acc[4 * i + 3] += p[3]; } }
        __syncthreads();
        if (kh == 0) {
#pragma unroll
            for (int i = 0; i < 16; ++i) cx[(grp * 32 + (i & 3) + 8 * (i >> 2) + 4 * hi) * 32 + r] = acc[i]; }
        __syncthreads();
    }
    int* topi = (int*)(F.ws + WS_TOPI); float* gate = (float*)(F.ws + WS_GATE); int* rank = (int*)(F.ws + WS_RANK);
    if (F.tid < 128) {
        const int row = tok0 + F.tid; const f32x4 q4 = *(const LAS f32x4*)(sq + F.tid * 4);
        const float rs = rsqrtf(((q4[0] + q4[1]) + (q4[2] + q4[3])) * (1.0f / D) + EPS); sq[512 + F.tid] = rs;
        const float* bias = (const float*)(F.ws + WS_RBIAS) + (l * NB + b) * NE;
        float lg[NE];
#pragma unroll
        for (int i = 0; i < 8; ++i) { const f32x4 c = *(const LAS f32x4*)(cx + F.tid * 32 + i * 4), bb = *(const f32x4*)(bias + i * 4);
            lg[4 * i] = c[0] * rs + bb[0]; lg[4 * i + 1] = c[1] * rs + bb[1]; lg[4 * i + 2] = c[2] * rs + bb[2]; lg[4 * i + 3] = c[3] * rs + bb[3]; }
        float tv[4]; int ti[4];
#pragma unroll
        for (int k = 0; k < 4; ++k) { float bv = lg[0]; int bi = 0;
#pragma unroll
            for (int e2 = 1; e2 < NE; ++e2) { if (lg[e2] > bv) { bv = lg[e2]; bi = e2; } }
            tv[k] = bv; ti[k] = bi;
#pragma unroll
            for (int e2 = 0; e2 < NE; ++e2) lg[e2] = (e2 == bi) ? -__builtin_inff() : lg[e2]; }
        const float e1 = __expf(tv[1] - tv[0]), e2 = __expf(tv[2] - tv[0]), e3 = __expf(tv[3] - tv[0]), inv = 1.0f / (1.0f + e1 + e2 + e3);
        *(f32x4*)(gate + (size_t)row * 4) = (f32x4){inv, e1 * inv, e2 * inv, e3 * inv};
        int4 tq, rq; tq.x = ti[0]; tq.y = ti[1]; tq.z = ti[2]; tq.w = ti[3];
        rq.x = __hip_atomic_fetch_add(&cnt[ti[0]], 1, __ATOMIC_RELAXED, __HIP_MEMORY_SCOPE_WORKGROUP); rq.y = __hip_atomic_fetch_add(&cnt[ti[1]], 1, __ATOMIC_RELAXED, __HIP_MEMORY_SCOPE_WORKGROUP);
        rq.z = __hip_atomic_fetch_add(&cnt[ti[2]], 1, __ATOMIC_RELAXED, __HIP_MEMORY_SCOPE_WORKGROUP); rq.w = __hip_atomic_fetch_add(&cnt[ti[3]], 1, __ATOMIC_RELAXED, __HIP_MEMORY_SCOPE_WORKGROUP);
        *(int4*)(topi + (size_t)row * 4) = tq; *(int4*)(rank + (size_t)row * 4) = rq;
    }
    __syncthreads();
    if (F.tid < NE) ((int*)(F.ws + WS_BLKCNT))[(l * 256 + F.blk) * NE + F.tid] = cnt[F.tid];
    { const float* g = GPTR(const float, A.in[I_N2G]) + l * D; f32x4 gv[4], sh[4], sc[4];
      row_ld16(g, F.lane, gv); row_ld16(modp(F, l, b, 3), F.lane, sh); row_ld16(modp(F, l, b, 4), F.lane, sc);
#pragma unroll
      for (int i = 0; i < 4; ++i) gv[i] = gv[i] * (sc[i] + 1.0f);
      for (int it = F.wave; it < ntok_blk; it += 2 * NWAVE) { const bool two = it + NWAVE < ntok_blk;
          u32x2 w0[4], w1[4];
#pragma unroll
          for (int i = 0; i < 4; ++i) { w0[i] = *(const u32x2*)(X + (size_t)(tok0 + it) * D + i * 256 + F.lane * 4); if (two) w1[i] = *(const u32x2*)(X + (size_t)(tok0 + it + NWAVE) * D + i * 256 + F.lane * 4); }
          const float r0 = sq[512 + it], r1 = two ? sq[512 + it + NWAVE] : 0.f;
          f32x4 v0[4], v1[4];
#pragma unroll
          for (int i = 0; i < 4; ++i) v0[i] = (f32x4){bflo(w0[i].x), bfhi(w0[i].x), bflo(w0[i].y), bfhi(w0[i].y)} * r0 * gv[i] + sh[i];
          row_st16_bf16(HA + (size_t)(tok0 + it) * D, F.lane, v0);
          if (two) {
#pragma unroll
              for (int i = 0; i < 4; ++i) v1[i] = (f32x4){bflo(w1[i].x), bfhi(w1[i].x), bflo(w1[i].y), bfhi(w1[i].y)} * r1 * gv[i] + sh[i];
              row_st16_bf16(HA + (size_t)(tok0 + it + NWAVE) * D, F.lane, v1); } } }
    __syncthreads();
}

__device__ __forceinline__ void ph_scatter(const Frame& F, int l) {
    LAS int* part = (LAS int*)F.lds;
    LAS int* basee = part + 1024;
    const int* bc = (const int*)(F.ws + WS_BLKCNT) + l * 256 * NE;
    { const int e = F.tid & 31, pt = F.tid >> 5; int pre = 0, tot = 0;
      for (int b = pt * 16; b < pt * 16 + 16 && b < F.G; ++b) { const int c = bc[b * NE + e]; tot += c; if (b < F.blk) pre += c; }
      part[pt * 32 + e] = pre; part[512 + pt * 32 + e] = tot; }
    __syncthreads();
    if (F.tid < NE) { int pre = 0, tot = 0;
        for (int pt = 0; pt < 16; ++pt) { pre += part[pt * 32 + F.tid]; tot += part[512 + pt * 32 + F.tid]; }
        part[F.tid] = pre; part[512 + F.tid] = tot; }
    __syncthreads();
    if (F.tid == 0) { int ps = 0; int* bexp = (int*)(F.ws + WS_BEXP) + l * 1024;
        for (int e = 0; e < NE; ++e) { const int padded = (part[512 + e] + EBLK - 1) / EBLK * EBLK; basee[e] = ps + part[e];
            if (F.blk == 0) for (int i = ps / EBLK; i < (ps + padded) / EBLK; ++i) bexp[1 + i] = e;
            ps += padded; }
        if (F.blk == 0) bexp[0] = ps / EBLK; }
    __syncthreads();
    const int* topi = (const int*)(F.ws + WS_TOPI); const int* rank = (const int*)(F.ws + WS_RANK); int* slot = (int*)(F.ws + WS_SLOT); int* rowtab = (int*)(F.ws + WS_ROWTAB);
    const int ntok_blk = NTOK / F.G;
    for (int it = F.tid; it < ntok_blk * 4 * 8; it += NTHR) {
        const int idx = F.blk * ntok_blk * 4 + (it >> 3), c8 = it & 7, s = basee[topi[idx]] + rank[idx];
        if (c8 == 0) slot[idx] = s;
        const int pm = s >> 8, r = s & 255, hh = r >> 7, R = r & 127, b = pg8::lds_byte(R, c8 * 8), pi = b >> 13, lt = (b & 8191) >> 4;
        rowtab[(((size_t)pm * 512 + lt) * 2 + hh) * 2 + pi] = idx >> 2;
    }
}

__device__ __forceinline__ void ph_combine(const Frame& F, int l) {
    const Args& A = *F.a; const bf16_t* X = (const bf16_t*)(F.ws + WS_X); bf16_t* XO = (bf16_t*)(F.ws + WS_X2); const bf16_t* Y = (const bf16_t*)(F.ws + WS_XG);
    const int* slot = (const int*)(F.ws + WS_SLOT); const float* gate = (const float*)(F.ws + WS_GATE);
    const int stride = F.G * NWAVE; int row = F.blk * NWAVE + F.wave;
    if (row >= NTOK) return;
    int4 sq_c = *(const int4*)(slot + (size_t)row * 4); f32x4 gq_c = *(const f32x4*)(gate + (size_t)row * 4);
    int4 sq_n = sq_c; f32x4 gq_n = gq_c;
    if (row + stride < NTOK) { sq_n = *(const int4*)(slot + (size_t)(row + stride) * 4); gq_n = *(const f32x4*)(gate + (size_t)(row + stride) * 4); }
    u32x4 yc[4][2], yn[4][2]; f32x4 xc[4], xn[4];
#define CMB_LOAD(yv, xq, sq, r_) do { const int ss_[4] = {sq.x, sq.y, sq.z, sq.w}; \
        _Pragma("unroll") for (int k = 0; k < 4; ++k) _Pragma("unroll") for (int i = 0; i < 2; ++i) yv[k][i] = *(const u32x4*)(Y + (size_t)ss_[k] * D + i * 512 + F.lane * 8); \
        _Pragma("unroll") for (int i = 0; i < 2; ++i) { const u32x4 xw_ = *(const u32x4*)(X + (size_t)(r_) * D + i * 512 + F.lane * 8); \
            xq[i * 2] = (f32x4){bflo(xw_.x), bfhi(xw_.x), bflo(xw_.y), bfhi(xw_.y)}; xq[i * 2 + 1] = (f32x4){bflo(xw_.z), bfhi(xw_.z), bflo(xw_.w), bfhi(xw_.w)}; } } while (0)
    CMB_LOAD(yc, xc, sq_c, row);
    for (; row < NTOK; row += stride) {
        const int b = row / SEQ; const bool has_n = row + stride < NTOK;
        const f32x4 gq = gq_c;
        if (has_n) CMB_LOAD(yn, xn, sq_n, row + stride);
        int4 sq_nn = sq_n; f32x4 gq_nn = gq_n;
        if (row + 2 * stride < NTOK) { sq_nn = *(const int4*)(slot + (size_t)(row + 2 * stride) * 4); gq_nn = *(const f32x4*)(gate + (size_t)(row + 2 * stride) * 4); }
        float acc[16];
#pragma unroll
        for (int i = 0; i < 16; ++i) acc[i] = 0.f;
#pragma unroll
        for (int k = 0; k < 4; ++k) { const float gk = gq[k];
#pragma unroll
            for (int i = 0; i < 2; ++i) { const u32x4 w = yc[k][i];
                acc[i * 8 + 0] += gk * bflo(w.x); acc[i * 8 + 1] += gk * bfhi(w.x); acc[i * 8 + 2] += gk * bflo(w.y); acc[i * 8 + 3] += gk * bfhi(w.y);
                acc[i * 8 + 4] += gk * bflo(w.z); acc[i * 8 + 5] += gk * bfhi(w.z); acc[i * 8 + 6] += gk * bflo(w.w); acc[i * 8 + 7] += gk * bfhi(w.w); } }
        const float* g2 = modp(F, l, b, 5);
        float xv[16]; float ssq = 0.f;
#pragma unroll
        for (int i = 0; i < 2; ++i)
#pragma unroll
            for (int h = 0; h < 2; ++h) { const int c = i * 512 + F.lane * 8 + h * 4; const f32x4 x0 = xc[i * 2 + h], gg = *(const f32x4*)(g2 + c);
#pragma unroll
                for (int j = 0; j < 4; ++j) { const float x = x0[j] + gg[j] * acc[i * 8 + h * 4 + j]; xv[i * 8 + h * 4 + j] = x; ssq += x * x; } }
        ssq = wave_sum(ssq); const float rs = rsqrtf(ssq * (1.0f / D) + EPS);
        if (l == 0) {
            bf16_t* HB = (bf16_t*)(F.ws + WS_HB); bf16_t* HA = (bf16_t*)(F.ws + WS_HA);
            const float* kvg = GPTR(const float, A.in[I_KVG]); const float* g1 = GPTR(const float, A.in[I_N1G]) + D; const float* sh = modp(F, 1, b, 0); const float* sc = modp(F, 1, b, 1);
#pragma unroll
            for (int i = 0; i < 2; ++i) { const int c = i * 512 + F.lane * 8; float o1[8], o2[8];
#pragma unroll
                for (int h = 0; h < 2; ++h) { const f32x4 kg = *(const f32x4*)(kvg + c + h * 4), gg = *(const f32x4*)(g1 + c + h * 4), s1 = *(const f32x4*)(sh + c + h * 4), s2 = *(const f32x4*)(sc + c + h * 4);
#pragma unroll
                    for (int j = 0; j < 4; ++j) { const float xh = xv[i * 8 + h * 4 + j] * rs; o1[h * 4 + j] = xh * kg[j]; o2[h * 4 + j] = xh * gg[j] * (s2[j] + 1.0f) + s1[j]; } }
                u32x4 w1, w2; w1.x = cvt_pk_bf16(o1[0], o1[1]); w1.y = cvt_pk_bf16(o1[2], o1[3]); w1.z = cvt_pk_bf16(o1[4], o1[5]); w1.w = cvt_pk_bf16(o1[6], o1[7]);
                w2.x = cvt_pk_bf16(o2[0], o2[1]); w2.y = cvt_pk_bf16(o2[2], o2[3]); w2.z = cvt_pk_bf16(o2[4], o2[5]); w2.w = cvt_pk_bf16(o2[6], o2[7]);
                u32x4 w0; w0.x = cvt_pk_bf16(xv[i * 8], xv[i * 8 + 1]); w0.y = cvt_pk_bf16(xv[i * 8 + 2], xv[i * 8 + 3]); w0.z = cvt_pk_bf16(xv[i * 8 + 4], xv[i * 8 + 5]); w0.w = cvt_pk_bf16(xv[i * 8 + 6], xv[i * 8 + 7]);
                *(u32x4*)(XO + (size_t)row * D + c) = w0; *(u32x4*)(HB + (size_t)row * D + c) = w1; *(u32x4*)(HA + (size_t)row * D + c) = w2; }
        } else {
            const float* fg = GPTR(const float, A.in[I_FG]);
#pragma unroll
            for (int i = 0; i < 2; ++i)
#pragma unroll
                for (int h = 0; h < 2; ++h) { const int c = i * 512 + F.lane * 8 + h * 4; const f32x4 gg = *(const f32x4*)(fg + c);
                    *(f32x4*)(GPTR(float, A.out) + (size_t)row * D + c) = (f32x4){xv[i * 8 + h * 4] * rs * gg[0], xv[i * 8 + h * 4 + 1] * rs * gg[1], xv[i * 8 + h * 4 + 2] * rs * gg[2], xv[i * 8 + h * 4 + 3] * rs * gg[3]}; }
        }
#pragma unroll
        for (int k = 0; k < 4; ++k) { yc[k][0] = yn[k][0]; yc[k][1] = yn[k][1]; xc[k] = xn[k]; }
        sq_c = sq_n; gq_c = gq_n; sq_n = sq_nn; gq_n = gq_nn;
    }
#undef CMB_LOAD
}

__device__ __forceinline__ void ph_latpost(const Frame& F) {
    const Args& A = *F.a; const float* LAT = (const float*)(F.ws + WS_LAT); const float* CQP = (const float*)(F.ws + WS_CQP);
    bf16_t* CKV = (bf16_t*)(F.ws + WS_CKV); bf16_t* KR = (bf16_t*)(F.ws + WS_KR); bf16_t* CQ = (bf16_t*)(F.ws + WS_CQ); const f32x2* cs = (const f32x2*)(F.ws + WS_CS);
    for (int row = F.blk * NWAVE + F.wave; row < NTOK; row += F.G * NWAVE) {
        const float* lr = LAT + (size_t)row * 512;
        { const f32x4 v = *(const f32x4*)(lr + F.lane * 4), g = *(const f32x4*)(GPTR(const float, A.in[I_CKVG]) + F.lane * 4);
          float s = wave_sum(v[0] * v[0] + v[1] * v[1] + v[2] * v[2] + v[3] * v[3]); const float rs = rsqrtf(s * (1.0f / KVLORA) + EPS);
          u32x2 w; w.x = cvt_pk_bf16(v[0] * rs * g[0], v[1] * rs * g[1]); w.y = cvt_pk_bf16(v[2] * rs * g[2], v[3] * rs * g[3]); *(u32x2*)(CKV + (size_t)row * KVLORA + F.lane * 4) = w; }
        if (F.lane < 32) { const int i = F.lane; const float x1 = lr[KVLORA + i], x2 = lr[KVLORA + 32 + i]; const f32x2 t = cs[(size_t)row * 32 + i];
          const float r1 = x1 * t[0] - x2 * t[1], r2 = x2 * t[0] + x1 * t[1]; const int p = (i >> 2) * 8 + (i & 3);
          KR[(size_t)row * DROPE + p] = (bf16_t)(cvt_pk_bf16(r1, r1) & 0xffffu); KR[(size_t)row * DROPE + p + 4] = (bf16_t)(cvt_pk_bf16(r2, r2) & 0xffffu); }
        { const float* qr = CQP + (size_t)row * 512; f32x2 v[3]; float s = 0.f;
#pragma unroll
          for (int i = 0; i < 3; ++i) { v[i] = *(const f32x2*)(qr + i * 128 + F.lane * 2); s += v[i][0] * v[i][0] + v[i][1] * v[i][1]; }
          s = wave_sum(s); const float rs = rsqrtf(s * (1.0f / QLORA) + EPS);
#pragma unroll
          for (int i = 0; i < 3; ++i) { const f32x2 g = *(const f32x2*)(GPTR(const float, A.in[I_CQG]) + i * 128 + F.lane * 2);
              *(unsigned*)(CQ + (size_t)row * QLORA + i * 128 + F.lane * 2) = cvt_pk_bf16(v[i][0] * rs * g[0], v[i][1] * rs * g[1]); } }
    }
}
constexpr int AT_KB = 24576, AT_VB0 = 49152, AT_VB = 16384;
#define AT_UPTR(p) ({ const GAS char* p_ = (const GAS char*)(p); asm volatile("" : "+s"(p_)); p_; })
#define AT_BAR() do { asm volatile("s_waitcnt lgkmcnt(0)" ::: "memory"); __builtin_amdgcn_s_barrier(); asm volatile("" ::: "memory"); } while (0)
#define AT_SB() __builtin_amdgcn_sched_barrier(0x6)
__device__ __forceinline__ void at_glds16(unsigned voff, const GAS char* sbase, unsigned lds_dst) {
    unsigned keep;
    asm volatile("s_mov_b32 %0, m0\n\ts_mov_b32 m0, %3\n\ts_nop 0\n\tglobal_load_lds_dwordx4 %1, %2\n\ts_mov_b32 m0, %0" : "=&s"(keep) : "v"(voff), "s"(sbase), "s"(lds_dst) : "memory");
}
#define AT_GLDS(sbase, voff, dstoff) at_glds16((voff), (sbase), ldsb_ + (unsigned)(dstoff))

__device__ __forceinline__ int swap23(int k) { return (k & ~0xC) | ((k & 4) << 1) | ((k & 8) >> 1); }

#if !NAIVE_ATTN
template <int VAR>
__device__ __forceinline__ void ph_attn(const Frame& F) {
    const char* Qg = (const char*)(F.ws + WS_Q); const char* KNg = (const char*)(F.ws + WS_KN); const char* KRg = (const char*)(F.ws + WS_KR); const char* VTg = (const char*)(F.ws + WS_VT);
    bf16_t* Og = (bf16_t*)(F.ws + (VAR == 0 ? WS_HC : WS_HB));
    const int lane = F.lane, w = F.wave, r32 = lane & 31, hi = lane >> 5;
    const unsigned ldsb_ = (unsigned)(size_t)F.lds;
    unsigned offK[3], offVt[2];
#pragma unroll
    for (int i = 0; i < 3; ++i) { const int g = (i * 8 + w) * 64 + lane, d0 = g >> 7, rho = (g & 127) >> 1, hh = (g & 1) ^ ((rho >> 3) & 1), key = swap23(rho);
        offK[i] = d0 < 8 ? (unsigned)key * 2048u + (unsigned)(d0 * 32 + hh * 16) : (unsigned)key * 128u + (unsigned)((d0 - 8) * 32 + hh * 16); }
#pragma unroll
    for (int i = 0; i < 2; ++i) { const int g = (i * 8 + w) * 64 + lane, ks = g >> 8, d = (g & 255) >> 1, hh = (g & 1) ^ ((d >> 3) & 1);
        offVt[i] = (unsigned)d * (unsigned)(NTOK * 2) + (unsigned)(ks * 32 + hh * 16); }
    const int rdoff = r32 * 32 + ((hi ^ ((r32 >> 3) & 1)) << 4);
    for (int item = F.blk; item < 512; item += F.G) {
        const int xcd = item & 7, kk = item >> 3, bh = xcd * 4 + (kk >> 4), x = kk & 15, b = bh >> 3, h = bh & 7;
#pragma unroll 1
        for (int pass = 0; pass < 2; ++pass) {
            const int j = pass ? 31 - x : x, NT = 4 * j + 4, cw = 4 * j + (w >> 1);
            const size_t tokb = (size_t)b * SEQ;
            const char* knb = KNg + tokb * 2048 + h * 256; const char* krb = KRg + tokb * 128; const char* vtb = VTg + ((size_t)h * 128 * NTOK + tokb) * 2;
            bf16x8 qr[12];
            { const GAS char* qp = AT_UPTR(Qg + (tokb + (size_t)j * 256 + w * 32) * (NH * DQK * 2) + h * (DQK * 2)) + (unsigned)(r32 * (NH * DQK * 2) + hi * 16);
#pragma unroll
              for (int d0 = 0; d0 < 12; ++d0) qr[d0] = *(const bf16x8*)(qp + d0 * 32);
              const float* csr = (const float*)(AT_UPTR((const float*)(F.ws + WS_CS) + (tokb + (size_t)j * 256 + w * 32) * 64) + (unsigned)(r32 * 256));
#pragma unroll
              for (int dd = 0; dd < 4; ++dd) { const int k4 = (dd * 2 + hi) * 4; const f32x4 t0 = *(const f32x4*)(csr + 2 * k4), t1 = *(const f32x4*)(csr + 2 * k4 + 4);
                  const u32x4 wq = *(const u32x4*)&qr[8 + dd];
                  const float x1[4] = {bflo(wq.x), bfhi(wq.x), bflo(wq.y), bfhi(wq.y)}, x2[4] = {bflo(wq.z), bfhi(wq.z), bflo(wq.w), bfhi(wq.w)};
                  const float co[4] = {t0[0], t0[2], t1[0], t1[2]}, si[4] = {t0[1], t0[3], t1[1], t1[3]}; float r1[4], r2[4];
#pragma unroll
                  for (int jj = 0; jj < 4; ++jj) { r1[jj] = x1[jj] * co[jj] - x2[jj] * si[jj]; r2[jj] = x2[jj] * co[jj] + x1[jj] * si[jj]; }
                  u32x4 wo = {cvt_pk_bf16(r1[0], r1[1]), cvt_pk_bf16(r1[2], r1[3]), cvt_pk_bf16(r2[0], r2[1]), cvt_pk_bf16(r2[2], r2[3])}; qr[8 + dd] = *(bf16x8*)&wo; } }
            f32x16 o[4];
#pragma unroll
            for (int d0 = 0; d0 < 4; ++d0)
#pragma unroll
                for (int r = 0; r < 16; ++r) o[d0][r] = 0.f;
            float m_run = -1e30f, l_run = 0.f;
#define AT_ISSUE_K(t, st) do { const int t_ = (t); \
                const GAS char* kp_ = AT_UPTR(knb + (size_t)t_ * (64 * 2048)); const GAS char* rp_ = AT_UPTR(krb + (size_t)t_ * (64 * 128)); \
                AT_GLDS(kp_, offK[0], (st) + w * 1024); AT_GLDS(kp_, offK[1], (st) + (8 + w) * 1024); \
                AT_GLDS(rp_, offK[2], (st) + (16 + w) * 1024); } while (0)
#define AT_ISSUE_V(t, st) do { const int t_ = (t); \
                const GAS char* vp_ = AT_UPTR(vtb + (size_t)t_ * 128); \
                AT_GLDS(vp_, offVt[0], AT_VB0 + (st) + w * 1024); AT_GLDS(vp_, offVt[1], AT_VB0 + (st) + (8 + w) * 1024); } while (0)
#define AT_DSRD(dst, ad, off) asm volatile("ds_read_b128 %0, %1 offset:%2" : "=v"(dst) : "v"(ad), "i"(off))
#define AT_LGKM(n) asm volatile("s_waitcnt lgkmcnt(%0)" :: "i"(n))
#define AT_SB0() __builtin_amdgcn_sched_barrier(0)
#define AT_KR(d_, x0, x1) do { AT_DSRD(x0, kad_, (d_) * 2048); AT_DSRD(x1, kad_, (d_) * 2048 + 1024); } while (0)
#define AT_MM(x0, x1, q_, PN0, PN1) do { AT_SB0(); __builtin_amdgcn_s_setprio(1); PN0 = __builtin_amdgcn_mfma_f32_32x32x16_bf16(x0, q_, PN0, 0, 0, 0); PN1 = __builtin_amdgcn_mfma_f32_32x32x16_bf16(x1, q_, PN1, 0, 0, 0); __builtin_amdgcn_s_setprio(0); AT_SB0(); } while (0)
#define AT_E1(PC0, PC1, e_) do { if ((e_) < 16) { PC0[(e_) & 15] = __builtin_amdgcn_exp2f(PC0[(e_) & 15] - m_run); ps_ += PC0[(e_) & 15]; } else if ((e_) < 32) { PC1[(e_) & 15] = __builtin_amdgcn_exp2f(PC1[(e_) & 15] - m_run); ps_ += PC1[(e_) & 15]; } } while (0)
#define AT_EX(PC0, PC1, i_) do { if (SM) { AT_E1(PC0, PC1, 3 * (i_)); AT_E1(PC0, PC1, 3 * (i_) + 1); AT_E1(PC0, PC1, 3 * (i_) + 2); } } while (0)
#define AT_QKX(st, P0, P1) do { \
                const unsigned kad_ = (unsigned)(size_t)((const LAS char*)F.lds + (st) + rdoff); \
                bf16x8 ka0, ka1, kb0, kb1, kc0, kc1; \
                AT_KR(0, ka0, ka1); AT_KR(1, kb0, kb1); \
                _Pragma("unroll") for (int r = 0; r < 16; ++r) { P0[r] = 0.f; P1[r] = 0.f; } \
                AT_KR(2, kc0, kc1); AT_LGKM(4); AT_MM(ka0, ka1, qr[0], P0, P1); \
                AT_KR(3, ka0, ka1); AT_LGKM(4); AT_MM(kb0, kb1, qr[1], P0, P1); \
                AT_KR(4, kb0, kb1); AT_LGKM(4); AT_MM(kc0, kc1, qr[2], P0, P1); \
                AT_KR(5, kc0, kc1); AT_LGKM(4); AT_MM(ka0, ka1, qr[3], P0, P1); \
                AT_KR(6, ka0, ka1); AT_LGKM(4); AT_MM(kb0, kb1, qr[4], P0, P1); \
                AT_KR(7, kb0, kb1); AT_LGKM(4); AT_MM(kc0, kc1, qr[5], P0, P1); \
                AT_KR(8, kc0, kc1); AT_LGKM(4); AT_MM(ka0, ka1, qr[6], P0, P1); \
                AT_KR(9, ka0, ka1); AT_LGKM(4); AT_MM(kb0, kb1, qr[7], P0, P1); \
                AT_KR(10, kb0, kb1); AT_LGKM(4); AT_MM(kc0, kc1, qr[8], P0, P1); \
                AT_KR(11, kc0, kc1); AT_LGKM(4); AT_MM(ka0, ka1, qr[9], P0, P1); \
                AT_LGKM(2); AT_MM(kb0, kb1, qr[10], P0, P1); \
                AT_LGKM(0); AT_MM(kc0, kc1, qr[11], P0, P1); } while (0)
#define AT_VR(ks_, v0, v1, v2, v3) do { AT_DSRD(v0, vad_, (ks_) * 4096); AT_DSRD(v1, vad_, (ks_) * 4096 + 1024); AT_DSRD(v2, vad_, (ks_) * 4096 + 2048); AT_DSRD(v3, vad_, (ks_) * 4096 + 3072); } while (0)
#define AT_PF(PX, b8) ({ u32x4 tp_ = {cvt_pk_bf16(PX[b8], PX[b8 + 1]), cvt_pk_bf16(PX[b8 + 2], PX[b8 + 3]), cvt_pk_bf16(PX[b8 + 4], PX[b8 + 5]), cvt_pk_bf16(PX[b8 + 6], PX[b8 + 7])}; *(bf16x8*)&tp_; })
#define AT_M4(pf_, v0, v1, v2, v3) do { AT_SB0(); __builtin_amdgcn_s_setprio(1); o[0] = __builtin_amdgcn_mfma_f32_32x32x16_bf16(v0, pf_, o[0], 0, 0, 0); o[1] = __builtin_amdgcn_mfma_f32_32x32x16_bf16(v1, pf_, o[1], 0, 0, 0); \
                o[2] = __builtin_amdgcn_mfma_f32_32x32x16_bf16(v2, pf_, o[2], 0, 0, 0); o[3] = __builtin_amdgcn_mfma_f32_32x32x16_bf16(v3, pf_, o[3], 0, 0, 0); __builtin_amdgcn_s_setprio(0); AT_SB0(); } while (0)
#define AT_MX8(PX, b8) do { _Pragma("unroll") for (int r = 0; r < 8; ++r) mxn_ = fmaxf(mxn_, PX[(b8) + r]); } while (0)
#define AT_PVX(st, PC0, PC1) do { const unsigned vad_ = (unsigned)(size_t)((const LAS char*)F.lds + AT_VB0 + (st) + rdoff); \
                bf16x8 va0, va1, va2, va3, vb0, vb1, vb2, vb3, pf_; \
                AT_VR(0, va0, va1, va2, va3); AT_VR(1, vb0, vb1, vb2, vb3); pf_ = AT_PF(PC0, 0); AT_LGKM(4); AT_M4(pf_, va0, va1, va2, va3); \
                AT_VR(2, va0, va1, va2, va3); pf_ = AT_PF(PC0, 8); AT_LGKM(4); AT_M4(pf_, vb0, vb1, vb2, vb3); \
                AT_VR(3, vb0, vb1, vb2, vb3); pf_ = AT_PF(PC1, 0); AT_LGKM(4); AT_M4(pf_, va0, va1, va2, va3); \
                pf_ = AT_PF(PC1, 8); AT_LGKM(0); AT_M4(pf_, vb0, vb1, vb2, vb3); } while (0)
#define AT_SMAX(P0, P1) do { \
                float mx = P0[0]; _Pragma("unroll") for (int r = 1; r < 16; ++r) mx = fmaxf(mx, P0[r]); _Pragma("unroll") for (int r = 0; r < 16; ++r) mx = fmaxf(mx, P1[r]); \
                mx = fmaxf(mx, __shfl_xor(mx, 32)); \
                if (!__all(mx - m_run <= 11.0f)) { const float mn = fmaxf(m_run, mx), al = __builtin_amdgcn_exp2f(m_run - mn); m_run = mn; l_run *= al; \
                    _Pragma("unroll") for (int d0 = 0; d0 < 4; ++d0) _Pragma("unroll") for (int r = 0; r < 16; ++r) o[d0][r] *= al; } } while (0)
#define AT_SEXP(P0, P1) do { \
                float ps = 0.f; \
                _Pragma("unroll") for (int r = 0; r < 16; ++r) { P0[r] = __builtin_amdgcn_exp2f(P0[r] - m_run); P1[r] = __builtin_amdgcn_exp2f(P1[r] - m_run); ps += P0[r] + P1[r]; } \
                l_run += ps; } while (0)
#define AT_STEP(t, st) do { \
                if (VAR != 1 && VAR != 6 && VAR != 7 && (t) + 1 < NT) { AT_ISSUE_K((t) + 1, (1 - (st)) * AT_KB); AT_ISSUE_V((t) + 1, (1 - (st)) * AT_VB); } \
                if (VAR != 2 && (t) <= cw) { f32x16 p0, p1; if (VAR != 5 && VAR != 7) AT_QKX((st) * AT_KB, p0, p1); else { _Pragma("unroll") for (int r = 0; r < 16; ++r) { p0[r] = m_run; p1[r] = l_run; } } \
                    if (VAR == 0 || VAR == 1) { AT_SMAX(p0, p1); AT_SEXP(p0, p1); } if (VAR != 4 && VAR != 6) AT_PVX((st) * AT_VB, p0, p1); else { m_run += p0[3] + p1[5]; } } \
                asm volatile("s_waitcnt vmcnt(0)" ::: "memory"); AT_BAR(); } while (0)
            AT_ISSUE_K(0, 0); AT_ISSUE_V(0, 0);
            asm volatile("s_waitcnt vmcnt(0)" ::: "memory"); AT_BAR();
#pragma unroll 1
            for (int t = 0; t < NT; t += 2) {
                AT_STEP(t, 0);
                AT_STEP(t + 1, 1);
            }
#undef AT_ISSUE_K
#undef AT_ISSUE_V
#undef AT_STEP
            const float lt = l_run + __shfl_xor(l_run, 32), inv = 1.0f / lt;
            bf16_t* op = (bf16_t*)(AT_UPTR(Og + (tokb + (size_t)j * 256 + w * 32) * D + h * DV) + (unsigned)(r32 * (D * 2) + 8 * hi));
#pragma unroll
            for (int d0 = 0; d0 < 4; ++d0)
#pragma unroll
                for (int g4 = 0; g4 < 4; ++g4) { u32x2 wv; wv.x = cvt_pk_bf16(o[d0][4 * g4] * inv, o[d0][4 * g4 + 1] * inv); wv.y = cvt_pk_bf16(o[d0][4 * g4 + 2] * inv, o[d0][4 * g4 + 3] * inv);
                    *(u32x2*)(op + d0 * 32 + 8 * g4) = wv; }
        }
    }
}
#else
template <int VAR>
__device__ __forceinline__ void ph_attn(const Frame& F) {
    const bf16_t* Qg = (const bf16_t*)(F.ws + WS_Q); const bf16_t* KNg = (const bf16_t*)(F.ws + WS_KN); const bf16_t* KRg = (const bf16_t*)(F.ws + WS_KR); const bf16_t* VTg = (const bf16_t*)(F.ws + WS_VT);
    bf16_t* Og = (bf16_t*)(F.ws + WS_HC);
    for (int it = F.blk * NWAVE + F.wave; it < NTOK * NH; it += F.G * NWAVE) {
        const int n = it >> 3, h = it & 7, b = n / SEQ, s = n - b * SEQ, nkb = s / 64 + 1; const size_t tokb = (size_t)b * SEQ;
        const bf16_t* q = Qg + (size_t)n * (NH * DQK) + h * DQK;
        float m = -1e30f, l = 0.f, o0 = 0.f, o1 = 0.f;
        for (int kb = 0; kb < nkb; ++kb) {
            const size_t key = tokb + kb * 64 + F.lane; float sc = 0.f;
            for (int d = 0; d < DNOPE; d += 8) { const u32x4 kv = *(const u32x4*)(KNg + key * D + h * DNOPE + d), qv = *(const u32x4*)(q + d);
                sc += bflo(kv.x) * bflo(qv.x) + bfhi(kv.x) * bfhi(qv.x) + bflo(kv.y) * bflo(qv.y) + bfhi(kv.y) * bfhi(qv.y) + bflo(kv.z) * bflo(qv.z) + bfhi(kv.z) * bfhi(qv.z) + bflo(kv.w) * bflo(qv.w) + bfhi(kv.w) * bfhi(qv.w); }
            for (int d = 0; d < DROPE; d += 8) { const u32x4 kv = *(const u32x4*)(KRg + key * DROPE + d), qv = *(const u32x4*)(q + DNOPE + d);
                sc += bflo(kv.x) * bflo(qv.x) + bfhi(kv.x) * bfhi(qv.x) + bflo(kv.y) * bflo(qv.y) + bfhi(kv.y) * bfhi(qv.y) + bflo(kv.z) * bflo(qv.z) + bfhi(kv.z) * bfhi(qv.z) + bflo(kv.w) * bflo(qv.w) + bfhi(kv.w) * bfhi(qv.w); }
            float mx = sc;
#pragma unroll
            for (int of = 32; of >= 1; of >>= 1) mx = fmaxf(mx, __shfl_xor(mx, of));
            const float mn = fmaxf(m, mx), al = exp2f(m - mn), p = exp2f(sc - mn); m = mn;
            l = l * al + wave_sum(p); o0 *= al; o1 *= al;
            for (int d = 0; d < DV; ++d) { const float v = bf2f(VTg[(size_t)(h * DV + d) * NTOK + key]); const float tot = wave_sum(p * v);
                if (F.lane == (d & 63)) { if (d < 64) o0 += tot; else o1 += tot; } }
        }
        const float inv = 1.0f / l;
        Og[(size_t)n * D + h * DV + F.lane] = (bf16_t)(cvt_pk_bf16(o0 * inv, 0.f) & 0xffffu);
        Og[(size_t)n * D + h * DV + 64 + F.lane] = (bf16_t)(cvt_pk_bf16(o1 * inv, 0.f) & 0xffffu);
    }
}
#endif
constexpr int NPH = 20;
__global__ void __launch_bounds__(NTHR, 2) yoco_fwd(Args args) {
    extern __shared__ __attribute__((aligned(16))) unsigned char lds_raw[];
    Frame F; F.lds = (LAS unsigned char*)lds_raw; F.ws = (GAS unsigned char*)args.ws; F.a = &args;
    F.tid = threadIdx.x; F.lane = F.tid & 63; F.wave = __builtin_amdgcn_readfirstlane(F.tid >> 6); F.G = gridDim.x; F.blk = blockIdx.x;
    volatile LAS unsigned* misc = (volatile LAS unsigned*)(F.lds + LDS_MISC);
    if (F.tid < 16) misc[F.tid] = 0u;
    __syncthreads();
    const int lo = args.ph_lo, hi = args.ph_hi;
    XcdBarrier bar; bar.bar = (unsigned*)(F.ws + WS_CTL); bar.x = 0; bar.st = misc;
    if (hi - lo > 1) bar = xcd_barrier_post((unsigned*)(F.ws + WS_CTL), misc);
#ifndef PH_MASK
#define PH_MASK 0xFFFFFu
#endif
#define IN(k) (((PH_MASK >> ((k) % 20 >= 15 ? (k) - 10 : (k))) & 1u) && lo <= (k) && (k) < hi)
#define FRESH() do { F.tid = threadIdx.x; asm volatile("" : "+v"(F.tid)); F.lane = F.tid & 63; F.wave = __builtin_amdgcn_readfirstlane(F.tid >> 6); F.ws = (GAS unsigned char*)args.ws; asm volatile("" : "+s"(F.ws)); } while (0)
#ifndef REPEAT_MASK
#define REPEAT_MASK 0u
#endif
#define PHBIT(k) ((k) >= 15 ? (k) - 10 : (k))
#define REPEAT(k) _Pragma("unroll 1") for (int rep_ = 0, nrep_ = ((REPEAT_MASK >> PHBIT(k)) & 1u) ? 2 : 1; rep_ < nrep_; ++rep_, (void)((rep_ < nrep_) ? (xcd_barrier(bar), 0) : 0))
#define SEAM(k) do { if (IN(k) && IN((k) + 1)) xcd_barrier(bar); } while (0)
    LAS unsigned char* stage = F.lds;
#define MOD ((const float*)(F.ws + WS_MOD))

    if (IN(0)) REPEAT(0) { FRESH(); ph_prologue(F); } SEAM(0);
    if (IN(1)) REPEAT(1) { FRESH(); ph_norm1(F); ph_router_prep(F); } SEAM(1);
    if (IN(2)) REPEAT(2) { FRESH();
        pg8::Gemm g{(const bf16_t*)(F.ws + WS_HA), (const bf16_t*)(F.ws + WS_WPW1), NTOK, 2 * D, D}; pg8::StaticOrder S; S.init(NTOK, 2 * D, F.G, F.blk);
        pg8::EpiGated<0> E{(bf16_t*)(F.ws + WS_HB), D, GPTR(const float, args.in[I_PW1B]), D, nullptr};
        GEMM_PHASE<pg8::EpiGated<0>, pg8::StaticOrder>(stage, g, S, E);
    } SEAM(2);
    if (IN(3)) REPEAT(3) { FRESH(); ph_conv(F); } SEAM(3);
    if (IN(4)) REPEAT(4) { FRESH();
        pg8::Gemm g{(const bf16_t*)(F.ws + WS_HC), (const bf16_t*)(F.ws + WS_WPW2), NTOK, D, D}; pg8::StaticOrder S; S.init(NTOK, D, F.G, F.blk);
        pg8::EpiResidB<false> E{GPTR(const float, args.in[I_X]), (bf16_t*)(F.ws + WS_X), GPTR(const float, args.in[I_PW2B]), MOD + 2 * D};
        GEMM_PHASE<pg8::EpiResidB<false>, pg8::StaticOrder>(stage, g, S, E);
    } SEAM(4);
#pragma unroll 1
    for (int l = 0; l < 2; ++l) {
        const int pb = 5 + 10 * l;
        if (IN(pb)) REPEAT(pb) { FRESH(); ph_router(F, l); } SEAM(pb);
        if (IN(pb + 1)) REPEAT(pb + 1) { FRESH(); ph_scatter(F, l); } SEAM(pb + 1);
        const int* bexp = (const int*)(F.ws + WS_BEXP) + l * 1024;
        const LAS int* lbexp = (const LAS int*)(F.lds + 131072);
#define FILL_LBEXP(nb) do { for (int i_ = F.tid; i_ <= (nb); i_ += NTHR) ((LAS int*)(F.lds + 131072))[i_] = bexp[i_]; __syncthreads(); } while (0)
        if (IN(pb + 2)) REPEAT(pb + 2) { FRESH();
            const int nblk = __builtin_amdgcn_readfirstlane(bexp[0]); FILL_LBEXP(nblk);
            pg8::Gemm g{(const bf16_t*)(F.ws + WS_HA), (const bf16_t*)(F.ws + WS_WGU) + (size_t)l * NE * 2 * DE * D, nblk * 256, 2 * DE, D};
            pg8::MoeGatherOrder S; S.init(nblk * 256, 2 * DE, F.G, F.blk); S.bexp = lbexp; S.estride = (size_t)2 * DE * D * 2; S.rowtab = (const unsigned*)(F.ws + WS_ROWTAB); S.nrows_src = NTOK;
            pg8::EpiGated<1> E{(bf16_t*)(F.ws + WS_ACT), DE, GPTR(const float, args.in[I_BGU]) + (size_t)l * NE * 2 * DE, DE, lbexp};
            GEMM_PHASE<pg8::EpiGated<1>, pg8::MoeGatherOrder>(stage, g, S, E);
        } SEAM(pb + 2);
        if (IN(pb + 3)) REPEAT(pb + 3) { FRESH();
            const int nblk = __builtin_amdgcn_readfirstlane(bexp[0]); FILL_LBEXP(nblk);
            pg8::Gemm g{(const bf16_t*)(F.ws + WS_ACT), (const bf16_t*)(F.ws + WS_WDN) + (size_t)l * NE * DE * D, nblk * 256, D, DE};
            pg8::MoeOrder S; S.init(nblk * 256, D, F.G, F.blk); S.bexp = lbexp; S.estride = (size_t)DE * D * 2; S.rev = true;
            pg8::EpiBf16P E{(bf16_t*)(F.ws + WS_XG), D, GPTR(const float, args.in[I_BDN]) + (size_t)l * NE * D, D, lbexp};
            GEMM_PHASE<pg8::EpiBf16P, pg8::MoeOrder>(stage, g, S, E);
#ifdef MOE_PROBE
            xcd_barrier(bar); FRESH(); { const int nb2 = __builtin_amdgcn_readfirstlane(bexp[0]); FILL_LBEXP(nb2);
              pg8::Gemm g2{(const bf16_t*)(F.ws + WS_ACT), (const bf16_t*)(F.ws + WS_WDN) + (size_t)l * NE * DE * D, nb2 * 256, D, DE};
              pg8::MoeOrder S2; S2.init(nb2 * 256, D, F.G, F.blk); S2.bexp = lbexp; S2.estride = (size_t)DE * D * 2; S2.rev = true; S2.same = (MOE_PROBE == 2);
              pg8::EpiBf16P E2{(bf16_t*)(F.ws + WS_HB), D, MOE_PROBE == 4 ? nullptr : GPTR(const float, args.in[I_BDN]) + (size_t)l * NE * D, D, lbexp, MOE_PROBE == 1 ? 1 : MOE_PROBE == 3 ? 3 : 2};
              GEMM_PHASE<pg8::EpiBf16P, pg8::MoeOrder>(stage, g2, S2, E2); }
#endif
        } SEAM(pb + 3);
        if (IN(pb + 4)) REPEAT(pb + 4) { FRESH(); ph_combine(F, l); } SEAM(pb + 4);
        if (l == 0) {
            if (IN(10)) REPEAT(10) { FRESH();
#pragma unroll 1
                for (int gi = 0; gi < 2; ++gi) {
                    pg8::Gemm g{(const bf16_t*)(F.ws + (gi ? WS_HA : WS_HB)), (const bf16_t*)(F.ws + (gi ? WS_WDQ : WS_WDKV)), NTOK, 512, D}; pg8::StaticOrder S; S.init(NTOK, 512, F.G, F.blk);
                    pg8::EpiLatQ E{(bf16_t*)(F.ws + (gi ? WS_CQ : WS_CKV)), gi ? QLORA : KVLORA, gi ? QLORA : KVLORA, gi ? (bf16_t*)nullptr : (bf16_t*)(F.ws + WS_KR), (const f32x2*)(F.ws + WS_CS), (float*)(F.ws + (gi ? WS_SSPQ : WS_SSPKV))};
                    GEMM_PHASE<pg8::EpiLatQ, pg8::StaticOrder>(stage, g, S, E);
                    __syncthreads(); }
            } do { if (IN(10) && IN(12)) xcd_barrier(bar); } while (0);
            if (IN(12)) REPEAT(12) { FRESH();
#pragma unroll 1
                for (int gi = 0; gi < 3; ++gi) {
                    pg8::Gemm g{(const bf16_t*)(F.ws + (gi == 0 ? WS_CKV : gi == 1 ? WS_WUV : WS_CQ)), (const bf16_t*)(F.ws + (gi == 0 ? WS_WUK : gi == 1 ? WS_CKV : WS_WUQ)),
                                gi == 1 ? D : NTOK, gi == 0 ? D : gi == 1 ? NTOK : NH * DQK, gi == 2 ? QLORA : KVLORA};
                    pg8::StaticOrder S; S.init(g.M, g.N, F.G, F.blk);
                    pg8::EpiScaled E{(bf16_t*)(F.ws + (gi == 0 ? WS_KN : gi == 1 ? WS_VT : WS_Q)), g.N, (const float*)(F.ws + (gi == 2 ? WS_SSPQ : WS_SSPKV)), gi == 1 ? 1 : 0, gi == 2 ? 8 : 4, gi == 2 ? 1.0f / QLORA : 1.0f / KVLORA};
                    GEMM_PHASE<pg8::EpiScaled, pg8::StaticOrder>(stage, g, S, E);
                    __syncthreads(); }
            } SEAM(12);
            if (IN(13)) REPEAT(13) { FRESH(); ph_attn<0>(F);
#ifdef ATTN_PROBE
                xcd_barrier(bar); FRESH(); ph_attn<ATTN_PROBE>(F);
#endif
            } SEAM(13);
            if (IN(14)) REPEAT(14) { FRESH();
                pg8::Gemm g{(const bf16_t*)(F.ws + WS_HC), (const bf16_t*)(F.ws + WS_WO), NTOK, D, D}; pg8::StaticOrder S; S.init(NTOK, D, F.G, F.blk);
                pg8::EpiResidB<true> E{(const bf16_t*)(F.ws + WS_X2), (bf16_t*)(F.ws + WS_X), nullptr, MOD + (size_t)NB * 6 * D + 2 * D};
                GEMM_PHASE<pg8::EpiResidB<true>, pg8::StaticOrder>(stage, g, S, E);
            } SEAM(14);
        }
    }
#undef IN
#undef SEAM
#undef MOD
#undef FRESH
}

extern "C" void kernel_launch(void* const* d_in, const int* in_sizes, int n_in, void* d_out, int out_size, void* d_ws, size_t ws_size, hipStream_t stream) {
    static int grid = 0;
    if (grid == 0) {
        if (n_in != 31 || out_size != NTOK * D || ws_size < WS_END) { fprintf(stderr, "kernel_launch: unexpected shapes (n_in %d, out %d, ws %zu < %zu)\n", n_in, out_size, ws_size, (size_t)WS_END); grid = -1; return; }
        int dev = 0, cus = 0, per_cu = 0;
        if (hipGetDevice(&dev) != hipSuccess || hipDeviceGetAttribute(&cus, hipDeviceAttributeMultiprocessorCount, dev) != hipSuccess) { grid = -1; return; }
        if (hipFuncSetAttribute((const void*)yoco_fwd, hipFuncAttributeMaxDynamicSharedMemorySize, LDS_BYTES) != hipSuccess) { fprintf(stderr, "kernel_launch: hipFuncSetAttribute failed\n"); grid = -1; return; }
        if (hipOccupancyMaxActiveBlocksPerMultiprocessor(&per_cu, (const void*)yoco_fwd, NTHR, LDS_BYTES) != hipSuccess || per_cu < 1) fprintf(stderr, "kernel_launch: occupancy query says %d\n", per_cu);
        (void)hipGetLastError();
        grid = cus;
        if (grid != 256) fprintf(stderr, "kernel_launch: %d CUs (built for 256)\n", grid);
        if (grid > 256) grid = 256;
    }
    if (grid < 0) return;
    (void)hipMemsetAsync((char*)d_ws + WS_CTL, 0, XCD_BAR_WORDS * sizeof(unsigned), stream);
    Args a{};
    for (int i = 0; i < 31; ++i) a.in[i] = (const float*)d_in[i];
    a.out = (float*)d_out; a.ws = (unsigned char*)d_ws;
#if N_LAUNCH_MODE == 1
    a.ph_lo = 0; a.ph_hi = NPH;
    hipLaunchKernelGGL(yoco_fwd, dim3(grid), dim3(NTHR), LDS_BYTES, stream, a);
#else
    for (int p = 0; p < NPH; ++p) { a.ph_lo = p; a.ph_hi = p + 1; hipLaunchKernelGGL(yoco_fwd, dim3(grid), dim3(NTHR), LDS_BYTES, stream, a); }
#endif
}
```

```cpp
#include <hip/hip_runtime.h>
#include <cstdio>
#include <cstdint>

#ifndef N_LAUNCH_MODE
#define N_LAUNCH_MODE 1
#endif
#ifndef NAIVE_GEMM
#define NAIVE_GEMM 0
#endif
#ifndef NAIVE_ATTN
#define NAIVE_ATTN 0
#endif

#define LAS __attribute__((address_space(3)))
#define GAS __attribute__((address_space(1)))
__device__ __forceinline__ const void* assume_global_(const void* p) {
#if defined(__HIP_DEVICE_COMPILE__)
    __builtin_assume(!__builtin_amdgcn_is_shared(p) && !__builtin_amdgcn_is_private(p));
#endif
    return p; }
#define GPTR(T, p) ((T*)assume_global_((const void*)(p)))
typedef unsigned short bf16_t;
typedef short bf16x8 __attribute__((ext_vector_type(8)));
typedef float f32x4 __attribute__((ext_vector_type(4)));
typedef float f32x2 __attribute__((ext_vector_type(2)));
typedef float f32x16 __attribute__((ext_vector_type(16)));
typedef unsigned u32x4 __attribute__((ext_vector_type(4)));
typedef unsigned u32x2 __attribute__((ext_vector_type(2)));

constexpr int D = 1024, NB = 4, SEQ = 8192, NTOK = NB * SEQ;
constexpr int CONVW = 31, NH = 8, DNOPE = 128, DROPE = 64, DQK = 192, DV = 128, QLORA = 384, KVLORA = 256;
constexpr int NE = 32, TOPK = 4, DE = 1024, EBLK = 256;
constexpr int NASSIGN = NTOK * TOPK;
constexpr int NROWS = ((NASSIGN + NE * (EBLK - 1) + EBLK - 1) / EBLK) * EBLK;
constexpr int MAXBLK = NROWS / EBLK;
constexpr float EPS = 1e-6f;
constexpr int NTHR = 512, NWAVE = 8;
constexpr int LDS_BYTES = 163840;
constexpr int LDS_MISC = 163328;

constexpr size_t MiB = (size_t)1 << 20;
constexpr size_t WS_CTL = 0;
constexpr size_t WS_MOETOT = 16 * 1024;
constexpr size_t WS_CTL_BYTES = WS_MOETOT + 256;
constexpr size_t WS_BLKCNT = 64 * 1024;
constexpr size_t WS_BEXP = 192 * 1024;
constexpr size_t WS_MOD = 1 * MiB;
constexpr size_t WS_TOPI = 2 * MiB;
constexpr size_t WS_GATE = WS_TOPI + 512 * 1024;
constexpr size_t WS_RANK = WS_GATE + 512 * 1024;
constexpr size_t WS_SLOT = WS_RANK + 512 * 1024;
constexpr size_t WS_CS = 4 * MiB;
constexpr size_t WS_RWF = 12 * MiB;
constexpr size_t WS_RBIAS = 13 * MiB;
constexpr size_t WS_WPW1 = 16 * MiB;
constexpr size_t WS_WPW2 = WS_WPW1 + 4 * MiB;
constexpr size_t WS_WDKV = WS_WPW2 + 2 * MiB;
constexpr size_t WS_WDQ = WS_WDKV + 1 * MiB;
constexpr size_t WS_WUK = WS_WDQ + 1 * MiB;
constexpr size_t WS_WUV = WS_WUK + MiB / 2;
constexpr size_t WS_WUQ = WS_WUV + MiB / 2;
constexpr size_t WS_WO = WS_WUQ + 2 * MiB;
constexpr size_t WS_WGU = 32 * MiB;
constexpr size_t WS_WDN = WS_WGU + 256 * MiB;
constexpr size_t WS_X = WS_WDN + 128 * MiB;
constexpr size_t WS_HA = WS_X + 128 * MiB;
constexpr size_t WS_HB = WS_HA + 64 * MiB;
constexpr size_t WS_HC = WS_HB + 64 * MiB;
constexpr size_t WS_XG = WS_HC + 64 * MiB;
constexpr size_t WS_ACT = WS_XG + 272 * MiB;
constexpr size_t WS_ROWTAB = WS_ACT + 272 * MiB;
constexpr size_t WS_X2 = WS_ROWTAB + 8 * MiB;
constexpr size_t WS_ROWTAB2 = WS_X2 + 64 * MiB;
constexpr size_t WS_END = WS_X2 + 128 * MiB;
constexpr size_t WS_LAT = WS_XG;
constexpr size_t WS_SSPKV = WS_XG;
constexpr size_t WS_SSPQ = WS_XG + 2 * MiB;
constexpr size_t WS_CQP = WS_LAT + 64 * MiB;
constexpr size_t WS_CKV = WS_CQP + 64 * MiB;
constexpr size_t WS_KR = WS_CKV + 16 * MiB;
constexpr size_t WS_CQ = WS_KR + 4 * MiB;
constexpr size_t WS_KN = WS_CQ + 28 * MiB;
constexpr size_t WS_VT = WS_KN + 64 * MiB;
constexpr size_t WS_Q = WS_VT + 64 * MiB;
static_assert(WS_Q + 96 * MiB <= WS_END, "ws map");

struct Args {
    const float* in[31]; float* out; unsigned char* ws; int ph_lo, ph_hi;
};
enum { I_X = 0, I_C, I_POS, I_MODW, I_MODB, I_N1G, I_N2G, I_PW1W, I_PW1B, I_DWW, I_DWB, I_LNG, I_LNB, I_PW2W, I_PW2B, I_KVG, I_WDKV, I_CKVG, I_WUK, I_WUV,
       I_WDQ, I_CQG, I_WUQ, I_WO, I_RW, I_RB, I_WGU, I_BGU, I_WDN, I_BDN, I_FG };

__device__ __forceinline__ unsigned cvt_pk_bf16(float lo, float hi) { unsigned r; asm volatile("v_cvt_pk_bf16_f32 %0, %1, %2" : "=v"(r) : "v"(lo), "v"(hi)); return r; }
__device__ __forceinline__ float bf2f(unsigned short b) { return __uint_as_float(((unsigned)b) << 16); }
__device__ __forceinline__ float bflo(unsigned w) { return __uint_as_float(w << 16); }
__device__ __forceinline__ float bfhi(unsigned w) { return __uint_as_float(w & 0xffff0000u); }
__device__ __forceinline__ float wave_sum(float v) {
#pragma unroll
    for (int o = 32; o >= 1; o >>= 1) v += __shfl_xor(v, o);
    return v;
}
__device__ __forceinline__ float sigmoidf_(float x) { return __builtin_amdgcn_rcpf(1.0f + __builtin_amdgcn_exp2f(-1.4426950408889634f * x)); }
#define XB_TMO      128
#define XB_XCNT(j)  (256  + 64 * (j))
#define XB_XSUB(j)  (1280 + 64 * (j))
#define XB_XGEN(j)  (2304 + 64 * (j))
#define XB_TOP      3328
#define XB_TOPGEN   3392
#define XCD_BAR_WORDS 3456
#define XB_SPIN_CAP (1u << 18)

__device__ __forceinline__ unsigned xb_ld(unsigned* p)              { return __hip_atomic_load(p, __ATOMIC_RELAXED, __HIP_MEMORY_SCOPE_AGENT); }
__device__ __forceinline__ unsigned xb_add(unsigned* p, unsigned v) { return __hip_atomic_fetch_add(p, v, __ATOMIC_RELAXED, __HIP_MEMORY_SCOPE_AGENT); }
__device__ __forceinline__ unsigned xb_xcc_id() { return (unsigned)__builtin_amdgcn_s_getreg((3 << 11) | 20) & 0xFu; }
#define XB_SPIN(cond, bar) do { unsigned _sp = 0; while (cond) { __builtin_amdgcn_s_sleep(1); \
    if ((++_sp & 255u) == 0u) { if (xb_ld(&(bar)[XB_TMO])) break; if (_sp > XB_SPIN_CAP) { atomicAdd(&(bar)[XB_TMO], 1u); break; } } } } while (0)

struct XcdBarrier {
    unsigned* bar; unsigned x;
    volatile LAS unsigned* st;
};

__device__ __forceinline__ XcdBarrier xcd_barrier_post(unsigned* bar, volatile LAS unsigned* st) {
    XcdBarrier b; b.bar = bar; b.x = xb_xcc_id(); b.st = st;
    if (threadIdx.x == 0) (void)xb_add(&bar[XB_XCNT(b.x)], 1u);
    return b;
}
__device__ __forceinline__ void xcd_barrier_complete(unsigned* bar, unsigned x, unsigned& nloc, unsigned& nx) {
    const unsigned G = gridDim.x * gridDim.y * gridDim.z;
    unsigned sum, cnt, mine, sp = 0u;
    for (;;) {
        sum = 0u; cnt = 0u; mine = 0u;
#pragma unroll
        for (unsigned j = 0; j < 16; ++j) { const unsigned c = xb_ld(&bar[XB_XCNT(j)]); sum += c; cnt += (c > 0u) ? 1u : 0u; mine = (j == x) ? c : mine; }
        if (sum == G) break;
        __builtin_amdgcn_s_sleep(1);
        if ((++sp & 255u) == 0u) { if (xb_ld(&bar[XB_TMO])) break; if (sp > XB_SPIN_CAP) { atomicAdd(&bar[XB_TMO], 1u); break; } }
    }
    nloc = mine > 0u ? mine : 1u; nx = cnt > 0u ? cnt : 1u;
}

__device__ __forceinline__ void xcd_barrier(const XcdBarrier& b) {
    asm volatile("s_waitcnt vmcnt(0)" ::: "memory");
    __syncthreads();
    if (threadIdx.x == 0) {
        unsigned* bar = b.bar;
        __builtin_amdgcn_s_waitcnt(0);
        unsigned nloc = b.st[0], nx = b.st[1];
        if (nloc == 0u) { xcd_barrier_complete(bar, b.x, nloc, nx); b.st[0] = nloc; b.st[1] = nx; }
        const unsigned old = xb_add(&bar[XB_XSUB(b.x)], 1u);
        const unsigned gen = old / nloc;
        if (old + 1u == (gen + 1u) * nloc) {
            __builtin_amdgcn_fence(__ATOMIC_RELEASE, "agent");
            asm volatile("s_waitcnt vmcnt(0)" ::: "memory");
            const unsigned og = xb_add(&bar[XB_TOP], 1u);
            const unsigned tg = og / nx;
            if (og + 1u == (tg + 1u) * nx) xb_add(&bar[XB_TOPGEN], 1u);
            else XB_SPIN(xb_ld(&bar[XB_TOPGEN]) == tg, bar);
            __builtin_amdgcn_fence(__ATOMIC_ACQUIRE, "agent");
            xb_add(&bar[XB_XGEN(b.x)], 1u);
            asm volatile("s_waitcnt vmcnt(0)" ::: "memory");
        } else {
            XB_SPIN(xb_ld(&bar[XB_XGEN(b.x)]) == gen, bar);
            __builtin_amdgcn_fence(__ATOMIC_ACQUIRE, "agent");
            asm volatile("s_waitcnt vmcnt(0)" ::: "memory");
        }
    }
    __syncthreads();
}
namespace pg8 {
#define PG8_LAS __attribute__((address_space(3)))
constexpr int BM = 256, BK = 64, HALF = 128, HTB = HALF * BK * 2  , STAGE_BYTES = 8 * HTB, NXCD = 8, WGM = 8;

__host__ __device__ __forceinline__ int lds_byte(int r, int c) { const int st = (r >> 4) * 2 + (c >> 5), rr = r & 15, cc = c & 31, ob = rr * 64 + cc * 2; return st * 1024 + (ob ^ (((ob >> 9) & 1) << 5)); }
__host__ __device__ __forceinline__ void stage_rc(int b, int& R, int& C) { const int st = b / 1024, sb = b % 1024, swz = sb ^ (((sb >> 9) & 1) << 5); R = (st >> 1) * 16 + swz / 64; C = (st & 1) * 32 + (swz % 64) / 2; }
__host__ __device__ __forceinline__ int perm32(int rho) { const int n = rho >> 4, i = rho & 15; return 8 * (i >> 2) + 4 * n + (i & 3); }

struct Unit { int pm, pn; };
struct Gemm { const bf16_t* A; const bf16_t* Bt; int M, N, K; };

struct StaticOrder {
    static constexpr bool GATHER = false;
    int nM, nN, nwg, G, c;
    __host__ __device__ void init(int M, int N, int G_, int c_) { nM = M / BM; nN = N / BM; nwg = nM * nN; G = G_; c = c_; }
    __host__ __device__ bool next(int i, Unit& u) const {
        const long L = (long)i * G + c; if (L >= nwg) return false;
        int wgid = (int)L; { const int q = nwg / NXCD, r = nwg % NXCD, xcd = wgid % NXCD, off = wgid / NXCD; wgid = (xcd < r ? xcd * (q + 1) : r * (q + 1) + (xcd - r) * q) + off; }
        const int nig = WGM * nN, gid = wgid / nig, fm = gid * WGM, gsz = (nM - fm) < WGM ? (nM - fm) : WGM;
        u.pm = fm + ((wgid % nig) % gsz); u.pn = (wgid % nig) / gsz; return true;
    }
    __device__ __forceinline__ void a_ready(const Unit&) const {}
    __device__ __forceinline__ size_t boff(const Unit& u, size_t tstep) const { return (size_t)u.pn * tstep; }
    __device__ __forceinline__ void done(const Unit&) const {}
};
template <class Epi, class Sched>
__device__ __forceinline__ void gemm_phase(PG8_LAS unsigned char* lds, const Gemm g, const Sched& S, const Epi& E) {
    constexpr bool STAMP = false; unsigned long long* stamps = nullptr;
    int tid_ = threadIdx.x; asm volatile("" : "+v"(tid_));
    const int tid = tid_, wid = __builtin_amdgcn_readfirstlane(tid >> 6), lane = tid & 63, wr = wid >> 2, wc = wid & 3, fr = lane & 15, fq = lane >> 4;
    const int K = g.K, nt = K / BK;
    int ts_lo = 0, ts_hi = 0, nts = 0; const unsigned long long rt_entry = STAMP ? (unsigned long long)wall_clock64() : 0ull;
#define PG8_STAMP() do { if (STAMP && wid == 0 && nts < 64) { const unsigned long long _c = (unsigned long long)clock64(); \
        ts_lo = (lane == nts) ? (int)(unsigned)_c : ts_lo; ts_hi = (lane == nts) ? (int)(unsigned)(_c >> 32) : ts_hi; ++nts; } } while (0)
    PG8_STAMP();
    unsigned voffA[2], voffB[2];
#pragma unroll
    for (int i = 0; i < 2; ++i) { int R, C; stage_rc(tid * 16 + i * 8192, R, C); const int Rb = Epi::PERM ? ((R & ~31) + perm32(R & 31)) : R;
        voffA[i] = (unsigned)(R * K + C) * 2u; voffB[i] = (unsigned)(Rb * K + C) * 2u; }
    unsigned gc[2][2], gn[2][2], gnn[2][2];
#define PG8_LOOKUP_LD(t4_, u) t4_ = *(const u32x4*)(S.rowtab + ((size_t)S.rt_blk(u) * 512 + tid) * 4)
#define PG8_LOOKUP_FIN(dst, t4_) do { const unsigned tk_[4] = {t4_.x, t4_.y, t4_.z, t4_.w}; \
        _Pragma("unroll") for (int h_ = 0; h_ < 2; ++h_) _Pragma("unroll") for (int i_ = 0; i_ < 2; ++i_) { int R_, C_; stage_rc(tid * 16 + i_ * 8192, R_, C_); \
        const unsigned tc_ = tk_[h_ * 2 + i_] < S.nrows_src ? tk_[h_ * 2 + i_] : S.nrows_src - 1u; dst[h_][i_] = (tc_ * (unsigned)K + (unsigned)C_) * 2u; } } while (0)
#define PG8_LOOKUP(dst, u) do { u32x4 t4x_; PG8_LOOKUP_LD(t4x_, u); PG8_LOOKUP_FIN(dst, t4x_); } while (0)
#define PG8_STAGE_G(bufoff, kbytes, off2) do { _Pragma("unroll") for (int _i = 0; _i < 2; ++_i) \
        __builtin_amdgcn_global_load_lds((const unsigned*)((const char*)g.A + (kbytes) + (off2)[_i]), (PG8_LAS unsigned*)(lds + (bufoff) + ldsw + _i * 8192), 16, 0, 0); } while (0)
    const size_t kstep = (size_t)(BK * 2);
    const size_t hstep = (size_t)HALF * K * 2;
    const size_t tstep = 2 * hstep;
    const unsigned ldsw = (unsigned)wid * 1024u;
    const int aoff = lds_byte(wr * 64 + fr, fq * 8), boff = lds_byte(wc * 32 + fr, fq * 8);
#define PG8_SA(b, h) (((b) * 2 + (h)) * HTB)
#define PG8_SB(b, h) ((4 + (b) * 2 + (h)) * HTB)
#define PG8_STAGE(bufoff, gbase, voff) do { _Pragma("unroll") for (int _i = 0; _i < 2; ++_i) \
        __builtin_amdgcn_global_load_lds((const unsigned*)((const char*)(gbase) + (voff)[_i]), (PG8_LAS unsigned*)(lds + (bufoff) + ldsw + _i * 8192), 16, 0, 0); } while (0)
#define PG8_LDA(dst, b, h) do { _Pragma("unroll") for (int m = 0; m < 4; ++m) _Pragma("unroll") for (int k = 0; k < 2; ++k) dst[m][k] = *(const PG8_LAS bf16x8*)(lds + PG8_SA(b, h) + aoff + m * 2048 + k * 1024); } while (0)
#define PG8_LDB(dst, b, h) do { _Pragma("unroll") for (int n = 0; n < 2; ++n) _Pragma("unroll") for (int k = 0; k < 2; ++k) dst[n][k] = *(const PG8_LAS bf16x8*)(lds + PG8_SB(b, h) + boff + n * 2048 + k * 1024); } while (0)
#define PG8_MMA(ai, bj, At, Bt) do { __builtin_amdgcn_s_setprio(1); _Pragma("unroll") for (int m = 0; m < 4; ++m) _Pragma("unroll") for (int n = 0; n < 2; ++n) _Pragma("unroll") for (int k = 0; k < 2; ++k) \
        acc[ai][bj][m][n] = __builtin_amdgcn_mfma_f32_16x16x32_bf16(Bt[n][k], At[m][k], acc[ai][bj][m][n], 0, 0, 0); __builtin_amdgcn_s_setprio(0); } while (0)
#define PG8_WAIT_V(n) asm volatile("s_waitcnt vmcnt(" #n ")" ::: "memory")
#define PG8_WAIT_L(n) asm volatile("s_waitcnt lgkmcnt(" #n ")" ::: "memory")
#define PG8_BAR __builtin_amdgcn_s_barrier()
#define PG8_SCHED __builtin_amdgcn_sched_barrier(0)
    Unit cur, nxt; int ui = 0;
    if (!S.next(0, cur)) return;
    f32x4 acc[2][2][4][2];
#pragma unroll
    for (int a = 0; a < 2; ++a)
#pragma unroll
        for (int b = 0; b < 2; ++b)
#pragma unroll
            for (int m = 0; m < 4; ++m)
#pragma unroll
                for (int n = 0; n < 2; ++n) acc[a][b][m][n] = (f32x4){0.f, 0.f, 0.f, 0.f};
    bf16x8 At[4][2], B0[2][2], B1[2][2];
    const char* cA = (const char*)g.A + (size_t)cur.pm * tstep; const char* cB = (const char*)g.Bt + S.boff(cur, tstep);
    S.a_ready(cur);
    if constexpr (Sched::GATHER) { PG8_LOOKUP(gc, cur); Unit u1_; if (S.next(1, u1_)) PG8_LOOKUP(gn, u1_); else { _Pragma("unroll") for (int h_ = 0; h_ < 2; ++h_) _Pragma("unroll") for (int i_ = 0; i_ < 2; ++i_) gn[h_][i_] = gc[h_][i_]; } }
    PG8_STAGE(PG8_SB(0, 0), cB, voffB); if constexpr (Sched::GATHER) PG8_STAGE_G(PG8_SA(0, 0), 0, gc[0]); else PG8_STAGE(PG8_SA(0, 0), cA, voffA);
    PG8_STAGE(PG8_SB(0, 1), cB + hstep, voffB); if constexpr (Sched::GATHER) PG8_STAGE_G(PG8_SA(0, 1), 0, gc[1]); else PG8_STAGE(PG8_SA(0, 1), cA + hstep, voffA);
    if (wr == 1) PG8_BAR;
    PG8_WAIT_V(4); PG8_BAR;
    PG8_STAGE(PG8_SB(1, 0), cB + kstep, voffB); if constexpr (Sched::GATHER) PG8_STAGE_G(PG8_SA(1, 0), kstep, gc[0]); else PG8_STAGE(PG8_SA(1, 0), cA + kstep, voffA);
    PG8_STAGE(PG8_SB(1, 1), cB + hstep + kstep, voffB);
    PG8_WAIT_V(6); PG8_BAR;
    PG8_STAMP();
    for (;;) {
        const bool has_next = S.next(ui + 1, nxt);
        const char* nA = has_next ? (const char*)g.A + (size_t)nxt.pm * tstep : cA; const char* nB = has_next ? (const char*)g.Bt + S.boff(nxt, tstep) : cB;
        const typename Epi::Pre pre = E.pre(cur, wr, wc, fr, fq);
        if constexpr (Sched::GATHER) { if (!has_next) { _Pragma("unroll") for (int h_ = 0; h_ < 2; ++h_) _Pragma("unroll") for (int i_ = 0; i_ < 2; ++i_) gn[h_][i_] = gc[h_][i_]; } }
        for (int t = 0; t < nt; t += 2) {
            const bool last = (t == nt - 2);
            unsigned gs[2][2]; size_t k1 = 0, k2 = 0;
            if constexpr (Sched::GATHER) { k1 = (size_t)(t + 1) * kstep; k2 = last ? 0 : (size_t)(t + 2) * kstep;
                _Pragma("unroll") for (int h_ = 0; h_ < 2; ++h_) _Pragma("unroll") for (int i_ = 0; i_ < 2; ++i_) gs[h_][i_] = last ? gn[h_][i_] : gc[h_][i_]; }
            const char* a1 = cA + (size_t)(t + 1) * kstep;
            const char* a2 = last ? nA : cA + (size_t)(t + 2) * kstep; const char* b2 = last ? nB : cB + (size_t)(t + 2) * kstep;
            const char* a3 = a2 + kstep; const char* b3 = b2 + kstep;
            if (last && has_next) S.a_ready(nxt);
            PG8_LDB(B0, 0, 0); PG8_SCHED; PG8_LDA(At, 0, 0); if constexpr (Sched::GATHER) PG8_STAGE_G(PG8_SA(1, 1), k1, gc[1]); else PG8_STAGE(PG8_SA(1, 1), a1 + hstep, voffA);
            PG8_WAIT_L(8); PG8_BAR; PG8_WAIT_L(0); PG8_MMA(0, 0, At, B0); PG8_BAR; PG8_SCHED;
            PG8_LDB(B1, 0, 1); PG8_STAGE(PG8_SB(0, 0), b2, voffB);
            PG8_BAR; PG8_WAIT_L(0); PG8_MMA(0, 1, At, B1); PG8_BAR;
            PG8_LDA(At, 0, 1); if constexpr (Sched::GATHER) PG8_STAGE_G(PG8_SA(0, 0), k2, gs[0]); else PG8_STAGE(PG8_SA(0, 0), a2, voffA);
            PG8_BAR; PG8_WAIT_L(0); PG8_MMA(1, 0, At, B0); PG8_BAR; PG8_SCHED;
            PG8_STAGE(PG8_SB(0, 1), b2 + hstep, voffB);
            PG8_WAIT_V(6); PG8_BAR; PG8_MMA(1, 1, At, B1); PG8_BAR;
            PG8_LDB(B0, 1, 0); PG8_SCHED; PG8_LDA(At, 1, 0); if constexpr (Sched::GATHER) PG8_STAGE_G(PG8_SA(0, 1), k2, gs[1]); else PG8_STAGE(PG8_SA(0, 1), a2 + hstep, voffA);
            PG8_WAIT_L(8); PG8_BAR; PG8_WAIT_L(0); PG8_MMA(0, 0, At, B0); PG8_BAR; PG8_SCHED;
            PG8_LDB(B1, 1, 1); PG8_STAGE(PG8_SB(1, 0), b3, voffB);
            PG8_BAR; PG8_WAIT_L(0); PG8_MMA(0, 1, At, B1); PG8_BAR;
            PG8_LDA(At, 1, 1); if constexpr (Sched::GATHER) PG8_STAGE_G(PG8_SA(1, 0), k2 + kstep, gs[0]); else PG8_STAGE(PG8_SA(1, 0), a3, voffA);
            PG8_BAR; PG8_WAIT_L(0); PG8_MMA(1, 0, At, B0); PG8_BAR; PG8_SCHED;
            PG8_STAGE(PG8_SB(1, 1), b3 + hstep, voffB);
            PG8_WAIT_V(6); PG8_BAR; PG8_MMA(1, 1, At, B1); PG8_BAR;
        }
        PG8_STAMP();
        u32x4 t4n_ = {0u, 0u, 0u, 0u}; bool has_nn_ = false;
        if constexpr (Sched::GATHER) { Unit u2_; has_nn_ = S.next(ui + 2, u2_); if (has_nn_) PG8_LOOKUP_LD(t4n_, u2_); }
        if constexpr (!Epi::AFTER_DRAIN) { if (wr == 0) PG8_BAR; E(acc, cur, wr, wc, fr, fq, pre); S.done(cur); if (wr == 1) PG8_BAR; }
        if constexpr (Sched::GATHER) { if (has_nn_) PG8_LOOKUP_FIN(gnn, t4n_); else { _Pragma("unroll") for (int h_ = 0; h_ < 2; ++h_) _Pragma("unroll") for (int i_ = 0; i_ < 2; ++i_) gnn[h_][i_] = gn[h_][i_]; } }
        PG8_STAMP();
        if (!has_next) break;
#pragma unroll
        for (int a = 0; a < 2; ++a)
#pragma unroll
            for (int b = 0; b < 2; ++b)
#pragma unroll
                for (int m = 0; m < 4; ++m)
#pragma unroll
                    for (int n = 0; n < 2; ++n) acc[a][b][m][n] = (f32x4){0.f, 0.f, 0.f, 0.f};
        cur = nxt; cA = nA; cB = nB; ++ui;
        if constexpr (Sched::GATHER) { _Pragma("unroll") for (int h_ = 0; h_ < 2; ++h_) _Pragma("unroll") for (int i_ = 0; i_ < 2; ++i_) { gc[h_][i_] = gn[h_][i_]; gn[h_][i_] = gnn[h_][i_]; } }
    }
    PG8_WAIT_V(0);
    if (wr == 0) PG8_BAR;
    PG8_BAR;
    if constexpr (Epi::AFTER_DRAIN) { E.fused(acc, cur, wr, wc, fr, fq, lds, wid, lane); S.done(cur); }
    PG8_STAMP();
    if (STAMP && wid == 0) { stamps[lane] = lane < nts ? (((unsigned long long)(unsigned)ts_hi << 32) | (unsigned)ts_lo) : 0ull;
        if (lane == 62) stamps[62] = rt_entry; if (lane == 63) stamps[63] = (unsigned long long)wall_clock64(); }
#undef PG8_STAMP
#undef PG8_SA
#undef PG8_SB
#undef PG8_STAGE
#undef PG8_STAGE_G
#undef PG8_LOOKUP
#undef PG8_LOOKUP_LD
#undef PG8_LOOKUP_FIN
#undef PG8_LDA
#undef PG8_LDB
#undef PG8_MMA
#undef PG8_WAIT_V
#undef PG8_WAIT_L
#undef PG8_BAR
#undef PG8_SCHED
}
}
namespace pg8 {
struct MoeOrder : StaticOrder {
    static constexpr bool GATHER = false;
    const LAS int* bexp; size_t estride;
    bool rev = false; bool same = false;
    __device__ __forceinline__ bool next(int i, Unit& u) const { const bool ok = StaticOrder::next(i, u); if (ok && rev) u.pm = nM - 1 - u.pm; if (ok && same) { u.pm = 0; u.pn = 0; } return ok; }
    __device__ __forceinline__ size_t boff(const Unit& u, size_t tstep) const { return (size_t)__builtin_amdgcn_readfirstlane(bexp[1 + u.pm]) * estride + (size_t)u.pn * tstep; }
};

struct MoeGatherOrder : MoeOrder {
    static constexpr bool GATHER = true;
    const unsigned* rowtab; unsigned nrows_src; const LAS int* fblk;
    __device__ __forceinline__ int rt_blk(const Unit& u) const { const int e = __builtin_amdgcn_readfirstlane(bexp[1 + u.pm]); return e * 128 + (u.pm - __builtin_amdgcn_readfirstlane(fblk[e])); }
};

template <int MODE> struct EpiGated {
    static constexpr bool PERM = true, AFTER_DRAIN = false;
    bf16_t* O; int ldo; const float* bias; int nh; const LAS int* bexp;
    struct Pre { f32x4 b0[2], b1[2]; };
    __device__ __forceinline__ Pre pre(const Unit& u, int wr, int wc, int fr, int fq) const {
        const int colh = u.pn * HALF + wc * 32 + 8 * fq; Pre p;
        const float* bp = bias; if (MODE == 1) bp += (size_t)__builtin_amdgcn_readfirstlane(bexp[1 + u.pm]) * (size_t)(2 * nh);
#pragma unroll
        for (int n = 0; n < 2; ++n) { p.b0[n] = *(const f32x4*)(bp + colh + 4 * n); p.b1[n] = *(const f32x4*)(bp + nh + colh + 4 * n); }
        return p; }
    __device__ __forceinline__ void operator()(const f32x4 (&acc)[2][2][4][2], const Unit& u, int wr, int wc, int fr, int fq, const Pre& P) const {
        const int row0 = u.pm * BM + wr * 64 + fr, colh = u.pn * HALF + wc * 32 + 8 * fq;
        f32x4 b0[2], b1[2];
#pragma unroll
        for (int n = 0; n < 2; ++n) { b0[n] = P.b0[n]; b1[n] = P.b1[n]; }
#pragma unroll
        for (int ai = 0; ai < 2; ++ai)
#pragma unroll
            for (int m = 0; m < 4; ++m) {
                float o[8];
#pragma unroll
                for (int n = 0; n < 2; ++n) { const f32x4 a = acc[ai][0][m][n] + b0[n], g = acc[ai][1][m][n] + b1[n];
#pragma unroll
                    for (int j = 0; j < 4; ++j) {
                        if (MODE == 0) o[4 * n + j] = a[j] * sigmoidf_(g[j]);
                        else { const float gg = fminf(a[j], 7.0f), uu = fminf(fmaxf(g[j], -7.0f), 7.0f);
                            o[4 * n + j] = fmaf(uu, gg, gg) * __builtin_amdgcn_rcpf(1.0f + __builtin_amdgcn_exp2f(gg * (-1.702f * 1.4426950408889634f))); } } }
                u32x4 w; w.x = cvt_pk_bf16(o[0], o[1]); w.y = cvt_pk_bf16(o[2], o[3]); w.z = cvt_pk_bf16(o[4], o[5]); w.w = cvt_pk_bf16(o[6], o[7]);
                *(u32x4*)(O + (size_t)(row0 + ai * HALF + m * 16) * ldo + colh) = w; }
    }
};
struct EpiBf16P {
    static constexpr bool PERM = true, AFTER_DRAIN = false;
    bf16_t* O; int ldo; const float* bias; int nbias; const LAS int* bexp; int probe = 0;
    struct Pre { f32x4 bv[2][2]; };
    __device__ __forceinline__ Pre pre(const Unit& u, int wr, int wc, int fr, int fq) const {
        const int col0 = u.pn * BM + wc * 32 + 8 * fq; Pre p;
        const float* bp = bias; if (bias && bexp) bp += (size_t)__builtin_amdgcn_readfirstlane(bexp[1 + u.pm]) * (size_t)nbias;
#pragma unroll
        for (int bj = 0; bj < 2; ++bj)
#pragma unroll
            for (int n = 0; n < 2; ++n) p.bv[bj][n] = bias ? *(const f32x4*)(bp + col0 + bj * HALF + 4 * n) : (f32x4){0.f, 0.f, 0.f, 0.f};
        return p; }
    __device__ __forceinline__ void operator()(const f32x4 (&acc)[2][2][4][2], const Unit& u_, int wr, int wc, int fr, int fq, const Pre& P) const {
        if (probe == 1) return;
        Unit u = u_; if (probe >= 2) { u.pm = 0; }
        const int row0 = u.pm * BM + wr * 64 + fr, col0 = u.pn * BM + wc * 32 + 8 * fq;
        f32x4 bv[2][2];
#pragma unroll
        for (int bj = 0; bj < 2; ++bj)
#pragma unroll
            for (int n = 0; n < 2; ++n) bv[bj][n] = P.bv[bj][n];
#pragma unroll
        for (int ai = 0; ai < 2; ++ai)
#pragma unroll
            for (int m = 0; m < 4; ++m) { bf16_t* rowp = O + (size_t)(row0 + ai * HALF + m * 16) * ldo + col0;
#pragma unroll
                for (int bj = 0; bj < 2; ++bj) { const f32x4 v0 = acc[ai][bj][m][0] + bv[bj][0], v1 = acc[ai][bj][m][1] + bv[bj][1];
                    u32x4 w; w.x = cvt_pk_bf16(v0[0], v0[1]); w.y = cvt_pk_bf16(v0[2], v0[3]); w.z = cvt_pk_bf16(v1[0], v1[1]); w.w = cvt_pk_bf16(v1[2], v1[3]);
                    if (probe == 3 && (ai | m)) { asm volatile("" :: "v"(w)); continue; }
                    *(u32x4*)(rowp + bj * HALF) = w; } }
    }
};
struct EpiF32P {
    static constexpr bool PERM = false, AFTER_DRAIN = false;
    float* C; int ldc;
    struct Pre {};
    __device__ __forceinline__ Pre pre(const Unit&, int, int, int, int) const { return Pre{}; }
    __device__ __forceinline__ void operator()(const f32x4 (&acc)[2][2][4][2], const Unit& u, int wr, int wc, int fr, int fq, const Pre&) const {
        const int row0 = u.pm * BM + wr * 64 + fr, col0 = u.pn * BM + wc * 32 + 4 * fq;
#pragma unroll
        for (int ai = 0; ai < 2; ++ai)
#pragma unroll
            for (int m = 0; m < 4; ++m) { float* rowp = C + (size_t)(row0 + ai * HALF + m * 16) * ldc + col0;
#pragma unroll
                for (int bj = 0; bj < 2; ++bj)
#pragma unroll
                    for (int n = 0; n < 2; ++n) *(f32x4*)(rowp + bj * HALF + n * 16) = acc[ai][bj][m][n]; }
    }
};
struct EpiResid {
    static constexpr bool PERM = false, AFTER_DRAIN = false;
    const float* base; float* X; const float* bias; const float* gate;
    struct Pre {};
    __device__ __forceinline__ Pre pre(const Unit&, int, int, int, int) const { return Pre{}; }
    __device__ __forceinline__ void operator()(const f32x4 (&acc)[2][2][4][2], const Unit& u, int wr, int wc, int fr, int fq, const Pre&) const {
        const int row0 = u.pm * BM + wr * 64 + fr, col0 = u.pn * BM + wc * 32 + 4 * fq;
        const float* gp = gate + (size_t)((u.pm * BM) / SEQ) * (6 * D);
        f32x4 bv[2][2], gv[2][2];
#pragma unroll
        for (int bj = 0; bj < 2; ++bj)
#pragma unroll
            for (int n = 0; n < 2; ++n) { bv[bj][n] = bias ? *(const f32x4*)(bias + col0 + bj * HALF + n * 16) : (f32x4){0.f, 0.f, 0.f, 0.f}; gv[bj][n] = *(const f32x4*)(gp + col0 + bj * HALF + n * 16); }
#pragma unroll
        for (int ai = 0; ai < 2; ++ai)
#pragma unroll
            for (int m = 0; m < 4; ++m) { const size_t off = (size_t)(row0 + ai * HALF + m * 16) * D + col0;
                f32x4 bs[2][2];
#pragma unroll
                for (int bj = 0; bj < 2; ++bj)
#pragma unroll
                    for (int n = 0; n < 2; ++n) bs[bj][n] = *(const f32x4*)(base + off + bj * HALF + n * 16);
#pragma unroll
                for (int bj = 0; bj < 2; ++bj)
#pragma unroll
                    for (int n = 0; n < 2; ++n) *(f32x4*)(X + off + bj * HALF + n * 16) = bs[bj][n] + gv[bj][n] * (acc[ai][bj][m][n] + bv[bj][n]); }
    }
};
struct EpiQRope {
    static constexpr bool PERM = true, AFTER_DRAIN = false;
    bf16_t* O; const f32x2* cs;
    struct Pre {};
    __device__ __forceinline__ Pre pre(const Unit&, int, int, int, int) const { return Pre{}; }
    __device__ __forceinline__ void operator()(const f32x4 (&acc)[2][2][4][2], const Unit& u, int wr, int wc, int fr, int fq, const Pre&) const {
        const int row0 = u.pm * BM + wr * 64 + fr, col0 = u.pn * BM + wc * 32 + 8 * fq;
#pragma unroll
        for (int bj = 0; bj < 2; ++bj) {
            const int c = col0 + bj * HALF, w = c % DQK; const bool rope = w >= DNOPE; const int k4 = rope ? ((w - DNOPE) >> 3) * 4 : 0;
#pragma unroll
            for (int ai = 0; ai < 2; ++ai)
#pragma unroll
                for (int m = 0; m < 4; ++m) { const int row = row0 + ai * HALF + m * 16;
                    f32x4 v0 = acc[ai][bj][m][0], v1 = acc[ai][bj][m][1];
                    if (rope) { const f32x4 t0 = *(const f32x4*)(cs + (size_t)row * 32 + k4), t1 = *(const f32x4*)(cs + (size_t)row * 32 + k4 + 2);
                        const float co[4] = {t0[0], t0[2], t1[0], t1[2]}, si[4] = {t0[1], t0[3], t1[1], t1[3]};
#pragma unroll
                        for (int j = 0; j < 4; ++j) { const float x1 = v0[j], x2 = v1[j]; v0[j] = x1 * co[j] - x2 * si[j]; v1[j] = x2 * co[j] + x1 * si[j]; } }
                    u32x4 wv; wv.x = cvt_pk_bf16(v0[0], v0[1]); wv.y = cvt_pk_bf16(v0[2], v0[3]); wv.z = cvt_pk_bf16(v1[0], v1[1]); wv.w = cvt_pk_bf16(v1[2], v1[3]);
                    *(u32x4*)(O + (size_t)row * (NH * DQK) + c) = wv;
                    asm volatile("" ::: "memory"); } }
    }
};

template <bool BF> struct EpiResidB {
    static constexpr bool PERM = true, AFTER_DRAIN = false;
    const void* base; bf16_t* X; const float* bias; const float* gate;
    struct Pre {};
    __device__ __forceinline__ Pre pre(const Unit&, int, int, int, int) const { return Pre{}; }
    __device__ __forceinline__ void operator()(const f32x4 (&acc)[2][2][4][2], const Unit& u, int wr, int wc, int fr, int fq, const Pre&) const {
        const int row0 = u.pm * BM + wr * 64 + fr, col0 = u.pn * BM + wc * 32 + 8 * fq;
        const float* gp = gate + (size_t)((u.pm * BM) / SEQ) * (6 * D);
        f32x4 bv[2][2], gv[2][2];
#pragma unroll
        for (int bj = 0; bj < 2; ++bj)
#pragma unroll
            for (int n = 0; n < 2; ++n) { bv[bj][n] = bias ? *(const f32x4*)(bias + col0 + bj * HALF + 4 * n) : (f32x4){0.f, 0.f, 0.f, 0.f}; gv[bj][n] = *(const f32x4*)(gp + col0 + bj * HALF + 4 * n); }
#pragma unroll
        for (int ai = 0; ai < 2; ++ai)
#pragma unroll
            for (int m = 0; m < 4; ++m) { const size_t off = (size_t)(row0 + ai * HALF + m * 16) * D + col0;
                f32x4 b0[2], b1[2];
#pragma unroll
                for (int bj = 0; bj < 2; ++bj) {
                    if (BF) { const u32x4 w = *(const u32x4*)((const bf16_t*)base + off + bj * HALF); b0[bj] = (f32x4){bflo(w.x), bfhi(w.x), bflo(w.y), bfhi(w.y)}; b1[bj] = (f32x4){bflo(w.z), bfhi(w.z), bflo(w.w), bfhi(w.w)}; }
                    else { b0[bj] = *(const f32x4*)((const float*)base + off + bj * HALF); b1[bj] = *(const f32x4*)((const float*)base + off + bj * HALF + 4); } }
#pragma unroll
                for (int bj = 0; bj < 2; ++bj) { const f32x4 v0 = b0[bj] + gv[bj][0] * (acc[ai][bj][m][0] + bv[bj][0]), v1 = b1[bj] + gv[bj][1] * (acc[ai][bj][m][1] + bv[bj][1]);
                    u32x4 w; w.x = cvt_pk_bf16(v0[0], v0[1]); w.y = cvt_pk_bf16(v0[2], v0[3]); w.z = cvt_pk_bf16(v1[0], v1[1]); w.w = cvt_pk_bf16(v1[2], v1[3]);
                    *(u32x4*)(X + off + bj * HALF) = w; } }
    }
};
struct EpiLatQ {
    static constexpr bool PERM = true, AFTER_DRAIN = false;
    bf16_t* O0; int ld0, n0; bf16_t* KR; const f32x2* cs; float* ssp;
    struct Pre {};
    __device__ __forceinline__ Pre pre(const Unit&, int, int, int, int) const { return Pre{}; }
    __device__ __forceinline__ void operator()(const f32x4 (&acc)[2][2][4][2], const Unit& u, int wr, int wc, int fr, int fq, const Pre&) const {
        const int row0 = u.pm * BM + wr * 64 + fr, col0 = u.pn * BM + wc * 32 + 8 * fq;
#pragma unroll
        for (int ai = 0; ai < 2; ++ai)
#pragma unroll
            for (int m = 0; m < 4; ++m) { const int row = row0 + ai * HALF + m * 16; float ss = 0.f;
#pragma unroll
                for (int bj = 0; bj < 2; ++bj) { const int c = col0 + bj * HALF; f32x4 v0 = acc[ai][bj][m][0], v1 = acc[ai][bj][m][1];
                    if (c < n0) {
                        ss += (v0[0] * v0[0] + v0[1] * v0[1]) + (v0[2] * v0[2] + v0[3] * v0[3]) + (v1[0] * v1[0] + v1[1] * v1[1]) + (v1[2] * v1[2] + v1[3] * v1[3]);
                        u32x4 w; w.x = cvt_pk_bf16(v0[0], v0[1]); w.y = cvt_pk_bf16(v0[2], v0[3]); w.z = cvt_pk_bf16(v1[0], v1[1]); w.w = cvt_pk_bf16(v1[2], v1[3]);
                        *(u32x4*)(O0 + (size_t)row * ld0 + c) = w;
                    } else if (KR && c < n0 + DROPE) { const int k4 = ((c - n0) >> 3) * 4; const f32x4 t0 = *(const f32x4*)(cs + (size_t)row * 32 + k4), t1 = *(const f32x4*)(cs + (size_t)row * 32 + k4 + 2);
                        const float co[4] = {t0[0], t0[2], t1[0], t1[2]}, si[4] = {t0[1], t0[3], t1[1], t1[3]};
#pragma unroll
                        for (int j = 0; j < 4; ++j) { const float x1 = v0[j], x2 = v1[j]; v0[j] = x1 * co[j] - x2 * si[j]; v1[j] = x2 * co[j] + x1 * si[j]; }
                        u32x4 w; w.x = cvt_pk_bf16(v0[0], v0[1]); w.y = cvt_pk_bf16(v0[2], v0[3]); w.z = cvt_pk_bf16(v1[0], v1[1]); w.w = cvt_pk_bf16(v1[2], v1[3]);
                        *(u32x4*)(KR + (size_t)row * DROPE + (c - n0)) = w; } }
                ss += __shfl_xor(ss, 16); ss += __shfl_xor(ss, 32);
                if (fq == 0) ssp[(size_t)row * 8 + u.pn * 4 + wc] = ss;
                asm volatile("" ::: "memory"); }
    }
};
struct EpiScaled {
    static constexpr bool PERM = true, AFTER_DRAIN = false;
    bf16_t* O; int ldo; const float* ssp; int mode, np; float inv_nd;
    struct Pre {};
    __device__ __forceinline__ Pre pre(const Unit&, int, int, int, int) const { return Pre{}; }
    __device__ __forceinline__ float rstd_of(int t) const { const f32x4 a = *(const f32x4*)(ssp + (size_t)t * 8); float s = (a[0] + a[1]) + (a[2] + a[3]);
        if (np == 8) { const f32x4 b = *(const f32x4*)(ssp + (size_t)t * 8 + 4); s += (b[0] + b[1]) + (b[2] + b[3]); } return rsqrtf(s * inv_nd + EPS); }
    __device__ __forceinline__ void operator()(const f32x4 (&acc)[2][2][4][2], const Unit& u, int wr, int wc, int fr, int fq, const Pre&) const {
        const int row0 = u.pm * BM + wr * 64 + fr, col0 = u.pn * BM + wc * 32 + 8 * fq;
        if (mode == 1) {
#pragma unroll
            for (int bj = 0; bj < 2; ++bj) { const int c = col0 + bj * HALF; float rc[8];
#pragma unroll
                for (int j = 0; j < 8; ++j) rc[j] = rstd_of(c + j);
#pragma unroll
                for (int ai = 0; ai < 2; ++ai)
#pragma unroll
                    for (int m = 0; m < 4; ++m) { const f32x4 v0 = acc[ai][bj][m][0], v1 = acc[ai][bj][m][1];
                        u32x4 w; w.x = cvt_pk_bf16(v0[0] * rc[0], v0[1] * rc[1]); w.y = cvt_pk_bf16(v0[2] * rc[2], v0[3] * rc[3]); w.z = cvt_pk_bf16(v1[0] * rc[4], v1[1] * rc[5]); w.w = cvt_pk_bf16(v1[2] * rc[6], v1[3] * rc[7]);
                        *(u32x4*)(O + (size_t)(row0 + ai * HALF + m * 16) * ldo + c) = w; }
                asm volatile("" ::: "memory"); }
        } else {
#pragma unroll
            for (int ai = 0; ai < 2; ++ai)
#pragma unroll
                for (int m = 0; m < 4; ++m) { const int row = row0 + ai * HALF + m * 16; const float r = rstd_of(row);
#pragma unroll
                    for (int bj = 0; bj < 2; ++bj) { const f32x4 v0 = acc[ai][bj][m][0] * r, v1 = acc[ai][bj][m][1] * r;
                        u32x4 w; w.x = cvt_pk_bf16(v0[0], v0[1]); w.y = cvt_pk_bf16(v0[2], v0[3]); w.z = cvt_pk_bf16(v1[0], v1[1]); w.w = cvt_pk_bf16(v1[2], v1[3]);
                        *(u32x4*)(O + (size_t)row * ldo + col0 + bj * HALF) = w; }
                    asm volatile("" ::: "memory"); }
        }
    }
};

#if NAIVE_GEMM
template <class Epi, class Sched>
__device__ __forceinline__ void gemm_phase_naive(PG8_LAS unsigned char*, const Gemm g, const Sched& S, const Epi& E) {
    const int tid = threadIdx.x, wid = tid >> 6, lane = tid & 63, wr = wid >> 2, wc = wid & 3, fr = lane & 15, fq = lane >> 4;
    const size_t tstep = (size_t)BM * g.K * 2;
    Unit u;
    for (int i = 0; S.next(i, u); ++i) {
        f32x4 acc[2][2][4][2];
        const bf16_t* Bb = (const bf16_t*)((const char*)g.Bt + S.boff(u, tstep));
#pragma unroll 1
        for (int ai = 0; ai < 2; ++ai)
#pragma unroll 1
            for (int m = 0; m < 4; ++m) {
                const bf16_t* ar = g.A + (size_t)(u.pm * BM + ai * HALF + wr * 64 + m * 16 + fr) * g.K;
#pragma unroll
                for (int bj = 0; bj < 2; ++bj)
#pragma unroll
                    for (int n = 0; n < 2; ++n) {
                        const int cs = Epi::PERM ? (bj * HALF + wc * 32 + 8 * fq + 4 * n) : (bj * HALF + wc * 32 + 16 * n + 4 * fq);
                        float s[4] = {0.f, 0.f, 0.f, 0.f};
                        for (int k = 0; k < g.K; k += 8) {
                            const u32x4 av = *(const u32x4*)(ar + k);
#pragma unroll
                            for (int j = 0; j < 4; ++j) { const u32x4 bv = *(const u32x4*)(Bb + (size_t)(cs + j) * g.K + k);
                                s[j] += bflo(av.x) * bflo(bv.x) + bfhi(av.x) * bfhi(bv.x) + bflo(av.y) * bflo(bv.y) + bfhi(av.y) * bfhi(bv.y)
                                      + bflo(av.z) * bflo(bv.z) + bfhi(av.z) * bfhi(bv.z) + bflo(av.w) * bflo(bv.w) + bfhi(av.w) * bfhi(bv.w); } }
                        f32x4 r = {s[0], s[1], s[2], s[3]};
#pragma unroll
                        for (int a2 = 0; a2 < 2; ++a2)
#pragma unroll
                            for (int m2 = 0; m2 < 4; ++m2) if (a2 == ai && m2 == m) acc[a2][bj][m2][n] = r;
                    }
            }
        E(acc, u, wr, wc, fr, fq, E.pre(u, wr, wc, fr, fq));
    }
}
#endif
}

#if NAIVE_GEMM
#define GEMM_PHASE pg8::gemm_phase_naive
#else
#define GEMM_PHASE pg8::gemm_phase
#endif
struct Frame {
    LAS unsigned char* lds; GAS unsigned char* ws; const Args* a;
    int tid, lane, wave, G, blk;
};
__device__ __forceinline__ const float* modp(const Frame& F, int l, int b, int part) { return (const float*)(F.ws + WS_MOD) + ((size_t)(l * NB + b) * 6 + part) * D; }

enum { CM_ID = 0, CM_GLU = 1, CM_UQ = 2, CM_DKV = 3 };
__device__ __forceinline__ int cvt_srccol(int mode, int n, int nvalid, int nh) {
    if (mode == CM_GLU) { const int pn = n >> 8, r = n & 255; return r < 128 ? pn * 128 + r : nh + pn * 128 + (r - 128); }
    if (mode == CM_UQ) { const int h = n / DQK, w = n - h * DQK; if (w < DNOPE) return n; const int p = w - DNOPE, blk = p >> 3, wi = p & 7, i = 4 * blk + (wi & 3); return h * DQK + (wi < 4 ? DNOPE + i : DNOPE + 32 + i); }
    if (mode == CM_DKV) { if (n < KVLORA) return n; if (n >= KVLORA + DROPE) return -1; const int p = n - KVLORA, blk = p >> 3, wi = p & 7, i = 4 * blk + (wi & 3); return KVLORA + (wi < 4 ? i : 32 + i); }
    return n < nvalid ? n : -1;
}
struct CvtJob { const float* src; bf16_t* dst; int K, ld, ndst, nvalid, mode, batch; size_t sstride, dstride; float scale; const float* kgain; };
__device__ __forceinline__ int cvt_tiles(const CvtJob& j) { return j.batch * (j.ndst / 128) * (j.K / 128); }
struct CvtTile { const float* src; bf16_t* dst; int n0, k0, sc; };
__device__ __forceinline__ CvtTile cvt_locate(const Frame& F, const CvtJob& J, int t) {
    const int nkt = J.K / 128, nnt = J.ndst / 128, per = nkt * nnt, bi = t / per, r = t - bi * per, nt = r / nkt, kt = r - nt * nkt;
    CvtTile T; T.src = J.src + (size_t)bi * J.sstride; T.dst = J.dst + (size_t)bi * J.dstride; T.n0 = nt * 128; T.k0 = kt * 128;
    T.sc = cvt_srccol(J.mode, T.n0 + 4 * (F.tid & 31), J.nvalid, J.ndst / 2); return T;
}
__device__ __forceinline__ void cvt_load(const Frame& F, const CvtJob& J, const CvtTile& T, f32x4 (&v)[8]) {
    const int kg = F.tid >> 5;
#pragma unroll
    for (int i = 0; i < 8; ++i) v[i] = T.sc >= 0 ? *(const f32x4*)(T.src + (size_t)(T.k0 + 8 * kg + i) * J.ld + T.sc) : (f32x4){0.f, 0.f, 0.f, 0.f};
}
__device__ __forceinline__ void cvt_to_lds(const Frame& F, const CvtJob& J, const CvtTile& T, const f32x4 (&v)[8], LAS unsigned char* img) {
    const int nq = F.tid & 31, kg = F.tid >> 5; float sc[8];
#pragma unroll
    for (int i = 0; i < 8; ++i) sc[i] = J.kgain ? J.scale * J.kgain[T.k0 + 8 * kg + i] : J.scale;
#pragma unroll
    for (int j = 0; j < 4; ++j) {
        u32x4 w; w.x = cvt_pk_bf16(v[0][j] * sc[0], v[1][j] * sc[1]); w.y = cvt_pk_bf16(v[2][j] * sc[2], v[3][j] * sc[3]); w.z = cvt_pk_bf16(v[4][j] * sc[4], v[5][j] * sc[5]); w.w = cvt_pk_bf16(v[6][j] * sc[6], v[7][j] * sc[7]);
        *(LAS u32x4*)(img + (4 * nq + j) * 256 + ((kg ^ (nq & 7)) << 4)) = w; }
}
__device__ __forceinline__ void cvt_from_lds(const Frame& F, const CvtJob& J, const CvtTile& T, const LAS unsigned char* img) {
#pragma unroll
    for (int p = 0; p < 4; ++p) { const int row = p * 32 + (F.tid >> 4), c = F.tid & 15;
        const u32x4 w = *(const LAS u32x4*)(img + row * 256 + ((c ^ ((row >> 2) & 7)) << 4));
        *(u32x4*)(T.dst + (size_t)(T.n0 + row) * J.K + T.k0 + c * 8) = w; }
}
__device__ __forceinline__ void cvt_job(const Frame& F, const CvtJob& J, int t0, int nt) {
    for (int t = t0; t < nt; t += 2 * F.G) {
        const bool two = t + F.G < nt;
        const CvtTile A = cvt_locate(F, J, t), B = cvt_locate(F, J, two ? t + F.G : t);
        f32x4 va[8], vb[8];
        cvt_load(F, J, A, va); if (two) cvt_load(F, J, B, vb);
        cvt_to_lds(F, J, A, va, F.lds); if (two) cvt_to_lds(F, J, B, vb, F.lds + 32768);
        __syncthreads();
        cvt_from_lds(F, J, A, F.lds); if (two) cvt_from_lds(F, J, B, F.lds + 32768);
        __syncthreads();
    }
}
__device__ __forceinline__ void sincos_small(float r, float& s, float& c) {
    const float q = rintf(r * 0.63661977236758134f); const float y = fmaf(q, -1.5707963267948966f, r) + q * 4.371139e-8f; const int qi = (int)q & 3;
    const float y2 = y * y;
    const float sp = y + y * y2 * (-1.6666654611e-1f + y2 * (8.3321608736e-3f + y2 * (-1.9515295891e-4f)));
    const float cp = 1.0f - 0.5f * y2 + y2 * y2 * (4.166664568298827e-2f + y2 * (-1.388731625493765e-3f + y2 * 2.443315711809948e-5f));
    s = (qi == 0) ? sp : (qi == 1) ? cp : (qi == 2) ? -sp : -cp;
    c = (qi == 0) ? cp : (qi == 1) ? -sp : (qi == 2) ? -cp : sp;
}
__device__ __forceinline__ void ph_prologue(const Frame& F) {
    const Args& A = *F.a; GAS unsigned char* ws = F.ws;
    const float qscale = 0.07216878364870322f * 1.4426950408889634f;
    CvtJob J[10];
    J[0] = {GPTR(const float, A.in[I_PW1W]), (bf16_t*)(ws + WS_WPW1), 1024, 2048, 2048, 2048, CM_GLU, 1, 0, 0, 1.f, nullptr};
    J[1] = {GPTR(const float, A.in[I_PW2W]), (bf16_t*)(ws + WS_WPW2), 1024, 1024, 1024, 1024, CM_ID, 1, 0, 0, 1.f, nullptr};
    J[2] = {GPTR(const float, A.in[I_WDKV]), (bf16_t*)(ws + WS_WDKV), 1024, 320, 512, 320, CM_DKV, 1, 0, 0, 1.f, nullptr};
    J[3] = {GPTR(const float, A.in[I_WDQ]), (bf16_t*)(ws + WS_WDQ), 1024, 384, 512, 384, CM_ID, 1, 0, 0, 1.f, nullptr};
    J[4] = {GPTR(const float, A.in[I_WUK]), (bf16_t*)(ws + WS_WUK), 256, 1024, 1024, 1024, CM_ID, 1, 0, 0, 1.f, GPTR(const float, A.in[I_CKVG])};
    J[5] = {GPTR(const float, A.in[I_WUV]), (bf16_t*)(ws + WS_WUV), 256, 1024, 1024, 1024, CM_ID, 1, 0, 0, 1.f, GPTR(const float, A.in[I_CKVG])};
    J[6] = {GPTR(const float, A.in[I_WUQ]), (bf16_t*)(ws + WS_WUQ), 384, 1536, 1536, 1536, CM_UQ, 1, 0, 0, qscale, GPTR(const float, A.in[I_CQG])};
    J[7] = {GPTR(const float, A.in[I_WO]), (bf16_t*)(ws + WS_WO), 1024, 1024, 1024, 1024, CM_ID, 1, 0, 0, 1.f, nullptr};
    J[8] = {GPTR(const float, A.in[I_WGU]), (bf16_t*)(ws + WS_WGU), 1024, 2048, 2048, 2048, CM_GLU, 64, (size_t)1024 * 2048, (size_t)2048 * 1024, 1.f, nullptr};
    J[9] = {GPTR(const float, A.in[I_WDN]), (bf16_t*)(ws + WS_WDN), 1024, 1024, 1024, 1024, CM_ID, 64, (size_t)1024 * 1024, (size_t)1024 * 1024, 1.f, nullptr};
    int base = 0;
#pragma unroll
    for (int j = 0; j < 10; ++j) { const int nt = cvt_tiles(J[j]);
        int t = F.blk - (base % F.G); if (t < 0) t += F.G;
        cvt_job(F, J[j], t, nt);
        base += nt; }
    {
        LAS float* cact = (LAS float*)F.lds;
        LAS float* red = cact + 4096;
        for (int i = F.tid; i < NB * D; i += NTHR) { const float c = GPTR(const float, A.in[I_C])[i]; cact[i] = c * sigmoidf_(c); }
        __syncthreads();
        for (int it = F.blk; it < 2 * 96; it += F.G) {
            const int l = it / 96, j0 = (it - l * 96) * 64, col = F.tid & 63, dg = F.tid >> 6;
            const float* wp = GPTR(const float, A.in[I_MODW]) + (size_t)l * D * 6 * D + (size_t)(dg * 128) * (6 * D) + j0 + col;
            float a0 = 0.f, a1 = 0.f, a2 = 0.f, a3 = 0.f;
#pragma unroll 32
            for (int d = 0; d < 128; ++d) { const float w = wp[(size_t)d * (6 * D)]; const int dd = dg * 128 + d;
                a0 += w * cact[dd]; a1 += w * cact[1024 + dd]; a2 += w * cact[2048 + dd]; a3 += w * cact[3072 + dd]; }
            red[(dg * 4 + 0) * 64 + col] = a0; red[(dg * 4 + 1) * 64 + col] = a1; red[(dg * 4 + 2) * 64 + col] = a2; red[(dg * 4 + 3) * 64 + col] = a3;
            __syncthreads();
            if (F.tid < 256) { const int b = F.tid >> 6, c2 = F.tid & 63; float s = GPTR(const float, A.in[I_MODB])[l * 6 * D + j0 + c2];
#pragma unroll
                for (int g = 0; g < 8; ++g) s += red[(g * 4 + b) * 64 + c2];
                ((float*)(ws + WS_MOD))[(size_t)(l * NB + b) * (6 * D) + j0 + c2] = s; }
            __syncthreads();
        }
    }
    {
        const int* pos = (const int*)GPTR(const float, A.in[I_POS]); f32x2* cs = (f32x2*)(ws + WS_CS);
        for (int idx = F.blk * NTHR + F.tid; idx < NTOK * 32; idx += F.G * NTHR) {
            const int tok = idx >> 5, i = idx & 31;
            const double inv = exp(-(2.0 * 9.210340371976184 / 64.0) * (double)i);
            const double ang = (double)pos[tok] * inv, rev = ang * 0.15915494309189535, fr = rev - rint(rev);
            float s, c; sincos_small((float)(fr * 6.283185307179586), s, c);
            cs[idx] = (f32x2){c, s};
        }
    }
}

__device__ __forceinline__ void row_ld16(const float* p, int lane, f32x4 (&v)[4]) {
#pragma unroll
    for (int i = 0; i < 4; ++i) v[i] = *(const f32x4*)(p + i * 256 + lane * 4);
}
__device__ __forceinline__ void row_st16_bf16(bf16_t* p, int lane, const f32x4 (&v)[4]) {
#pragma unroll
    for (int i = 0; i < 4; ++i) { u32x2 w; w.x = cvt_pk_bf16(v[i][0], v[i][1]); w.y = cvt_pk_bf16(v[i][2], v[i][3]); *(u32x2*)(p + i * 256 + lane * 4) = w; }
}
__device__ __forceinline__ float row_rstd(const f32x4 (&v)[4]) {
    float s = 0.f;
#pragma unroll
    for (int i = 0; i < 4; ++i) s += v[i][0] * v[i][0] + v[i][1] * v[i][1] + v[i][2] * v[i][2] + v[i][3] * v[i][3];
    s = wave_sum(s);
    return rsqrtf(s * (1.0f / D) + EPS);
}

__device__ __forceinline__ void ph_norm1(const Frame& F) {
    const Args& A = *F.a; bf16_t* HA = (bf16_t*)(F.ws + WS_HA); const float* g = GPTR(const float, A.in[I_N1G]);
    for (int row = F.blk * NWAVE + F.wave; row < NTOK; row += F.G * NWAVE) {
        const int b = row / SEQ; f32x4 v[4], gv[4], sh[4], sc[4];
        row_ld16(GPTR(const float, A.in[I_X]) + (size_t)row * D, F.lane, v); row_ld16(g, F.lane, gv); row_ld16(modp(F, 0, b, 0), F.lane, sh); row_ld16(modp(F, 0, b, 1), F.lane, sc);
        const float rs = row_rstd(v);
#pragma unroll
        for (int i = 0; i < 4; ++i) v[i] = v[i] * rs * gv[i] * (sc[i] + 1.0f) + sh[i];
        row_st16_bf16(HA + (size_t)row * D, F.lane, v);
    }
}

__device__ __forceinline__ void ph_conv(const Frame& F) {
    const Args& A = *F.a; const bf16_t* U = (const bf16_t*)(F.ws + WS_HB); bf16_t* O = (bf16_t*)(F.ws + WS_HC);
    LAS unsigned char* tile = F.lds;
    LAS f32x2* part = (LAS f32x2*)(F.lds + 62 * 2048);
    LAS f32x2* red = part + 8 * NTHR;
    const int c2 = F.tid * 2;
    f32x2 w[CONVW];
#pragma unroll
    for (int j = 0; j < CONVW; ++j) w[j] = *(const f32x2*)(GPTR(const float, A.in[I_DWW]) + j * D + c2);
    const f32x2 db = *(const f32x2*)(GPTR(const float, A.in[I_DWB]) + c2), lg = *(const f32x2*)(GPTR(const float, A.in[I_LNG]) + c2), lb = *(const f32x2*)(GPTR(const float, A.in[I_LNB]) + c2);
    for (int t = F.blk; t < NTOK / 32; t += F.G) {
        const int tok0 = t * 32, s0 = tok0 % SEQ;
        for (int ch = F.tid; ch < 62 * 128; ch += NTHR) { const int r = ch >> 7, cc = ch & 127; u32x4 v = {0u, 0u, 0u, 0u};
            if (s0 + r - 30 >= 0) v = *(const u32x4*)(U + (size_t)(tok0 + r - 30) * D + cc * 8);
            *(LAS u32x4*)(tile + r * 2048 + cc * 16) = v; }
        __syncthreads();
#pragma unroll 1
        for (int g = 0; g < 4; ++g) {
            f32x2 acc[8];
#pragma unroll
            for (int r = 0; r < 8; ++r) acc[r] = db;
#pragma unroll
            for (int j = 0; j < 38; ++j) { const unsigned u = *(const LAS unsigned*)(tile + (g * 8 + j) * 2048 + F.tid * 4); const f32x2 x = {bflo(u), bfhi(u)};
#pragma unroll
                for (int r = 0; r < 8; ++r) { const int tap = j - r; if (tap >= 0 && tap < CONVW) acc[r] += x * w[tap]; } }
#pragma unroll
            for (int r = 0; r < 8; ++r) part[r * NTHR + F.tid] = (f32x2){acc[r][0] + acc[r][1], acc[r][0] * acc[r][0] + acc[r][1] * acc[r][1]};
            __syncthreads();
            { float s = 0.f, q = 0.f;
#pragma unroll
              for (int i = 0; i < 8; ++i) { const f32x2 p = part[F.wave * NTHR + i * 64 + F.lane]; s += p[0]; q += p[1]; }
              s = wave_sum(s); q = wave_sum(q);
              if (F.lane == 0) { const float mean = s * (1.0f / D), var = fmaxf(q * (1.0f / D) - mean * mean, 0.f); red[F.wave] = (f32x2){mean, rsqrtf(var + EPS)}; } }
            __syncthreads();
#pragma unroll
            for (int r = 0; r < 8; ++r) { const f32x2 st = red[r]; const float mean = st[0], rs = st[1];
                const float y0 = (acc[r][0] - mean) * rs * lg[0] + lb[0], y1 = (acc[r][1] - mean) * rs * lg[1] + lb[1];
                *(unsigned*)(O + (size_t)(tok0 + g * 8 + r) * D + c2) = cvt_pk_bf16(y0 * sigmoidf_(y0), y1 * sigmoidf_(y1)); }
            __syncthreads();
        }
    }
}

__device__ __forceinline__ void ph_router_prep(const Frame& F) {
    const Args& A = *F.a; bf16_t* rwf = (bf16_t*)(F.ws + WS_RWF); float* rbias = (float*)(F.ws + WS_RBIAS);
    for (int it = F.blk; it < 8 * 64; it += F.G) {
        const int lb = it >> 6, s = it & 63, l = lb >> 2, b = lb & 3, hh = F.tid >> 8, e = (F.tid >> 3) & 31, j = F.tid & 7, k = 16 * s + 8 * hh + j;
        const float v = GPTR(const float, A.in[I_N2G])[l * D + k] * (1.0f + modp(F, l, b, 4)[k]) * GPTR(const float, A.in[I_RW])[(size_t)l * D * NE + k * NE + e];
        const unsigned hi = cvt_pk_bf16(v, 0.f) & 0xffffu; const float rem = v - bflo(hi); const unsigned lo = cvt_pk_bf16(rem, 0.f) & 0xffffu;
        const size_t o = ((size_t)lb * 2 * 64 * 2 * 32 + ((size_t)s * 2 + hh) * 32 + e) * 8 + j;
        rwf[o] = (bf16_t)hi; rwf[o + (size_t)64 * 2 * 32 * 8] = (bf16_t)lo;
    }
    if (F.blk < 8) { const int l = F.blk >> 2, b = F.blk & 3, e = F.tid >> 4, q = F.tid & 15; float s = 0.f;
        for (int k = q; k < D; k += 16) s += modp(F, l, b, 3)[k] * GPTR(const float, A.in[I_RW])[(size_t)l * D * NE + k * NE + e];
        s += __shfl_xor(s, 8); s += __shfl_xor(s, 4); s += __shfl_xor(s, 2); s += __shfl_xor(s, 1);
        if (q == 0) rbias[F.blk * NE + e] = s + GPTR(const float, A.in[I_RB])[l * NE + e]; }
}

__device__ __forceinline__ void moe_layout(const Frame& F, int l, LAS int* tab, LAS int* fb) {
    const unsigned* tot = (const unsigned*)(F.ws + WS_MOETOT) + l * NE;
    LAS int* nbv = fb + 40;
    if (F.tid < NE) nbv[F.tid] = (int)((tot[F.tid] + EBLK - 1) / EBLK);
    __syncthreads();
    if (F.tid <= NE) { int s = 0; for (int e = 0; e < F.tid; ++e) s += nbv[e]; fb[F.tid] = s; if (F.tid == NE && tab) tab[0] = s; }
    __syncthreads();
    if (tab) for (int i = F.tid; i < MAXBLK; i += NTHR) { int e = 0;
#pragma unroll 1
        for (int q = 1; q < NE; ++q) e = (i >= fb[q]) ? q : e;
        tab[1 + i] = e; }
    __syncthreads();
}

__device__ __forceinline__ void ph_router(const Frame& F, int l) {
    const Args& A = *F.a; const bf16_t* X = (const bf16_t*)(F.ws + WS_X); bf16_t* HA = (bf16_t*)(F.ws + WS_HA);
    const int ntok_blk = NTOK / F.G, tok0 = F.blk * ntok_blk, b = tok0 / SEQ;
    LAS unsigned char* wl_ = F.lds;
    LAS int* cnt = (LAS int*)(F.lds + 131072 + 2304);
    LAS float* cx = (LAS float*)(F.lds + 135168);
    LAS float* sq = (LAS float*)(F.lds + 135168 + 16384);
    { const u32x4* src = (const u32x4*)(F.ws + WS_RWF + (size_t)(l * NB + b) * 131072);
      for (int i = F.tid; i < 131072 / 16; i += NTHR) *(LAS u32x4*)(wl_ + i * 16) = src[i]; }
    if (F.tid < NE) cnt[F.tid] = 0;
    __syncthreads();
    const int w = F.wave, lane = F.lane, grp = w & 3, kh = w >> 2, r = lane & 31, hi = lane >> 5;
    {
        const bf16_t* xr = X + (size_t)(tok0 + grp * 32 + r) * D + kh * 512 + hi * 8;
        const LAS unsigned char* bw = wl_ + ((kh * 32 * 2 + hi) * 32 + r) * 16;
        f32x16 acc;
#pragma unroll
        for (int i = 0; i < 16; ++i) acc[i] = 0.f;
        float ssq = 0.f;
        u32x4 xa[8], xb[8];
#define RT_LD(dst, s0) do { _Pragma("unroll") for (int u = 0; u < 8; ++u) dst[u] = *(const u32x4*)(xr + ((s0) + u) * 16); } while (0)
#define RT_DO(src, s0) do { _Pragma("unroll") for (int u = 0; u < 8; ++u) { const u32x4 xw = src[u]; \
            { const float a0 = bflo(xw.x), a1 = bfhi(xw.x), a2 = bflo(xw.y), a3 = bfhi(xw.y), a4 = bflo(xw.z), a5 = bfhi(xw.z), a6 = bflo(xw.w), a7 = bfhi(xw.w); \
              ssq += (a0 * a0 + a1 * a1) + (a2 * a2 + a3 * a3) + (a4 * a4 + a5 * a5) + (a6 * a6 + a7 * a7); } \
            const bf16x8 ah = *(const bf16x8*)&xw; \
            const bf16x8 bh = *(const LAS bf16x8*)(bw + ((s0) + u) * 1024), bl = *(const LAS bf16x8*)(bw + ((s0) + u) * 1024 + 65536); \
            acc = __builtin_amdgcn_mfma_f32_32x32x16_bf16(ah, bh, acc, 0, 0, 0); acc = __builtin_amdgcn_mfma_f32_32x32x16_bf16(ah, bl, acc, 0, 0, 0); } } while (0)
        RT_LD(xa, 0);
#pragma unroll 1
        for (int s0 = 0; s0 < 32; s0 += 16) { RT_LD(xb, s0 + 8); RT_DO(xa, s0); if (s0 + 16 < 32) RT_LD(xa, s0 + 16); RT_DO(xb, s0 + 8); }
#undef RT_LD
#undef RT_DO
        sq[(grp * 32 + r) * 4 + kh * 2 + hi] = ssq;
        if (kh == 1) { LAS float* c = cx + (grp * 64 + lane) * 16;
#pragma unroll
            for (int i = 0; i < 4; ++i) *(LAS f32x4*)(c + i * 4) = (f32x4){acc[4 * i], acc[4 * i + 1], acc[4 * i + 2], acc[4 * i + 3]}; }
        __syncthreads();
        if (kh == 0) { const LAS float* c = cx + (grp * 64 + lane) * 16;
#pragma unroll
            for (int i = 0; i < 4; ++i) { const f32x4 p = *(const LAS f32x4*)(c + i * 4); acc[4 * i] += p[0]; acc[4 * i + 1] += p[1]; acc[4 * i + 2] += p[2]; acc[4 * i + 3] += p[3]; } }
        __syncthreads();
        if (kh == 0) {
#pragma unroll
            for (int i = 0; i < 16; ++i) cx[(grp * 32 + (i & 3) + 8 * (i >> 2) + 4 * hi) * 32 + r] = acc[i]; }
        __syncthreads();
    }
    float* gate = (float*)(F.ws + WS_GATE);
    LAS int* asg_e = (LAS int*)(F.lds + 155648); LAS int* asg_r = asg_e + 512; LAS int* basel = asg_r + 512;
    if (F.tid < 128) {
        const int row = tok0 + F.tid; const f32x4 q4 = *(const LAS f32x4*)(sq + F.tid * 4);
        const float rs = rsqrtf(((q4[0] + q4[1]) + (q4[2] + q4[3])) * (1.0f / D) + EPS); sq[512 + F.tid] = rs;
        const float* bias = (const float*)(F.ws + WS_RBIAS) + (l * NB + b) * NE;
        float lg[NE];
#pragma unroll
        for (int i = 0; i < 8; ++i) { const f32x4 c = *(const LAS f32x4*)(cx + F.tid * 32 + i * 4), bb = *(const f32x4*)(bias + i * 4);
            lg[4 * i] = c[0] * rs + bb[0]; lg[4 * i + 1] = c[1] * rs + bb[1]; lg[4 * i + 2] = c[2] * rs + bb[2]; lg[4 * i + 3] = c[3] * rs + bb[3]; }
        float tv[4]; int ti[4];
#pragma unroll
        for (int k = 0; k < 4; ++k) { float bv = lg[0]; int bi = 0;
#pragma unroll
            for (int e2 = 1; e2 < NE; ++e2) { if (lg[e2] > bv) { bv = lg[e2]; bi = e2; } }
            tv[k] = bv; ti[k] = bi;
#pragma unroll
            for (int e2 = 0; e2 < NE; ++e2) lg[e2] = (e2 == bi) ? -__builtin_inff() : lg[e2]; }
        const float e1 = __expf(tv[1] - tv[0]), e2 = __expf(tv[2] - tv[0]), e3 = __expf(tv[3] - tv[0]), inv = 1.0f / (1.0f + e1 + e2 + e3);
        *(f32x4*)(gate + (size_t)row * 4) = (f32x4){inv, e1 * inv, e2 * inv, e3 * inv};
        int4 tq, rq; tq.x = ti[0]; tq.y = ti[1]; tq.z = ti[2]; tq.w = ti[3];
        rq.x = __hip_atomic_fetch_add(&cnt[ti[0]], 1, __ATOMIC_RELAXED, __HIP_MEMORY_SCOPE_WORKGROUP); rq.y = __hip_atomic_fetch_add(&cnt[ti[1]], 1, __ATOMIC_RELAXED, __HIP_MEMORY_SCOPE_WORKGROUP);
        rq.z = __hip_atomic_fetch_add(&cnt[ti[2]], 1, __ATOMIC_RELAXED, __HIP_MEMORY_SCOPE_WORKGROUP); rq.w = __hip_atomic_fetch_add(&cnt[ti[3]], 1, __ATOMIC_RELAXED, __HIP_MEMORY_SCOPE_WORKGROUP);
        asg_e[F.tid * 4] = tq.x; asg_e[F.tid * 4 + 1] = tq.y; asg_e[F.tid * 4 + 2] = tq.z; asg_e[F.tid * 4 + 3] = tq.w;
        asg_r[F.tid * 4] = rq.x; asg_r[F.tid * 4 + 1] = rq.y; asg_r[F.tid * 4 + 2] = rq.z; asg_r[F.tid * 4 + 3] = rq.w;
    }
    __syncthreads();
    if (F.tid < NE) basel[F.tid] = (int)__hip_atomic_fetch_add((unsigned*)(F.ws + WS_MOETOT) + l * NE + F.tid, (unsigned)cnt[F.tid], __ATOMIC_RELAXED, __HIP_MEMORY_SCOPE_AGENT);
    __syncthreads();
    { int* slotp = (int*)(F.ws + WS_SLOT); int* rowtab2 = (int*)(F.ws + WS_ROWTAB2);
      for (int it = F.tid; it < ntok_blk * 4 * 8; it += NTHR) { const int a = it >> 3, c8 = it & 7, e = asg_e[a], gr = basel[e] + asg_r[a];
          if (c8 == 0) slotp[(size_t)tok0 * 4 + a] = e * 32768 + gr;
          const int blk = gr >> 8, r = gr & 255, hh = r >> 7, R = r & 127, bb = pg8::lds_byte(R, c8 * 8), pi = bb >> 13, lt = (bb & 8191) >> 4;
          rowtab2[((((size_t)e * 128 + blk) * 512 + lt) * 2 + hh) * 2 + pi] = tok0 + (a >> 2); } }
    { const float* g = GPTR(const float, A.in[I_N2G]) + l * D; f32x4 gv[4], sh[4], sc[4];
      row_ld16(g, F.lane, gv); row_ld16(modp(F, l, b, 3), F.lane, sh); row_ld16(modp(F, l, b, 4), F.lane, sc);
#pragma unroll
      for (int i = 0; i < 4; ++i) gv[i] = gv[i] * (sc[i] + 1.0f);
      for (int it = F.wave; it < ntok_blk; it += 2 * NWAVE) { const bool two = it + NWAVE < ntok_blk;
          u32x2 w0[4], w1[4];
#pragma unroll
          for (int i = 0; i < 4; ++i) { w0[i] = *(const u32x2*)(X + (size_t)(tok0 + it) * D + i * 256 + F.lane * 4); if (two) w1[i] = *(const u32x2*)(X + (size_t)(tok0 + it + NWAVE) * D + i * 256 + F.lane * 4); }
          const float r0 = sq[512 + it], r1 = two ? sq[512 + it + NWAVE] : 0.f;
          f32x4 v0[4], v1[4];
#pragma unroll
          for (int i = 0; i < 4; ++i) v0[i] = (f32x4){bflo(w0[i].x), bfhi(w0[i].x), bflo(w0[i].y), bfhi(w0[i].y)} * r0 * gv[i] + sh[i];
          row_st16_bf16(HA + (size_t)(tok0 + it) * D, F.lane, v0);
          if (two) {
#pragma unroll
              for (int i = 0; i < 4; ++i) v1[i] = (f32x4){bflo(w1[i].x), bfhi(w1[i].x), bflo(w1[i].y), bfhi(w1[i].y)} * r1 * gv[i] + sh[i];
              row_st16_bf16(HA + (size_t)(tok0 + it + NWAVE) * D, F.lane, v1); } } }
    __syncthreads();
}

__device__ __forceinline__ void ph_combine(const Frame& F, int l) {
    const Args& A = *F.a; const bf16_t* X = (const bf16_t*)(F.ws + WS_X); bf16_t* XO = (bf16_t*)(F.ws + WS_X2); const bf16_t* Y = (const bf16_t*)(F.ws + WS_XG);
    const int* slot = (const int*)(F.ws + WS_SLOT); const float* gate = (const float*)(F.ws + WS_GATE);
    LAS int* fbk = (LAS int*)F.lds; moe_layout(F, l, nullptr, fbk);
    const int stride = F.G * NWAVE; int row = F.blk * NWAVE + F.wave;
    if (row >= NTOK) return;
    int4 sq_c = *(const int4*)(slot + (size_t)row * 4); f32x4 gq_c = *(const f32x4*)(gate + (size_t)row * 4);
    int4 sq_n = sq_c; f32x4 gq_n = gq_c;
    if (row + stride < NTOK) { sq_n = *(const int4*)(slot + (size_t)(row + stride) * 4); gq_n = *(const f32x4*)(gate + (size_t)(row + stride) * 4); }
    u32x4 yc[4][2], yn[4][2]; f32x4 xc[4], xn[4];
#define CMB_LOAD(yv, xq, sq, r_) do { const int ss_[4] = {fbk[sq.x >> 15] * EBLK + (sq.x & 32767), fbk[sq.y >> 15] * EBLK + (sq.y & 32767), fbk[sq.z >> 15] * EBLK + (sq.z & 32767), fbk[sq.w >> 15] * EBLK + (sq.w & 32767)}; \
        _Pragma("unroll") for (int k = 0; k < 4; ++k) _Pragma("unroll") for (int i = 0; i < 2; ++i) yv[k][i] = *(const u32x4*)(Y + (size_t)ss_[k] * D + i * 512 + F.lane * 8); \
        _Pragma("unroll") for (int i = 0; i < 2; ++i) { const u32x4 xw_ = *(const u32x4*)(X + (size_t)(r_) * D + i * 512 + F.lane * 8); \
            xq[i * 2] = (f32x4){bflo(xw_.x), bfhi(xw_.x), bflo(xw_.y), bfhi(xw_.y)}; xq[i * 2 + 1] = (f32x4){bflo(xw_.z), bfhi(xw_.z), bflo(xw_.w), bfhi(xw_.w)}; } } while (0)
    CMB_LOAD(yc, xc, sq_c, row);
    for (; row < NTOK; row += stride) {
        const int b = row / SEQ; const bool has_n = row + stride < NTOK;
        const f32x4 gq = gq_c;
        if (has_n) CMB_LOAD(yn, xn, sq_n, row + stride);
        int4 sq_nn = sq_n; f32x4 gq_nn = gq_n;
        if (row + 2 * stride < NTOK) { sq_nn = *(const int4*)(slot + (size_t)(row + 2 * stride) * 4); gq_nn = *(const f32x4*)(gate + (size_t)(row + 2 * stride) * 4); }
        float acc[16];
#pragma unroll
        for (int i = 0; i < 16; ++i) acc[i] = 0.f;
#pragma unroll
        for (int k = 0; k < 4; ++k) { const float gk = gq[k];
#pragma unroll
            for (int i = 0; i < 2; ++i) { const u32x4 w = yc[k][i];
                acc[i * 8 + 0] += gk * bflo(w.x); acc[i * 8 + 1] += gk * bfhi(w.x); acc[i * 8 + 2] += gk * bflo(w.y); acc[i * 8 + 3] += gk * bfhi(w.y);
                acc[i * 8 + 4] += gk * bflo(w.z); acc[i * 8 + 5] += gk * bfhi(w.z); acc[i * 8 + 6] += gk * bflo(w.w); acc[i * 8 + 7] += gk * bfhi(w.w); } }
        const float* g2 = modp(F, l, b, 5);
        float xv[16]; float ssq = 0.f;
#pragma unroll
        for (int i = 0; i < 2; ++i)
#pragma unroll
            for (int h = 0; h < 2; ++h) { const int c = i * 512 + F.lane * 8 + h * 4; const f32x4 x0 = xc[i * 2 + h], gg = *(const f32x4*)(g2 + c);
#pragma unroll
                for (int j = 0; j < 4; ++j) { const float x = x0[j] + gg[j] * acc[i * 8 + h * 4 + j]; xv[i * 8 + h * 4 + j] = x; ssq += x * x; } }
        ssq = wave_sum(ssq); const float rs = rsqrtf(ssq * (1.0f / D) + EPS);
        if (l == 0) {
            bf16_t* HB = (bf16_t*)(F.ws + WS_HB); bf16_t* HA = (bf16_t*)(F.ws + WS_HA);
            const float* kvg = GPTR(const float, A.in[I_KVG]); const float* g1 = GPTR(const float, A.in[I_N1G]) + D; const float* sh = modp(F, 1, b, 0); const float* sc = modp(F, 1, b, 1);
#pragma unroll
            for (int i = 0; i < 2; ++i) { const int c = i * 512 + F.lane * 8; float o1[8], o2[8];
#pragma unroll
                for (int h = 0; h < 2; ++h) { const f32x4 kg = *(const f32x4*)(kvg + c + h * 4), gg = *(const f32x4*)(g1 + c + h * 4), s1 = *(const f32x4*)(sh + c + h * 4), s2 = *(const f32x4*)(sc + c + h * 4);
#pragma unroll
                    for (int j = 0; j < 4; ++j) { const float xh = xv[i * 8 + h * 4 + j] * rs; o1[h * 4 + j] = xh * kg[j]; o2[h * 4 + j] = xh * gg[j] * (s2[j] + 1.0f) + s1[j]; } }
                u32x4 w1, w2; w1.x = cvt_pk_bf16(o1[0], o1[1]); w1.y = cvt_pk_bf16(o1[2], o1[3]); w1.z = cvt_pk_bf16(o1[4], o1[5]); w1.w = cvt_pk_bf16(o1[6], o1[7]);
                w2.x = cvt_pk_bf16(o2[0], o2[1]); w2.y = cvt_pk_bf16(o2[2], o2[3]); w2.z = cvt_pk_bf16(o2[4], o2[5]); w2.w = cvt_pk_bf16(o2[6], o2[7]);
                u32x4 w0; w0.x = cvt_pk_bf16(xv[i * 8], xv[i * 8 + 1]); w0.y = cvt_pk_bf16(xv[i * 8 + 2], xv[i * 8 + 3]); w0.z = cvt_pk_bf16(xv[i * 8 + 4], xv[i * 8 + 5]); w0.w = cvt_pk_bf16(xv[i * 8 + 6], xv[i * 8 + 7]);
                *(u32x4*)(XO + (size_t)row * D + c) = w0; *(u32x4*)(HB + (size_t)row * D + c) = w1; *(u32x4*)(HA + (size_t)row * D + c) = w2; }
        } else {
            const float* fg = GPTR(const float, A.in[I_FG]);
#pragma unroll
            for (int i = 0; i < 2; ++i)
#pragma unroll
                for (int h = 0; h < 2; ++h) { const int c = i * 512 + F.lane * 8 + h * 4; const f32x4 gg = *(const f32x4*)(fg + c);
                    *(f32x4*)(GPTR(float, A.out) + (size_t)row * D + c) = (f32x4){xv[i * 8 + h * 4] * rs * gg[0], xv[i * 8 + h * 4 + 1] * rs * gg[1], xv[i * 8 + h * 4 + 2] * rs * gg[2], xv[i * 8 + h * 4 + 3] * rs * gg[3]}; }
        }
#pragma unroll
        for (int k = 0; k < 4; ++k) { yc[k][0] = yn[k][0]; yc[k][1] = yn[k][1]; xc[k] = xn[k]; }
        sq_c = sq_n; gq_c = gq_n; sq_n = sq_nn; gq_n = gq_nn;
    }
#undef CMB_LOAD
}

__device__ __forceinline__ void ph_latpost(const Frame& F) {
    const Args& A = *F.a; const float* LAT = (const float*)(F.ws + WS_LAT); const float* CQP = (const float*)(F.ws + WS_CQP);
    bf16_t* CKV = (bf16_t*)(F.ws + WS_CKV); bf16_t* KR = (bf16_t*)(F.ws + WS_KR); bf16_t* CQ = (bf16_t*)(F.ws + WS_CQ); const f32x2* cs = (const f32x2*)(F.ws + WS_CS);
    for (int row = F.blk * NWAVE + F.wave; row < NTOK; row += F.G * NWAVE) {
        const float* lr = LAT + (size_t)row * 512;
        { const f32x4 v = *(const f32x4*)(lr + F.lane * 4), g = *(const f32x4*)(GPTR(const float, A.in[I_CKVG]) + F.lane * 4);
          float s = wave_sum(v[0] * v[0] + v[1] * v[1] + v[2] * v[2] + v[3] * v[3]); const float rs = rsqrtf(s * (1.0f / KVLORA) + EPS);
          u32x2 w; w.x = cvt_pk_bf16(v[0] * rs * g[0], v[1] * rs * g[1]); w.y = cvt_pk_bf16(v[2] * rs * g[2], v[3] * rs * g[3]); *(u32x2*)(CKV + (size_t)row * KVLORA + F.lane * 4) = w; }
        if (F.lane < 32) { const int i = F.lane; const float x1 = lr[KVLORA + i], x2 = lr[KVLORA + 32 + i]; const f32x2 t = cs[(size_t)row * 32 + i];
          const float r1 = x1 * t[0] - x2 * t[1], r2 = x2 * t[0] + x1 * t[1]; const int p = (i >> 2) * 8 + (i & 3);
          KR[(size_t)row * DROPE + p] = (bf16_t)(cvt_pk_bf16(r1, r1) & 0xffffu); KR[(size_t)row * DROPE + p + 4] = (bf16_t)(cvt_pk_bf16(r2, r2) & 0xffffu); }
        { const float* qr = CQP + (size_t)row * 512; f32x2 v[3]; float s = 0.f;
#pragma unroll
          for (int i = 0; i < 3; ++i) { v[i] = *(const f32x2*)(qr + i * 128 + F.lane * 2); s += v[i][0] * v[i][0] + v[i][1] * v[i][1]; }
          s = wave_sum(s); const float rs = rsqrtf(s * (1.0f / QLORA) + EPS);
#pragma unroll
          for (int i = 0; i < 3; ++i) { const f32x2 g = *(const f32x2*)(GPTR(const float, A.in[I_CQG]) + i * 128 + F.lane * 2);
              *(unsigned*)(CQ + (size_t)row * QLORA + i * 128 + F.lane * 2) = cvt_pk_bf16(v[i][0] * rs * g[0], v[i][1] * rs * g[1]); } }
    }
}
constexpr int AT_KB = 24576, AT_VB0 = 49152, AT_VB = 16384;
#define AT_UPTR(p) ({ const GAS char* p_ = (const GAS char*)(p); asm volatile("" : "+s"(p_)); p_; })
#define AT_BAR() do { asm volatile("s_waitcnt lgkmcnt(0)" ::: "memory"); __builtin_amdgcn_s_barrier(); asm volatile("" ::: "memory"); } while (0)
#define AT_SB() __builtin_amdgcn_sched_barrier(0x6)
__device__ __forceinline__ void at_glds16(unsigned voff, const GAS char* sbase, unsigned lds_dst) {
    unsigned keep;
    asm volatile("s_mov_b32 %0, m0\n\ts_mov_b32 m0, %3\n\ts_nop 0\n\tglobal_load_lds_dwordx4 %1, %2\n\ts_mov_b32 m0, %0" : "=&s"(keep) : "v"(voff), "s"(sbase), "s"(lds_dst) : "memory");
}
#define AT_GLDS(sbase, voff, dstoff) at_glds16((voff), (sbase), ldsb_ + (unsigned)(dstoff))

__device__ __forceinline__ int swap23(int k) { return (k & ~0xC) | ((k & 4) << 1) | ((k & 8) >> 1); }

#if !NAIVE_ATTN
template <int VAR>
__device__ __forceinline__ void ph_attn(const Frame& F) {
    const char* Qg = (const char*)(F.ws + WS_Q); const char* KNg = (const char*)(F.ws + WS_KN); const char* KRg = (const char*)(F.ws + WS_KR); const char* VTg = (const char*)(F.ws + WS_VT);
    bf16_t* Og = (bf16_t*)(F.ws + (VAR == 0 ? WS_HC : WS_HB));
    const int lane = F.lane, w = F.wave, r32 = lane & 31, hi = lane >> 5;
    const unsigned ldsb_ = (unsigned)(size_t)F.lds;
    unsigned offK[3], offVt[2];
#pragma unroll
    for (int i = 0; i < 3; ++i) { const int g = (i * 8 + w) * 64 + lane, d0 = g >> 7, rho = (g & 127) >> 1, hh = (g & 1) ^ ((rho >> 3) & 1), key = swap23(rho);
        offK[i] = d0 < 8 ? (unsigned)key * 2048u + (unsigned)(d0 * 32 + hh * 16) : (unsigned)key * 128u + (unsigned)((d0 - 8) * 32 + hh * 16); }
#pragma unroll
    for (int i = 0; i < 2; ++i) { const int g = (i * 8 + w) * 64 + lane, ks = g >> 8, d = (g & 255) >> 1, hh = (g & 1) ^ ((d >> 3) & 1);
        offVt[i] = (unsigned)d * (unsigned)(NTOK * 2) + (unsigned)(ks * 32 + hh * 16); }
    const int rdoff = r32 * 32 + ((hi ^ ((r32 >> 3) & 1)) << 4);
    for (int item = F.blk; item < 512; item += F.G) {
        const int xcd = item & 7, kk = item >> 3, bh = xcd * 4 + (kk >> 4), x = kk & 15, b = bh >> 3, h = bh & 7;
#pragma unroll 1
        for (int pass = 0; pass < 2; ++pass) {
            const int j = pass ? 31 - x : x, NT = 4 * j + 4, cw = 4 * j + (w >> 1);
            const size_t tokb = (size_t)b * SEQ;
            const char* knb = KNg + tokb * 2048 + h * 256; const char* krb = KRg + tokb * 128; const char* vtb = VTg + ((size_t)h * 128 * NTOK + tokb) * 2;
            bf16x8 qr[12];
            { const GAS char* qp = AT_UPTR(Qg + (tokb + (size_t)j * 256 + w * 32) * (NH * DQK * 2) + h * (DQK * 2)) + (unsigned)(r32 * (NH * DQK * 2) + hi * 16);
#pragma unroll
              for (int d0 = 0; d0 < 12; ++d0) qr[d0] = *(const bf16x8*)(qp + d0 * 32);
              const float* csr = (const float*)(AT_UPTR((const float*)(F.ws + WS_CS) + (tokb + (size_t)j * 256 + w * 32) * 64) + (unsigned)(r32 * 256));
#pragma unroll
              for (int dd = 0; dd < 4; ++dd) { const int k4 = (dd * 2 + hi) * 4; const f32x4 t0 = *(const f32x4*)(csr + 2 * k4), t1 = *(const f32x4*)(csr + 2 * k4 + 4);
                  const u32x4 wq = *(const u32x4*)&qr[8 + dd];
                  const float x1[4] = {bflo(wq.x), bfhi(wq.x), bflo(wq.y), bfhi(wq.y)}, x2[4] = {bflo(wq.z), bfhi(wq.z), bflo(wq.w), bfhi(wq.w)};
                  const float co[4] = {t0[0], t0[2], t1[0], t1[2]}, si[4] = {t0[1], t0[3], t1[1], t1[3]}; float r1[4], r2[4];
#pragma unroll
                  for (int jj = 0; jj < 4; ++jj) { r1[jj] = x1[jj] * co[jj] - x2[jj] * si[jj]; r2[jj] = x2[jj] * co[jj] + x1[jj] * si[jj]; }
                  u32x4 wo = {cvt_pk_bf16(r1[0], r1[1]), cvt_pk_bf16(r1[2], r1[3]), cvt_pk_bf16(r2[0], r2[1]), cvt_pk_bf16(r2[2], r2[3])}; qr[8 + dd] = *(bf16x8*)&wo; } }
            f32x16 o[4];
#pragma unroll
            for (int d0 = 0; d0 < 4; ++d0)
#pragma unroll
                for (int r = 0; r < 16; ++r) o[d0][r] = 0.f;
            float m_run = -1e30f, l_run = 0.f;
#define AT_ISSUE_K(t, st) do { const int t_ = (t); \
                const GAS char* kp_ = AT_UPTR(knb + (size_t)t_ * (64 * 2048)); const GAS char* rp_ = AT_UPTR(krb + (size_t)t_ * (64 * 128)); \
                AT_GLDS(kp_, offK[0], (st) + w * 1024); AT_GLDS(kp_, offK[1], (st) + (8 + w) * 1024); \
                AT_GLDS(rp_, offK[2], (st) + (16 + w) * 1024); } while (0)
#define AT_ISSUE_V(t, st) do { const int t_ = (t); \
                const GAS char* vp_ = AT_UPTR(vtb + (size_t)t_ * 128); \
                AT_GLDS(vp_, offVt[0], AT_VB0 + (st) + w * 1024); AT_GLDS(vp_, offVt[1], AT_VB0 + (st) + (8 + w) * 1024); } while (0)
#define AT_DSRD(dst, ad, off) asm volatile("ds_read_b128 %0, %1 offset:%2" : "=v"(dst) : "v"(ad), "i"(off))
#define AT_LGKM(n) asm volatile("s_waitcnt lgkmcnt(%0)" :: "i"(n))
#define AT_SB0() __builtin_amdgcn_sched_barrier(0)
#define AT_KR(d_, x0, x1) do { AT_DSRD(x0, kad_, (d_) * 2048); AT_DSRD(x1, kad_, (d_) * 2048 + 1024); } while (0)
#define AT_MM(x0, x1, q_, PN0, PN1) do { AT_SB0(); __builtin_amdgcn_s_setprio(1); PN0 = __builtin_amdgcn_mfma_f32_32x32x16_bf16(x0, q_, PN0, 0, 0, 0); PN1 = __builtin_amdgcn_mfma_f32_32x32x16_bf16(x1, q_, PN1, 0, 0, 0); __builtin_amdgcn_s_setprio(0); AT_SB0(); } while (0)
#define AT_E1(PC0, PC1, e_) do { if ((e_) < 16) { PC0[(e_) & 15] = __builtin_amdgcn_exp2f(PC0[(e_) & 15] - m_run); ps_ += PC0[(e_) & 15]; } else if ((e_) < 32) { PC1[(e_) & 15] = __builtin_amdgcn_exp2f(PC1[(e_) & 15] - m_run); ps_ += PC1[(e_) & 15]; } } while (0)
#define AT_EX(PC0, PC1, i_) do { if (SM) { AT_E1(PC0, PC1, 3 * (i_)); AT_E1(PC0, PC1, 3 * (i_) + 1); AT_E1(PC0, PC1, 3 * (i_) + 2); } } while (0)
#define AT_QKX(st, P0, P1) do { \
                const unsigned kad_ = (unsigned)(size_t)((const LAS char*)F.lds + (st) + rdoff); \
                bf16x8 ka0, ka1, kb0, kb1, kc0, kc1; \
                AT_KR(0, ka0, ka1); AT_KR(1, kb0, kb1); \
                _Pragma("unroll") for (int r = 0; r < 16; ++r) { P0[r] = 0.f; P1[r] = 0.f; } \
                AT_KR(2, kc0, kc1); AT_LGKM(4); AT_MM(ka0, ka1, qr[0], P0, P1); \
                AT_KR(3, ka0, ka1); AT_LGKM(4); AT_MM(kb0, kb1, qr[1], P0, P1); \
                AT_KR(4, kb0, kb1); AT_LGKM(4); AT_MM(kc0, kc1, qr[2], P0, P1); \
                AT_KR(5, kc0, kc1); AT_LGKM(4); AT_MM(ka0, ka1, qr[3], P0, P1); \
                AT_KR(6, ka0, ka1); AT_LGKM(4); AT_MM(kb0, kb1, qr[4], P0, P1); \
                AT_KR(7, kb0, kb1); AT_LGKM(4); AT_MM(kc0, kc1, qr[5], P0, P1); \
                AT_KR(8, kc0, kc1); AT_LGKM(4); AT_MM(ka0, ka1, qr[6], P0, P1); \
                AT_KR(9, ka0, ka1); AT_LGKM(4); AT_MM(kb0, kb1, qr[7], P0, P1); \
                AT_KR(10, kb0, kb1); AT_LGKM(4); AT_MM(kc0, kc1, qr[8], P0, P1); \
                AT_KR(11, kc0, kc1); AT_LGKM(4); AT_MM(ka0, ka1, qr[9], P0, P1); \
                AT_LGKM(2); AT_MM(kb0, kb1, qr[10], P0, P1); \
                AT_LGKM(0); AT_MM(kc0, kc1, qr[11], P0, P1); } while (0)
#define AT_VR(ks_, v0, v1, v2, v3) do { AT_DSRD(v0, vad_, (ks_) * 4096); AT_DSRD(v1, vad_, (ks_) * 4096 + 1024); AT_DSRD(v2, vad_, (ks_) * 4096 + 2048); AT_DSRD(v3, vad_, (ks_) * 4096 + 3072); } while (0)
#define AT_PF(PX, b8) ({ u32x4 tp_ = {cvt_pk_bf16(PX[b8], PX[b8 + 1]), cvt_pk_bf16(PX[b8 + 2], PX[b8 + 3]), cvt_pk_bf16(PX[b8 + 4], PX[b8 + 5]), cvt_pk_bf16(PX[b8 + 6], PX[b8 + 7])}; *(bf16x8*)&tp_; })
#define AT_M4(pf_, v0, v1, v2, v3) do { AT_SB0(); __builtin_amdgcn_s_setprio(1); o[0] = __builtin_amdgcn_mfma_f32_32x32x16_bf16(v0, pf_, o[0], 0, 0, 0); o[1] = __builtin_amdgcn_mfma_f32_32x32x16_bf16(v1, pf_, o[1], 0, 0, 0); \
                o[2] = __builtin_amdgcn_mfma_f32_32x32x16_bf16(v2, pf_, o[2], 0, 0, 0); o[3] = __builtin_amdgcn_mfma_f32_32x32x16_bf16(v3, pf_, o[3], 0, 0, 0); __builtin_amdgcn_s_setprio(0); AT_SB0(); } while (0)
#define AT_MX8(PX, b8) do { _Pragma("unroll") for (int r = 0; r < 8; ++r) mxn_ = fmaxf(mxn_, PX[(b8) + r]); } while (0)
#define AT_PVX(st, PC0, PC1) do { const unsigned vad_ = (unsigned)(size_t)((const LAS char*)F.lds + AT_VB0 + (st) + rdoff); \
                bf16x8 va0, va1, va2, va3, vb0, vb1, vb2, vb3, pf_; \
                AT_VR(0, va0, va1, va2, va3); AT_VR(1, vb0, vb1, vb2, vb3); pf_ = AT_PF(PC0, 0); AT_LGKM(4); AT_M4(pf_, va0, va1, va2, va3); \
                AT_VR(2, va0, va1, va2, va3); pf_ = AT_PF(PC0, 8); AT_LGKM(4); AT_M4(pf_, vb0, vb1, vb2, vb3); \
                AT_VR(3, vb0, vb1, vb2, vb3); pf_ = AT_PF(PC1, 0); AT_LGKM(4); AT_M4(pf_, va0, va1, va2, va3); \
                pf_ = AT_PF(PC1, 8); AT_LGKM(0); AT_M4(pf_, vb0, vb1, vb2, vb3); } while (0)
#define AT_SMAX(P0, P1) do { \
                float mx = P0[0]; _Pragma("unroll") for (int r = 1; r < 16; ++r) mx = fmaxf(mx, P0[r]); _Pragma("unroll") for (int r = 0; r < 16; ++r) mx = fmaxf(mx, P1[r]); \
                mx = fmaxf(mx, __shfl_xor(mx, 32)); \
                if (!__all(mx - m_run <= 11.0f)) { const float mn = fmaxf(m_run, mx), al = __builtin_amdgcn_exp2f(m_run - mn); m_run = mn; l_run *= al; \
                    _Pragma("unroll") for (int d0 = 0; d0 < 4; ++d0) _Pragma("unroll") for (int r = 0; r < 16; ++r) o[d0][r] *= al; } } while (0)
#define AT_SEXP(P0, P1) do { \
                float ps = 0.f; \
                _Pragma("unroll") for (int r = 0; r < 16; ++r) { P0[r] = __builtin_amdgcn_exp2f(P0[r] - m_run); P1[r] = __builtin_amdgcn_exp2f(P1[r] - m_run); ps += P0[r] + P1[r]; } \
                l_run += ps; } while (0)
#define AT_STEP(t, st) do { \
                if (VAR != 1 && VAR != 6 && VAR != 7 && (t) + 1 < NT) { AT_ISSUE_K((t) + 1, (1 - (st)) * AT_KB); AT_ISSUE_V((t) + 1, (1 - (st)) * AT_VB); } \
                if (VAR != 2 && (t) <= cw) { f32x16 p0, p1; if (VAR != 5 && VAR != 7) AT_QKX((st) * AT_KB, p0, p1); else { _Pragma("unroll") for (int r = 0; r < 16; ++r) { p0[r] = m_run; p1[r] = l_run; } } \
                    if (VAR == 0 || VAR == 1) { AT_SMAX(p0, p1); AT_SEXP(p0, p1); } if (VAR != 4 && VAR != 6) AT_PVX((st) * AT_VB, p0, p1); else { m_run += p0[3] + p1[5]; } } \
                asm volatile("s_waitcnt vmcnt(0)" ::: "memory"); AT_BAR(); } while (0)
            AT_ISSUE_K(0, 0); AT_ISSUE_V(0, 0);
            asm volatile("s_waitcnt vmcnt(0)" ::: "memory"); AT_BAR();
#pragma unroll 1
            for (int t = 0; t < NT; t += 2) {
                AT_STEP(t, 0);
                AT_STEP(t + 1, 1);
            }
#undef AT_ISSUE_K
#undef AT_ISSUE_V
#undef AT_STEP
            const float lt = l_run + __shfl_xor(l_run, 32), inv = 1.0f / lt;
            bf16_t* op = (bf16_t*)(AT_UPTR(Og + (tokb + (size_t)j * 256 + w * 32) * D + h * DV) + (unsigned)(r32 * (D * 2) + 8 * hi));
#pragma unroll
            for (int d0 = 0; d0 < 4; ++d0)
#pragma unroll
                for (int g4 = 0; g4 < 4; ++g4) { u32x2 wv; wv.x = cvt_pk_bf16(o[d0][4 * g4] * inv, o[d0][4 * g4 + 1] * inv); wv.y = cvt_pk_bf16(o[d0][4 * g4 + 2] * inv, o[d0][4 * g4 + 3] * inv);
                    *(u32x2*)(op + d0 * 32 + 8 * g4) = wv; }
        }
    }
}
#else
template <int VAR>
__device__ __forceinline__ void ph_attn(const Frame& F) {
    const bf16_t* Qg = (const bf16_t*)(F.ws + WS_Q); const bf16_t* KNg = (const bf16_t*)(F.ws + WS_KN); const bf16_t* KRg = (const bf16_t*)(F.ws + WS_KR); const bf16_t* VTg = (const bf16_t*)(F.ws + WS_VT);
    bf16_t* Og = (bf16_t*)(F.ws + WS_HC);
    for (int it = F.blk * NWAVE + F.wave; it < NTOK * NH; it += F.G * NWAVE) {
        const int n = it >> 3, h = it & 7, b = n / SEQ, s = n - b * SEQ, nkb = s / 64 + 1; const size_t tokb = (size_t)b * SEQ;
        const bf16_t* q = Qg + (size_t)n * (NH * DQK) + h * DQK;
        float m = -1e30f, l = 0.f, o0 = 0.f, o1 = 0.f;
        for (int kb = 0; kb < nkb; ++kb) {
            const size_t key = tokb + kb * 64 + F.lane; float sc = 0.f;
            for (int d = 0; d < DNOPE; d += 8) { const u32x4 kv = *(const u32x4*)(KNg + key * D + h * DNOPE + d), qv = *(const u32x4*)(q + d);
                sc += bflo(kv.x) * bflo(qv.x) + bfhi(kv.x) * bfhi(qv.x) + bflo(kv.y) * bflo(qv.y) + bfhi(kv.y) * bfhi(qv.y) + bflo(kv.z) * bflo(qv.z) + bfhi(kv.z) * bfhi(qv.z) + bflo(kv.w) * bflo(qv.w) + bfhi(kv.w) * bfhi(qv.w); }
            for (int d = 0; d < DROPE; d += 8) { const u32x4 kv = *(const u32x4*)(KRg + key * DROPE + d), qv = *(const u32x4*)(q + DNOPE + d);
                sc += bflo(kv.x) * bflo(qv.x) + bfhi(kv.x) * bfhi(qv.x) + bflo(kv.y) * bflo(qv.y) + bfhi(kv.y) * bfhi(qv.y) + bflo(kv.z) * bflo(qv.z) + bfhi(kv.z) * bfhi(qv.z) + bflo(kv.w) * bflo(qv.w) + bfhi(kv.w) * bfhi(qv.w); }
            float mx = sc;
#pragma unroll
            for (int of = 32; of >= 1; of >>= 1) mx = fmaxf(mx, __shfl_xor(mx, of));
            const float mn = fmaxf(m, mx), al = exp2f(m - mn), p = exp2f(sc - mn); m = mn;
            l = l * al + wave_sum(p); o0 *= al; o1 *= al;
            for (int d = 0; d < DV; ++d) { const float v = bf2f(VTg[(size_t)(h * DV + d) * NTOK + key]); const float tot = wave_sum(p * v);
                if (F.lane == (d & 63)) { if (d < 64) o0 += tot; else o1 += tot; } }
        }
        const float inv = 1.0f / l;
        Og[(size_t)n * D + h * DV + F.lane] = (bf16_t)(cvt_pk_bf16(o0 * inv, 0.f) & 0xffffu);
        Og[(size_t)n * D + h * DV + 64 + F.lane] = (bf16_t)(cvt_pk_bf16(o1 * inv, 0.f) & 0xffffu);
    }
}
#endif
constexpr int NPH = 20;
__global__ void __launch_bounds__(NTHR, 2) yoco_fwd(Args args) {
    extern __shared__ __attribute__((aligned(16))) unsigned char lds_raw[];
    Frame F; F.lds = (LAS unsigned char*)lds_raw; F.ws = (GAS unsigned char*)args.ws; F.a = &args;
    F.tid = threadIdx.x; F.lane = F.tid & 63; F.wave = __builtin_amdgcn_readfirstlane(F.tid >> 6); F.G = gridDim.x; F.blk = blockIdx.x;
    volatile LAS unsigned* misc = (volatile LAS unsigned*)(F.lds + LDS_MISC);
    if (F.tid < 16) misc[F.tid] = 0u;
    __syncthreads();
    const int lo = args.ph_lo, hi = args.ph_hi;
    XcdBarrier bar; bar.bar = (unsigned*)(F.ws + WS_CTL); bar.x = 0; bar.st = misc;
    if (hi - lo > 1) bar = xcd_barrier_post((unsigned*)(F.ws + WS_CTL), misc);
#ifndef PH_MASK
#define PH_MASK 0xFFFFFu
#endif
#define IN(k) (((PH_MASK >> ((k) % 20 >= 15 ? (k) - 10 : (k))) & 1u) && lo <= (k) && (k) < hi)
#define FRESH() do { F.tid = threadIdx.x; asm volatile("" : "+v"(F.tid)); F.lane = F.tid & 63; F.wave = __builtin_amdgcn_readfirstlane(F.tid >> 6); F.ws = (GAS unsigned char*)args.ws; asm volatile("" : "+s"(F.ws)); } while (0)
#ifndef REPEAT_MASK
#define REPEAT_MASK 0u
#endif
#define PHBIT(k) ((k) >= 15 ? (k) - 10 : (k))
#define REPEAT(k) _Pragma("unroll 1") for (int rep_ = 0, nrep_ = ((REPEAT_MASK >> PHBIT(k)) & 1u) ? 2 : 1; rep_ < nrep_; ++rep_, (void)((rep_ < nrep_) ? (xcd_barrier(bar), 0) : 0))
#define SEAM(k) do { if (IN(k) && IN((k) + 1)) xcd_barrier(bar); } while (0)
    LAS unsigned char* stage = F.lds;
#define MOD ((const float*)(F.ws + WS_MOD))

    if (IN(0)) REPEAT(0) { FRESH(); ph_prologue(F); } SEAM(0);
    if (IN(1)) REPEAT(1) { FRESH(); ph_norm1(F); ph_router_prep(F); } SEAM(1);
    if (IN(2)) REPEAT(2) { FRESH();
        pg8::Gemm g{(const bf16_t*)(F.ws + WS_HA), (const bf16_t*)(F.ws + WS_WPW1), NTOK, 2 * D, D}; pg8::StaticOrder S; S.init(NTOK, 2 * D, F.G, F.blk);
        pg8::EpiGated<0> E{(bf16_t*)(F.ws + WS_HB), D, GPTR(const float, args.in[I_PW1B]), D, nullptr};
        GEMM_PHASE<pg8::EpiGated<0>, pg8::StaticOrder>(stage, g, S, E);
    } SEAM(2);
    if (IN(3)) REPEAT(3) { FRESH(); ph_conv(F); } SEAM(3);
    if (IN(4)) REPEAT(4) { FRESH();
        pg8::Gemm g{(const bf16_t*)(F.ws + WS_HC), (const bf16_t*)(F.ws + WS_WPW2), NTOK, D, D}; pg8::StaticOrder S; S.init(NTOK, D, F.G, F.blk);
        pg8::EpiResidB<false> E{GPTR(const float, args.in[I_X]), (bf16_t*)(F.ws + WS_X), GPTR(const float, args.in[I_PW2B]), MOD + 2 * D};
        GEMM_PHASE<pg8::EpiResidB<false>, pg8::StaticOrder>(stage, g, S, E);
    } SEAM(4);
#pragma unroll 1
    for (int l = 0; l < 2; ++l) {
        const int pb = 5 + 10 * l;
        if (IN(pb)) REPEAT(pb) { FRESH(); ph_router(F, l); } do { if (IN(pb) && IN(pb + 2)) xcd_barrier(bar); } while (0);
        LAS int* lbexp = (LAS int*)(F.lds + 131072);
        LAS int* lfb = (LAS int*)(F.lds + 131072 + 2304);
        if (IN(pb + 2)) REPEAT(pb + 2) { FRESH();
            moe_layout(F, l, lbexp, lfb); const int nblk = __builtin_amdgcn_readfirstlane(lbexp[0]);
            pg8::Gemm g{(const bf16_t*)(F.ws + WS_HA), (const bf16_t*)(F.ws + WS_WGU) + (size_t)l * NE * 2 * DE * D, nblk * 256, 2 * DE, D};
            pg8::MoeGatherOrder S; S.init(nblk * 256, 2 * DE, F.G, F.blk); S.bexp = lbexp; S.estride = (size_t)2 * DE * D * 2; S.rowtab = (const unsigned*)(F.ws + WS_ROWTAB2); S.nrows_src = NTOK; S.fblk = lfb;
            pg8::EpiGated<1> E{(bf16_t*)(F.ws + WS_ACT), DE, GPTR(const float, args.in[I_BGU]) + (size_t)l * NE * 2 * DE, DE, lbexp};
            GEMM_PHASE<pg8::EpiGated<1>, pg8::MoeGatherOrder>(stage, g, S, E);
        } SEAM(pb + 2);
        if (IN(pb + 3)) REPEAT(pb + 3) { FRESH();
            moe_layout(F, l, lbexp, lfb); const int nblk = __builtin_amdgcn_readfirstlane(lbexp[0]);
            pg8::Gemm g{(const bf16_t*)(F.ws + WS_ACT), (const bf16_t*)(F.ws + WS_WDN) + (size_t)l * NE * DE * D, nblk * 256, D, DE};
            pg8::MoeOrder S; S.init(nblk * 256, D, F.G, F.blk); S.bexp = lbexp; S.estride = (size_t)DE * D * 2; S.rev = true;
            pg8::EpiBf16P E{(bf16_t*)(F.ws + WS_XG), D, GPTR(const float, args.in[I_BDN]) + (size_t)l * NE * D, D, lbexp};
            GEMM_PHASE<pg8::EpiBf16P, pg8::MoeOrder>(stage, g, S, E);
        } SEAM(pb + 3);
        if (IN(pb + 4)) REPEAT(pb + 4) { FRESH(); ph_combine(F, l); } SEAM(pb + 4);
        if (l == 0) {
            if (IN(10)) REPEAT(10) { FRESH();
#pragma unroll 1
                for (int gi = 0; gi < 2; ++gi) {
                    pg8::Gemm g{(const bf16_t*)(F.ws + (gi ? WS_HA : WS_HB)), (const bf16_t*)(F.ws + (gi ? WS_WDQ : WS_WDKV)), NTOK, 512, D}; pg8::StaticOrder S; S.init(NTOK, 512, F.G, F.blk);
                    pg8::EpiLatQ E{(bf16_t*)(F.ws + (gi ? WS_CQ : WS_CKV)), gi ? QLORA : KVLORA, gi ? QLORA : KVLORA, gi ? (bf16_t*)nullptr : (bf16_t*)(F.ws + WS_KR), (const f32x2*)(F.ws + WS_CS), (float*)(F.ws + (gi ? WS_SSPQ : WS_SSPKV))};
                    GEMM_PHASE<pg8::EpiLatQ, pg8::StaticOrder>(stage, g, S, E);
                    __syncthreads(); }
            } do { if (IN(10) && IN(12)) xcd_barrier(bar); } while (0);
            if (IN(12)) REPEAT(12) { FRESH();
#pragma unroll 1
                for (int gi = 0; gi < 3; ++gi) {
                    pg8::Gemm g{(const bf16_t*)(F.ws + (gi == 0 ? WS_CKV : gi == 1 ? WS_WUV : WS_CQ)), (const bf16_t*)(F.ws + (gi == 0 ? WS_WUK : gi == 1 ? WS_CKV : WS_WUQ)),
                                gi == 1 ? D : NTOK, gi == 0 ? D : gi == 1 ? NTOK : NH * DQK, gi == 2 ? QLORA : KVLORA};
                    pg8::StaticOrder S; S.init(g.M, g.N, F.G, F.blk);
                    pg8::EpiScaled E{(bf16_t*)(F.ws + (gi == 0 ? WS_KN : gi == 1 ? WS_VT : WS_Q)), g.N, (const float*)(F.ws + (gi == 2 ? WS_SSPQ : WS_SSPKV)), gi == 1 ? 1 : 0, gi == 2 ? 8 : 4, gi == 2 ? 1.0f / QLORA : 1.0f / KVLORA};
                    GEMM_PHASE<pg8::EpiScaled, pg8::StaticOrder>(stage, g, S, E);
                    __syncthreads(); }
            } SEAM(12);
            if (IN(13)) REPEAT(13) { FRESH(); ph_attn<0>(F);
#ifdef ATTN_PROBE
                xcd_barrier(bar); FRESH(); ph_attn<ATTN_PROBE>(F);
#endif
            } SEAM(13);
            if (IN(14)) REPEAT(14) { FRESH();
                pg8::Gemm g{(const bf16_t*)(F.ws + WS_HC), (const bf16_t*)(F.ws + WS_WO), NTOK, D, D}; pg8::StaticOrder S; S.init(NTOK, D, F.G, F.blk);
                pg8::EpiResidB<true> E{(const bf16_t*)(F.ws + WS_X2), (bf16_t*)(F.ws + WS_X), nullptr, MOD + (size_t)NB * 6 * D + 2 * D};
                GEMM_PHASE<pg8::EpiResidB<true>, pg8::StaticOrder>(stage, g, S, E);
            } SEAM(14);
        }
    }
#undef IN
#undef SEAM
#undef MOD
#undef FRESH
}

extern "C" void kernel_launch(void* const* d_in, const int* in_sizes, int n_in, void* d_out, int out_size, void* d_ws, size_t ws_size, hipStream_t stream) {
    static int grid = 0;
    if (grid == 0) {
        if (n_in != 31 || out_size != NTOK * D || ws_size < WS_END) { fprintf(stderr, "kernel_launch: unexpected shapes (n_in %d, out %d, ws %zu < %zu)\n", n_in, out_size, ws_size, (size_t)WS_END); grid = -1; return; }
        int dev = 0, cus = 0, per_cu = 0;
        if (hipGetDevice(&dev) != hipSuccess || hipDeviceGetAttribute(&cus, hipDeviceAttributeMultiprocessorCount, dev) != hipSuccess) { grid = -1; return; }
        if (hipFuncSetAttribute((const void*)yoco_fwd, hipFuncAttributeMaxDynamicSharedMemorySize, LDS_BYTES) != hipSuccess) { fprintf(stderr, "kernel_launch: hipFuncSetAttribute failed\n"); grid = -1; return; }
        if (hipOccupancyMaxActiveBlocksPerMultiprocessor(&per_cu, (const void*)yoco_fwd, NTHR, LDS_BYTES) != hipSuccess || per_cu < 1) fprintf(stderr, "kernel_launch: occupancy query says %d\n", per_cu);
        (void)hipGetLastError();
        grid = cus;
        if (grid != 256) fprintf(stderr, "kernel_launch: %d CUs (built for 256)\n", grid);
        if (grid > 256) grid = 256;
    }
    if (grid < 0) return;
    (void)hipMemsetAsync((char*)d_ws + WS_CTL, 0, WS_CTL_BYTES, stream);
    Args a{};
    for (int i = 0; i < 31; ++i) a.in[i] = (const float*)d_in[i];
    a.out = (float*)d_out; a.ws = (unsigned char*)d_ws;
#if N_LAUNCH_MODE == 1
    a.ph_lo = 0; a.ph_hi = NPH;
    hipLaunchKernelGGL(yoco_fwd, dim3(grid), dim3(NTHR), LDS_BYTES, stream, a);
#else
    for (int p = 0; p < NPH; ++p) { a.ph_lo = p; a.ph_hi = p + 1; hipLaunchKernelGGL(yoco_fwd, dim3(grid), dim3(NTHR), LDS_BYTES, stream, a); }
#endif
}
```

```cpp
#include <hip/hip_runtime.h>
#include <cstdio>
#include <cstdint>

#ifndef N_LAUNCH_MODE
#define N_LAUNCH_MODE 1
#endif
#ifndef NAIVE_GEMM
#define NAIVE_GEMM 0
#endif
#ifndef NAIVE_ATTN
#define NAIVE_ATTN 0
#endif

#define LAS __attribute__((address_space(3)))
#define GAS __attribute__((address_space(1)))
__device__ __forceinline__ const void* assume_global_(const void* p) {
#if defined(__HIP_DEVICE_COMPILE__)
    __builtin_assume(!__builtin_amdgcn_is_shared(p) && !__builtin_amdgcn_is_private(p));
#endif
    return p; }
#define GPTR(T, p) ((T*)assume_global_((const void*)(p)))
typedef unsigned short bf16_t;
typedef short bf16x8 __attribute__((ext_vector_type(8)));
typedef float f32x4 __attribute__((ext_vector_type(4)));
typedef float f32x2 __attribute__((ext_vector_type(2)));
typedef float f32x16 __attribute__((ext_vector_type(16)));
typedef unsigned u32x4 __attribute__((ext_vector_type(4)));
typedef unsigned u32x2 __attribute__((ext_vector_type(2)));

constexpr int D = 1024, NB = 4, SEQ = 8192, NTOK = NB * SEQ;
constexpr int CONVW = 31, NH = 8, DNOPE = 128, DROPE = 64, DQK = 192, DV = 128, QLORA = 384, KVLORA = 256;
constexpr int NE = 32, TOPK = 4, DE = 1024, EBLK = 256;
constexpr int NASSIGN = NTOK * TOPK;
constexpr int NROWS = ((NASSIGN + NE * (EBLK - 1) + EBLK - 1) / EBLK) * EBLK;
constexpr int MAXBLK = NROWS / EBLK;
constexpr float EPS = 1e-6f;
constexpr int NTHR = 512, NWAVE = 8;
constexpr int LDS_BYTES = 163840;
constexpr int LDS_MISC = 163328;

constexpr size_t MiB = (size_t)1 << 20;
constexpr size_t WS_CTL = 0;
constexpr size_t WS_MOETOT = 16 * 1024;
constexpr size_t WS_CTL_BYTES = WS_MOETOT + 256;
constexpr size_t WS_BLKCNT = 64 * 1024;
constexpr size_t WS_BEXP = 192 * 1024;
constexpr size_t WS_MOD = 1 * MiB;
constexpr size_t WS_TOPI = 2 * MiB;
constexpr size_t WS_GATE = WS_TOPI + 512 * 1024;
constexpr size_t WS_RANK = WS_GATE + 512 * 1024;
constexpr size_t WS_SLOT = WS_RANK + 512 * 1024;
constexpr size_t WS_CS = 4 * MiB;
constexpr size_t WS_RWF = 12 * MiB;
constexpr size_t WS_RBIAS = 13 * MiB;
constexpr size_t WS_WPW1 = 16 * MiB;
constexpr size_t WS_WPW2 = WS_WPW1 + 4 * MiB;
constexpr size_t WS_WDKV = WS_WPW2 + 2 * MiB;
constexpr size_t WS_WDQ = WS_WDKV + 1 * MiB;
constexpr size_t WS_WUK = WS_WDQ + 1 * MiB;
constexpr size_t WS_WUV = WS_WUK + MiB / 2;
constexpr size_t WS_WUQ = WS_WUV + MiB / 2;
constexpr size_t WS_WO = WS_WUQ + 2 * MiB;
constexpr size_t WS_WGU = 32 * MiB;
constexpr size_t WS_WDN = WS_WGU + 256 * MiB;
constexpr size_t WS_X = WS_WDN + 128 * MiB;
constexpr size_t WS_HA = WS_X + 128 * MiB;
constexpr size_t WS_HB = WS_HA + 64 * MiB;
constexpr size_t WS_HC = WS_HB + 64 * MiB;
constexpr size_t WS_XG = WS_HC + 64 * MiB;
constexpr size_t WS_ACT = WS_XG + 272 * MiB;
constexpr size_t WS_ROWTAB = WS_ACT + 272 * MiB;
constexpr size_t WS_X2 = WS_ROWTAB + 8 * MiB;
constexpr size_t WS_ROWTAB2 = WS_X2 + 64 * MiB;
constexpr size_t WS_END = WS_X2 + 128 * MiB;
constexpr size_t WS_LAT = WS_XG;
constexpr size_t WS_SSPKV = WS_XG;
constexpr size_t WS_SSPQ = WS_XG + 2 * MiB;
constexpr size_t WS_CQP = WS_LAT + 64 * MiB;
constexpr size_t WS_CKV = WS_CQP + 64 * MiB;
constexpr size_t WS_KR = WS_CKV + 16 * MiB;
constexpr size_t WS_CQ = WS_KR + 4 * MiB;
constexpr size_t WS_KN = WS_CQ + 28 * MiB;
constexpr size_t WS_VT = WS_KN + 64 * MiB;
constexpr size_t WS_Q = WS_VT + 64 * MiB;
static_assert(WS_Q + 96 * MiB <= WS_END, "ws map");

struct Args {
    const float* in[31]; float* out; unsigned char* ws; int ph_lo, ph_hi;
};
enum { I_X = 0, I_C, I_POS, I_MODW, I_MODB, I_N1G, I_N2G, I_PW1W, I_PW1B, I_DWW, I_DWB, I_LNG, I_LNB, I_PW2W, I_PW2B, I_KVG, I_WDKV, I_CKVG, I_WUK, I_WUV,
       I_WDQ, I_CQG, I_WUQ, I_WO, I_RW, I_RB, I_WGU, I_BGU, I_WDN, I_BDN, I_FG };

__device__ __forceinline__ unsigned cvt_pk_bf16(float lo, float hi) { unsigned r; asm volatile("v_cvt_pk_bf16_f32 %0, %1, %2" : "=v"(r) : "v"(lo), "v"(hi)); return r; }
__device__ __forceinline__ float bf2f(unsigned short b) { return __uint_as_float(((unsigned)b) << 16); }
__device__ __forceinline__ float bflo(unsigned w) { return __uint_as_float(w << 16); }
__device__ __forceinline__ float bfhi(unsigned w) { return __uint_as_float(w & 0xffff0000u); }
__device__ __forceinline__ float wave_sum(float v) {
#pragma unroll
    for (int o = 32; o >= 1; o >>= 1) v += __shfl_xor(v, o);
    return v;
}
__device__ __forceinline__ float sigmoidf_(float x) { return __builtin_amdgcn_rcpf(1.0f + __builtin_amdgcn_exp2f(-1.4426950408889634f * x)); }
#define XB_TMO      128
#define XB_XCNT(j)  (256  + 64 * (j))
#define XB_XSUB(j)  (1280 + 64 * (j))
#define XB_XGEN(j)  (2304 + 64 * (j))
#define XB_TOP      3328
#define XB_TOPGEN   3392
#define XCD_BAR_WORDS 3456
#define XB_SPIN_CAP (1u << 18)

__device__ __forceinline__ unsigned xb_ld(unsigned* p)              { return __hip_atomic_load(p, __ATOMIC_RELAXED, __HIP_MEMORY_SCOPE_AGENT); }
__device__ __forceinline__ unsigned xb_add(unsigned* p, unsigned v) { return __hip_atomic_fetch_add(p, v, __ATOMIC_RELAXED, __HIP_MEMORY_SCOPE_AGENT); }
__device__ __forceinline__ unsigned xb_xcc_id() { return (unsigned)__builtin_amdgcn_s_getreg((3 << 11) | 20) & 0xFu; }
#define XB_SPIN(cond, bar) do { unsigned _sp = 0; while (cond) { __builtin_amdgcn_s_sleep(1); \
    if ((++_sp & 255u) == 0u) { if (xb_ld(&(bar)[XB_TMO])) break; if (_sp > XB_SPIN_CAP) { atomicAdd(&(bar)[XB_TMO], 1u); break; } } } } while (0)

struct XcdBarrier {
    unsigned* bar; unsigned x;
    volatile LAS unsigned* st;
};

__device__ __forceinline__ XcdBarrier xcd_barrier_post(unsigned* bar, volatile LAS unsigned* st) {
    XcdBarrier b; b.bar = bar; b.x = xb_xcc_id(); b.st = st;
    if (threadIdx.x == 0) (void)xb_add(&bar[XB_XCNT(b.x)], 1u);
    return b;
}
__device__ __forceinline__ void xcd_barrier_complete(unsigned* bar, unsigned x, unsigned& nloc, unsigned& nx) {
    const unsigned G = gridDim.x * gridDim.y * gridDim.z;
    unsigned sum, cnt, mine, sp = 0u;
    for (;;) {
        sum = 0u; cnt = 0u; mine = 0u;
#pragma unroll
        for (unsigned j = 0; j < 16; ++j) { const unsigned c = xb_ld(&bar[XB_XCNT(j)]); sum += c; cnt += (c > 0u) ? 1u : 0u; mine = (j == x) ? c : mine; }
        if (sum == G) break;
        __builtin_amdgcn_s_sleep(1);
        if ((++sp & 255u) == 0u) { if (xb_ld(&bar[XB_TMO])) break; if (sp > XB_SPIN_CAP) { atomicAdd(&bar[XB_TMO], 1u); break; } }
    }
    nloc = mine > 0u ? mine : 1u; nx = cnt > 0u ? cnt : 1u;
}

__device__ __forceinline__ void xcd_barrier(const XcdBarrier& b) {
    asm volatile("s_waitcnt vmcnt(0)" ::: "memory");
    __syncthreads();
    if (threadIdx.x == 0) {
        unsigned* bar = b.bar;
        __builtin_amdgcn_s_waitcnt(0);
        unsigned nloc = b.st[0], nx = b.st[1];
        if (nloc == 0u) { xcd_barrier_complete(bar, b.x, nloc, nx); b.st[0] = nloc; b.st[1] = nx; }
        const unsigned old = xb_add(&bar[XB_XSUB(b.x)], 1u);
        const unsigned gen = old / nloc;
        if (old + 1u == (gen + 1u) * nloc) {
            __builtin_amdgcn_fence(__ATOMIC_RELEASE, "agent");
            asm volatile("s_waitcnt vmcnt(0)" ::: "memory");
            const unsigned og = xb_add(&bar[XB_TOP], 1u);
            const unsigned tg = og / nx;
            if (og + 1u == (tg + 1u) * nx) xb_add(&bar[XB_TOPGEN], 1u);
            else XB_SPIN(xb_ld(&bar[XB_TOPGEN]) == tg, bar);
            __builtin_amdgcn_fence(__ATOMIC_ACQUIRE, "agent");
            xb_add(&bar[XB_XGEN(b.x)], 1u);
            asm volatile("s_waitcnt vmcnt(0)" ::: "memory");
        } else {
            XB_SPIN(xb_ld(&bar[XB_XGEN(b.x)]) == gen, bar);
            __builtin_amdgcn_fence(__ATOMIC_ACQUIRE, "agent");
            asm volatile("s_waitcnt vmcnt(0)" ::: "memory");
        }
    }
    __syncthreads();
}
namespace pg8 {
#define PG8_LAS __attribute__((address_space(3)))
constexpr int BM = 256, BK = 64, HALF = 128, HTB = HALF * BK * 2  , STAGE_BYTES = 8 * HTB, NXCD = 8, WGM = 8;

__host__ __device__ __forceinline__ int lds_byte(int r, int c) { const int st = (r >> 4) * 2 + (c >> 5), rr = r & 15, cc = c & 31, ob = rr * 64 + cc * 2; return st * 1024 + (ob ^ (((ob >> 9) & 1) << 5)); }
__host__ __device__ __forceinline__ void stage_rc(int b, int& R, int& C) { const int st = b / 1024, sb = b % 1024, swz = sb ^ (((sb >> 9) & 1) << 5); R = (st >> 1) * 16 + swz / 64; C = (st & 1) * 32 + (swz % 64) / 2; }
__host__ __device__ __forceinline__ int perm32(int rho) { const int n = rho >> 4, i = rho & 15; return 8 * (i >> 2) + 4 * n + (i & 3); }

struct Unit { int pm, pn; };
struct Gemm { const bf16_t* A; const bf16_t* Bt; int M, N, K; };

struct StaticOrder {
    static constexpr bool GATHER = false;
    int nM, nN, nwg, G, c;
    __host__ __device__ void init(int M, int N, int G_, int c_) { nM = M / BM; nN = N / BM; nwg = nM * nN; G = G_; c = c_; }
    __host__ __device__ bool next(int i, Unit& u) const {
        const long L = (long)i * G + c; if (L >= nwg) return false;
        int wgid = (int)L; { const int q = nwg / NXCD, r = nwg % NXCD, xcd = wgid % NXCD, off = wgid / NXCD; wgid = (xcd < r ? xcd * (q + 1) : r * (q + 1) + (xcd - r) * q) + off; }
        const int nig = WGM * nN, gid = wgid / nig, fm = gid * WGM, gsz = (nM - fm) < WGM ? (nM - fm) : WGM;
        u.pm = fm + ((wgid % nig) % gsz); u.pn = (wgid % nig) / gsz; return true;
    }
    __device__ __forceinline__ void a_ready(const Unit&) const {}
    __device__ __forceinline__ size_t boff(const Unit& u, size_t tstep) const { return (size_t)u.pn * tstep; }
    __device__ __forceinline__ void done(const Unit&) const {}
};
template <class Epi, class Sched>
__device__ __forceinline__ void gemm_phase(PG8_LAS unsigned char* lds, const Gemm g, const Sched& S, const Epi& E) {
    constexpr bool STAMP = false; unsigned long long* stamps = nullptr;
    int tid_ = threadIdx.x; asm volatile("" : "+v"(tid_));
    const int tid = tid_, wid = __builtin_amdgcn_readfirstlane(tid >> 6), lane = tid & 63, wr = wid >> 2, wc = wid & 3, fr = lane & 15, fq = lane >> 4;
    const int K = g.K, nt = K / BK;
    int ts_lo = 0, ts_hi = 0, nts = 0; const unsigned long long rt_entry = STAMP ? (unsigned long long)wall_clock64() : 0ull;
#define PG8_STAMP() do { if (STAMP && wid == 0 && nts < 64) { const unsigned long long _c = (unsigned long long)clock64(); \
        ts_lo = (lane == nts) ? (int)(unsigned)_c : ts_lo; ts_hi = (lane == nts) ? (int)(unsigned)(_c >> 32) : ts_hi; ++nts; } } while (0)
    PG8_STAMP();
    unsigned voffA[2], voffB[2];
#pragma unroll
    for (int i = 0; i < 2; ++i) { int R, C; stage_rc(tid * 16 + i * 8192, R, C); const int Rb = Epi::PERM ? ((R & ~31) + perm32(R & 31)) : R;
        voffA[i] = (unsigned)(R * K + C) * 2u; voffB[i] = (unsigned)(Rb * K + C) * 2u; }
    unsigned gc[2][2], gn[2][2], gnn[2][2];
#define PG8_LOOKUP_LD(t4_, u) t4_ = *(const u32x4*)(S.rowtab + ((size_t)S.rt_blk(u) * 512 + tid) * 4)
#define PG8_LOOKUP_FIN(dst, t4_) do { const unsigned tk_[4] = {t4_.x, t4_.y, t4_.z, t4_.w}; \
        _Pragma("unroll") for (int h_ = 0; h_ < 2; ++h_) _Pragma("unroll") for (int i_ = 0; i_ < 2; ++i_) { int R_, C_; stage_rc(tid * 16 + i_ * 8192, R_, C_); \
        const unsigned tc_ = tk_[h_ * 2 + i_] < S.nrows_src ? tk_[h_ * 2 + i_] : S.nrows_src - 1u; dst[h_][i_] = (tc_ * (unsigned)K + (unsigned)C_) * 2u; } } while (0)
#define PG8_LOOKUP(dst, u) do { u32x4 t4x_; PG8_LOOKUP_LD(t4x_, u); PG8_LOOKUP_FIN(dst, t4x_); } while (0)
#define PG8_STAGE_G(bufoff, kbytes, off2) do { _Pragma("unroll") for (int _i = 0; _i < 2; ++_i) \
        __builtin_amdgcn_global_load_lds((const unsigned*)((const char*)g.A + (kbytes) + (off2)[_i]), (PG8_LAS unsigned*)(lds + (bufoff) + ldsw + _i * 8192), 16, 0, 0); } while (0)
    const size_t kstep = (size_t)(BK * 2);
    const size_t hstep = (size_t)HALF * K * 2;
    const size_t tstep = 2 * hstep;
    const unsigned ldsw = (unsigned)wid * 1024u;
    const int aoff = lds_byte(wr * 64 + fr, fq * 8), boff = lds_byte(wc * 32 + fr, fq * 8);
#define PG8_SA(b, h) (((b) * 2 + (h)) * HTB)
#define PG8_SB(b, h) ((4 + (b) * 2 + (h)) * HTB)
#define PG8_STAGE(bufoff, gbase, voff) do { _Pragma("unroll") for (int _i = 0; _i < 2; ++_i) \
        __builtin_amdgcn_global_load_lds((const unsigned*)((const char*)(gbase) + (voff)[_i]), (PG8_LAS unsigned*)(lds + (bufoff) + ldsw + _i * 8192), 16, 0, 0); } while (0)
#define PG8_LDA(dst, b, h) do { _Pragma("unroll") for (int m = 0; m < 4; ++m) _Pragma("unroll") for (int k = 0; k < 2; ++k) dst[m][k] = *(const PG8_LAS bf16x8*)(lds + PG8_SA(b, h) + aoff + m * 2048 + k * 1024); } while (0)
#define PG8_LDB(dst, b, h) do { _Pragma("unroll") for (int n = 0; n < 2; ++n) _Pragma("unroll") for (int k = 0; k < 2; ++k) dst[n][k] = *(const PG8_LAS bf16x8*)(lds + PG8_SB(b, h) + boff + n * 2048 + k * 1024); } while (0)
#define PG8_MMA(ai, bj, At, Bt) do { __builtin_amdgcn_s_setprio(1); _Pragma("unroll") for (int m = 0; m < 4; ++m) _Pragma("unroll") for (int n = 0; n < 2; ++n) _Pragma("unroll") for (int k = 0; k < 2; ++k) \
        acc[ai][bj][m][n] = __builtin_amdgcn_mfma_f32_16x16x32_bf16(Bt[n][k], At[m][k], acc[ai][bj][m][n], 0, 0, 0); __builtin_amdgcn_s_setprio(0); } while (0)
#define PG8_WAIT_V(n) asm volatile("s_waitcnt vmcnt(" #n ")" ::: "memory")
#define PG8_WAIT_L(n) asm volatile("s_waitcnt lgkmcnt(" #n ")" ::: "memory")
#define PG8_BAR __builtin_amdgcn_s_barrier()
#define PG8_SCHED __builtin_amdgcn_sched_barrier(0)
    Unit cur, nxt; int ui = 0;
    if (!S.next(0, cur)) return;
    f32x4 acc[2][2][4][2];
#pragma unroll
    for (int a = 0; a < 2; ++a)
#pragma unroll
        for (int b = 0; b < 2; ++b)
#pragma unroll
            for (int m = 0; m < 4; ++m)
#pragma unroll
                for (int n = 0; n < 2; ++n) acc[a][b][m][n] = (f32x4){0.f, 0.f, 0.f, 0.f};
    bf16x8 At[4][2], B0[2][2], B1[2][2];
    const char* cA = (const char*)g.A + (size_t)cur.pm * tstep; const char* cB = (const char*)g.Bt + S.boff(cur, tstep);
    S.a_ready(cur);
    if constexpr (Sched::GATHER) { PG8_LOOKUP(gc, cur); Unit u1_; if (S.next(1, u1_)) PG8_LOOKUP(gn, u1_); else { _Pragma("unroll") for (int h_ = 0; h_ < 2; ++h_) _Pragma("unroll") for (int i_ = 0; i_ < 2; ++i_) gn[h_][i_] = gc[h_][i_]; } }
    PG8_STAGE(PG8_SB(0, 0), cB, voffB); if constexpr (Sched::GATHER) PG8_STAGE_G(PG8_SA(0, 0), 0, gc[0]); else PG8_STAGE(PG8_SA(0, 0), cA, voffA);
    PG8_STAGE(PG8_SB(0, 1), cB + hstep, voffB); if constexpr (Sched::GATHER) PG8_STAGE_G(PG8_SA(0, 1), 0, gc[1]); else PG8_STAGE(PG8_SA(0, 1), cA + hstep, voffA);
    if (wr == 1) PG8_BAR;
    PG8_WAIT_V(4); PG8_BAR;
    PG8_STAGE(PG8_SB(1, 0), cB + kstep, voffB); if constexpr (Sched::GATHER) PG8_STAGE_G(PG8_SA(1, 0), kstep, gc[0]); else PG8_STAGE(PG8_SA(1, 0), cA + kstep, voffA);
    PG8_STAGE(PG8_SB(1, 1), cB + hstep + kstep, voffB);
    PG8_WAIT_V(6); PG8_BAR;
    PG8_STAMP();
    for (;;) {
        const bool has_next = S.next(ui + 1, nxt);
        const char* nA = has_next ? (const char*)g.A + (size_t)nxt.pm * tstep : cA; const char* nB = has_next ? (const char*)g.Bt + S.boff(nxt, tstep) : cB;
        const typename Epi::Pre pre = E.pre(cur, wr, wc, fr, fq);
        if constexpr (Sched::GATHER) { if (!has_next) { _Pragma("unroll") for (int h_ = 0; h_ < 2; ++h_) _Pragma("unroll") for (int i_ = 0; i_ < 2; ++i_) gn[h_][i_] = gc[h_][i_]; } }
        for (int t = 0; t < nt; t += 2) {
            const bool last = (t == nt - 2);
            unsigned gs[2][2]; size_t k1 = 0, k2 = 0;
            if constexpr (Sched::GATHER) { k1 = (size_t)(t + 1) * kstep; k2 = last ? 0 : (size_t)(t + 2) * kstep;
                _Pragma("unroll") for (int h_ = 0; h_ < 2; ++h_) _Pragma("unroll") for (int i_ = 0; i_ < 2; ++i_) gs[h_][i_] = last ? gn[h_][i_] : gc[h_][i_]; }
            const char* a1 = cA + (size_t)(t + 1) * kstep;
            const char* a2 = last ? nA : cA + (size_t)(t + 2) * kstep; const char* b2 = last ? nB : cB + (size_t)(t + 2) * kstep;
            const char* a3 = a2 + kstep; const char* b3 = b2 + kstep;
            if (last && has_next) S.a_ready(nxt);
            PG8_LDB(B0, 0, 0); PG8_SCHED; PG8_LDA(At, 0, 0); if constexpr (Sched::GATHER) PG8_STAGE_G(PG8_SA(1, 1), k1, gc[1]); else PG8_STAGE(PG8_SA(1, 1), a1 + hstep, voffA);
            PG8_WAIT_L(8); PG8_BAR; PG8_WAIT_L(0); PG8_MMA(0, 0, At, B0); PG8_BAR; PG8_SCHED;
            PG8_LDB(B1, 0, 1); PG8_STAGE(PG8_SB(0, 0), b2, voffB);
            PG8_BAR; PG8_WAIT_L(0); PG8_MMA(0, 1, At, B1); PG8_BAR;
            PG8_LDA(At, 0, 1); if constexpr (Sched::GATHER) PG8_STAGE_G(PG8_SA(0, 0), k2, gs[0]); else PG8_STAGE(PG8_SA(0, 0), a2, voffA);
            PG8_BAR; PG8_WAIT_L(0); PG8_MMA(1, 0, At, B0); PG8_BAR; PG8_SCHED;
            PG8_STAGE(PG8_SB(0, 1), b2 + hstep, voffB);
            PG8_WAIT_V(6); PG8_BAR; PG8_MMA(1, 1, At, B1); PG8_BAR;
            PG8_LDB(B0, 1, 0); PG8_SCHED; PG8_LDA(At, 1, 0); if constexpr (Sched::GATHER) PG8_STAGE_G(PG8_SA(0, 1), k2, gs[1]); else PG8_STAGE(PG8_SA(0, 1), a2 + hstep, voffA);
            PG8_WAIT_L(8); PG8_BAR; PG8_WAIT_L(0); PG8_MMA(0, 0, At, B0); PG8_BAR; PG8_SCHED;
            PG8_LDB(B1, 1, 1); PG8_STAGE(PG8_SB(1, 0), b3, voffB);
            PG8_BAR; PG8_WAIT_L(0); PG8_MMA(0, 1, At, B1); PG8_BAR;
            PG8_LDA(At, 1, 1); if constexpr (Sched::GATHER) PG8_STAGE_G(PG8_SA(1, 0), k2 + kstep, gs[0]); else PG8_STAGE(PG8_SA(1, 0), a3, voffA);
            PG8_BAR; PG8_WAIT_L(0); PG8_MMA(1, 0, At, B0); PG8_BAR; PG8_SCHED;
            PG8_STAGE(PG8_SB(1, 1), b3 + hstep, voffB);
            PG8_WAIT_V(6); PG8_BAR; PG8_MMA(1, 1, At, B1); PG8_BAR;
        }
        PG8_STAMP();
        u32x4 t4n_ = {0u, 0u, 0u, 0u}; bool has_nn_ = false;
        if constexpr (Sched::GATHER) { Unit u2_; has_nn_ = S.next(ui + 2, u2_); if (has_nn_) PG8_LOOKUP_LD(t4n_, u2_); }
        if constexpr (!Epi::AFTER_DRAIN) { if (wr == 0) PG8_BAR; E(acc, cur, wr, wc, fr, fq, pre); S.done(cur); if (wr == 1) PG8_BAR; }
        if constexpr (Sched::GATHER) { if (has_nn_) PG8_LOOKUP_FIN(gnn, t4n_); else { _Pragma("unroll") for (int h_ = 0; h_ < 2; ++h_) _Pragma("unroll") for (int i_ = 0; i_ < 2; ++i_) gnn[h_][i_] = gn[h_][i_]; } }
        PG8_STAMP();
        if (!has_next) break;
#pragma unroll
        for (int a = 0; a < 2; ++a)
#pragma unroll
            for (int b = 0; b < 2; ++b)
#pragma unroll
                for (int m = 0; m < 4; ++m)
#pragma unroll
                    for (int n = 0; n < 2; ++n) acc[a][b][m][n] = (f32x4){0.f, 0.f, 0.f, 0.f};
        cur = nxt; cA = nA; cB = nB; ++ui;
        if constexpr (Sched::GATHER) { _Pragma("unroll") for (int h_ = 0; h_ < 2; ++h_) _Pragma("unroll") for (int i_ = 0; i_ < 2; ++i_) { gc[h_][i_] = gn[h_][i_]; gn[h_][i_] = gnn[h_][i_]; } }
    }
    PG8_WAIT_V(0);
    if (wr == 0) PG8_BAR;
    PG8_BAR;
    if constexpr (Epi::AFTER_DRAIN) { E.fused(acc, cur, wr, wc, fr, fq, lds, wid, lane); S.done(cur); }
    PG8_STAMP();
    if (STAMP && wid == 0) { stamps[lane] = lane < nts ? (((unsigned long long)(unsigned)ts_hi << 32) | (unsigned)ts_lo) : 0ull;
        if (lane == 62) stamps[62] = rt_entry; if (lane == 63) stamps[63] = (unsigned long long)wall_clock64(); }
#undef PG8_STAMP
#undef PG8_SA
#undef PG8_SB
#undef PG8_STAGE
#undef PG8_STAGE_G
#undef PG8_LOOKUP
#undef PG8_LOOKUP_LD
#undef PG8_LOOKUP_FIN
#undef PG8_LDA
#undef PG8_LDB
#undef PG8_MMA
#undef PG8_WAIT_V
#undef PG8_WAIT_L
#undef PG8_BAR
#undef PG8_SCHED
}
}
namespace pg8 {
struct MoeOrder : StaticOrder {
    static constexpr bool GATHER = false;
    const LAS int* bexp; size_t estride;
    bool rev = false; bool same = false;
    __device__ __forceinline__ bool next(int i, Unit& u) const { const bool ok = StaticOrder::next(i, u); if (ok && rev) u.pm = nM - 1 - u.pm; if (ok && same) { u.pm = 0; u.pn = 0; } return ok; }
    __device__ __forceinline__ size_t boff(const Unit& u, size_t tstep) const { return (size_t)__builtin_amdgcn_readfirstlane(bexp[1 + u.pm]) * estride + (size_t)u.pn * tstep; }
};

struct MoeGatherOrder : MoeOrder {
    static constexpr bool GATHER = true;
    const unsigned* rowtab; unsigned nrows_src; const LAS int* fblk;
    __device__ __forceinline__ int rt_blk(const Unit& u) const { const int e = __builtin_amdgcn_readfirstlane(bexp[1 + u.pm]); return e * 128 + (u.pm - __builtin_amdgcn_readfirstlane(fblk[e])); }
};

template <int MODE> struct EpiGated {
    static constexpr bool PERM = true, AFTER_DRAIN = false;
    bf16_t* O; int ldo; const float* bias; int nh; const LAS int* bexp;
    struct Pre { f32x4 b0[2], b1[2]; };
    __device__ __forceinline__ Pre pre(const Unit& u, int wr, int wc, int fr, int fq) const {
        const int colh = u.pn * HALF + wc * 32 + 8 * fq; Pre p;
        const float* bp = bias; if (MODE == 1) bp += (size_t)__builtin_amdgcn_readfirstlane(bexp[1 + u.pm]) * (size_t)(2 * nh);
#pragma unroll
        for (int n = 0; n < 2; ++n) { p.b0[n] = *(const f32x4*)(bp + colh + 4 * n); p.b1[n] = *(const f32x4*)(bp + nh + colh + 4 * n); }
        return p; }
    __device__ __forceinline__ void operator()(const f32x4 (&acc)[2][2][4][2], const Unit& u, int wr, int wc, int fr, int fq, const Pre& P) const {
        const int row0 = u.pm * BM + wr * 64 + fr, colh = u.pn * HALF + wc * 32 + 8 * fq;
        f32x4 b0[2], b1[2];
#pragma unroll
        for (int n = 0; n < 2; ++n) { b0[n] = P.b0[n]; b1[n] = P.b1[n]; }
#pragma unroll
        for (int ai = 0; ai < 2; ++ai)
#pragma unroll
            for (int m = 0; m < 4; ++m) {
                float o[8];
#pragma unroll
                for (int n = 0; n < 2; ++n) { const f32x4 a = acc[ai][0][m][n] + b0[n], g = acc[ai][1][m][n] + b1[n];
#pragma unroll
                    for (int j = 0; j < 4; ++j) {
                        if (MODE == 0) o[4 * n + j] = a[j] * sigmoidf_(g[j]);
                        else { const float gg = fminf(a[j], 7.0f), uu = fminf(fmaxf(g[j], -7.0f), 7.0f);
                            o[4 * n + j] = fmaf(uu, gg, gg) * __builtin_amdgcn_rcpf(1.0f + __builtin_amdgcn_exp2f(gg * (-1.702f * 1.4426950408889634f))); } } }
                u32x4 w; w.x = cvt_pk_bf16(o[0], o[1]); w.y = cvt_pk_bf16(o[2], o[3]); w.z = cvt_pk_bf16(o[4], o[5]); w.w = cvt_pk_bf16(o[6], o[7]);
                *(u32x4*)(O + (size_t)(row0 + ai * HALF + m * 16) * ldo + colh) = w; }
    }
};
struct EpiBf16P {
    static constexpr bool PERM = true, AFTER_DRAIN = false;
    bf16_t* O; int ldo; const float* bias; int nbias; const LAS int* bexp; int probe = 0;
    struct Pre { f32x4 bv[2][2]; };
    __device__ __forceinline__ Pre pre(const Unit& u, int wr, int wc, int fr, int fq) const {
        const int col0 = u.pn * BM + wc * 32 + 8 * fq; Pre p;
        const float* bp = bias; if (bias && bexp) bp += (size_t)__builtin_amdgcn_readfirstlane(bexp[1 + u.pm]) * (size_t)nbias;
#pragma unroll
        for (int bj = 0; bj < 2; ++bj)
#pragma unroll
            for (int n = 0; n < 2; ++n) p.bv[bj][n] = bias ? *(const f32x4*)(bp + col0 + bj * HALF + 4 * n) : (f32x4){0.f, 0.f, 0.f, 0.f};
        return p; }
    __device__ __forceinline__ void operator()(const f32x4 (&acc)[2][2][4][2], const Unit& u_, int wr, int wc, int fr, int fq, const Pre& P) const {
        if (probe == 1) return;
        Unit u = u_; if (probe >= 2) { u.pm = 0; }
        const int row0 = u.pm * BM + wr * 64 + fr, col0 = u.pn * BM + wc * 32 + 8 * fq;
        f32x4 bv[2][2];
#pragma unroll
        for (int bj = 0; bj < 2; ++bj)
#pragma unroll
            for (int n = 0; n < 2; ++n) bv[bj][n] = P.bv[bj][n];
#pragma unroll
        for (int ai = 0; ai < 2; ++ai)
#pragma unroll
            for (int m = 0; m < 4; ++m) { bf16_t* rowp = O + (size_t)(row0 + ai * HALF + m * 16) * ldo + col0;
#pragma unroll
                for (int bj = 0; bj < 2; ++bj) { const f32x4 v0 = acc[ai][bj][m][0] + bv[bj][0], v1 = acc[ai][bj][m][1] + bv[bj][1];
                    u32x4 w; w.x = cvt_pk_bf16(v0[0], v0[1]); w.y = cvt_pk_bf16(v0[2], v0[3]); w.z = cvt_pk_bf16(v1[0], v1[1]); w.w = cvt_pk_bf16(v1[2], v1[3]);
                    if (probe == 3 && (ai | m)) { asm volatile("" :: "v"(w)); continue; }
                    *(u32x4*)(rowp + bj * HALF) = w; } }
    }
};
struct EpiF32P {
    static constexpr bool PERM = false, AFTER_DRAIN = false;
    float* C; int ldc;
    struct Pre {};
    __device__ __forceinline__ Pre pre(const Unit&, int, int, int, int) const { return Pre{}; }
    __device__ __forceinline__ void operator()(const f32x4 (&acc)[2][2][4][2], const Unit& u, int wr, int wc, int fr, int fq, const Pre&) const {
        const int row0 = u.pm * BM + wr * 64 + fr, col0 = u.pn * BM + wc * 32 + 4 * fq;
#pragma unroll
        for (int ai = 0; ai < 2; ++ai)
#pragma unroll
            for (int m = 0; m < 4; ++m) { float* rowp = C + (size_t)(row0 + ai * HALF + m * 16) * ldc + col0;
#pragma unroll
                for (int bj = 0; bj < 2; ++bj)
#pragma unroll
                    for (int n = 0; n < 2; ++n) *(f32x4*)(rowp + bj * HALF + n * 16) = acc[ai][bj][m][n]; }
    }
};
struct EpiResid {
    static constexpr bool PERM = false, AFTER_DRAIN = false;
    const float* base; float* X; const float* bias; const float* gate;
    struct Pre {};
    __device__ __forceinline__ Pre pre(const Unit&, int, int, int, int) const { return Pre{}; }
    __device__ __forceinline__ void operator()(const f32x4 (&acc)[2][2][4][2], const Unit& u, int wr, int wc, int fr, int fq, const Pre&) const {
        const int row0 = u.pm * BM + wr * 64 + fr, col0 = u.pn * BM + wc * 32 + 4 * fq;
        const float* gp = gate + (size_t)((u.pm * BM) / SEQ) * (6 * D);
        f32x4 bv[2][2], gv[2][2];
#pragma unroll
        for (int bj = 0; bj < 2; ++bj)
#pragma unroll
            for (int n = 0; n < 2; ++n) { bv[bj][n] = bias ? *(const f32x4*)(bias + col0 + bj * HALF + n * 16) : (f32x4){0.f, 0.f, 0.f, 0.f}; gv[bj][n] = *(const f32x4*)(gp + col0 + bj * HALF + n * 16); }
#pragma unroll
        for (int ai = 0; ai < 2; ++ai)
#pragma unroll
            for (int m = 0; m < 4; ++m) { const size_t off = (size_t)(row0 + ai * HALF + m * 16) * D + col0;
                f32x4 bs[2][2];
#pragma unroll
                for (int bj = 0; bj < 2; ++bj)
#pragma unroll
                    for (int n = 0; n < 2; ++n) bs[bj][n] = *(const f32x4*)(base + off + bj * HALF + n * 16);
#pragma unroll
                for (int bj = 0; bj < 2; ++bj)
#pragma unroll
                    for (int n = 0; n < 2; ++n) *(f32x4*)(X + off + bj * HALF + n * 16) = bs[bj][n] + gv[bj][n] * (acc[ai][bj][m][n] + bv[bj][n]); }
    }
};
struct EpiQRope {
    static constexpr bool PERM = true, AFTER_DRAIN = false;
    bf16_t* O; const f32x2* cs;
    struct Pre {};
    __device__ __forceinline__ Pre pre(const Unit&, int, int, int, int) const { return Pre{}; }
    __device__ __forceinline__ void operator()(const f32x4 (&acc)[2][2][4][2], const Unit& u, int wr, int wc, int fr, int fq, const Pre&) const {
        const int row0 = u.pm * BM + wr * 64 + fr, col0 = u.pn * BM + wc * 32 + 8 * fq;
#pragma unroll
        for (int bj = 0; bj < 2; ++bj) {
            const int c = col0 + bj * HALF, w = c % DQK; const bool rope = w >= DNOPE; const int k4 = rope ? ((w - DNOPE) >> 3) * 4 : 0;
#pragma unroll
            for (int ai = 0; ai < 2; ++ai)
#pragma unroll
                for (int m = 0; m < 4; ++m) { const int row = row0 + ai * HALF + m * 16;
                    f32x4 v0 = acc[ai][bj][m][0], v1 = acc[ai][bj][m][1];
                    if (rope) { const f32x4 t0 = *(const f32x4*)(cs + (size_t)row * 32 + k4), t1 = *(const f32x4*)(cs + (size_t)row * 32 + k4 + 2);
                        const float co[4] = {t0[0], t0[2], t1[0], t1[2]}, si[4] = {t0[1], t0[3], t1[1], t1[3]};
#pragma unroll
                        for (int j = 0; j < 4; ++j) { const float x1 = v0[j], x2 = v1[j]; v0[j] = x1 * co[j] - x2 * si[j]; v1[j] = x2 * co[j] + x1 * si[j]; } }
                    u32x4 wv; wv.x = cvt_pk_bf16(v0[0], v0[1]); wv.y = cvt_pk_bf16(v0[2], v0[3]); wv.z = cvt_pk_bf16(v1[0], v1[1]); wv.w = cvt_pk_bf16(v1[2], v1[3]);
                    *(u32x4*)(O + (size_t)row * (NH * DQK) + c) = wv;
                    asm volatile("" ::: "memory"); } }
    }
};

template <bool BF> struct EpiResidB {
    static constexpr bool PERM = true, AFTER_DRAIN = false;
    const void* base; bf16_t* X; const float* bias; const float* gate;
    struct Pre {};
    __device__ __forceinline__ Pre pre(const Unit&, int, int, int, int) const { return Pre{}; }
    __device__ __forceinline__ void operator()(const f32x4 (&acc)[2][2][4][2], const Unit& u, int wr, int wc, int fr, int fq, const Pre&) const {
        const int row0 = u.pm * BM + wr * 64 + fr, col0 = u.pn * BM + wc * 32 + 8 * fq;
        const float* gp = gate + (size_t)((u.pm * BM) / SEQ) * (6 * D);
        f32x4 bv[2][2], gv[2][2];
#pragma unroll
        for (int bj = 0; bj < 2; ++bj)
#pragma unroll
            for (int n = 0; n < 2; ++n) { bv[bj][n] = bias ? *(const f32x4*)(bias + col0 + bj * HALF + 4 * n) : (f32x4){0.f, 0.f, 0.f, 0.f}; gv[bj][n] = *(const f32x4*)(gp + col0 + bj * HALF + 4 * n); }
#pragma unroll
        for (int ai = 0; ai < 2; ++ai)
#pragma unroll
            for (int m = 0; m < 4; ++m) { const size_t off = (size_t)(row0 + ai * HALF + m * 16) * D + col0;
                f32x4 b0[2], b1[2];
#pragma unroll
                for (int bj = 0; bj < 2; ++bj) {
                    if (BF) { const u32x4 w = *(const u32x4*)((const bf16_t*)base + off + bj * HALF); b0[bj] = (f32x4){bflo(w.x), bfhi(w.x), bflo(w.y), bfhi(w.y)}; b1[bj] = (f32x4){bflo(w.z), bfhi(w.z), bflo(w.w), bfhi(w.w)}; }
                    else { b0[bj] = *(const f32x4*)((const float*)base + off + bj * HALF); b1[bj] = *(const f32x4*)((const float*)base + off + bj * HALF + 4); } }
#pragma unroll
                for (int bj = 0; bj < 2; ++bj) { const f32x4 v0 = b0[bj] + gv[bj][0] * (acc[ai][bj][m][0] + bv[bj][0]), v1 = b1[bj] + gv[bj][1] * (acc[ai][bj][m][1] + bv[bj][1]);
                    u32x4 w; w.x = cvt_pk_bf16(v0[0], v0[1]); w.y = cvt_pk_bf16(v0[2], v0[3]); w.z = cvt_pk_bf16(v1[0], v1[1]); w.w = cvt_pk_bf16(v1[2], v1[3]);
                    *(u32x4*)(X + off + bj * HALF) = w; } }
    }
};
struct EpiLatQ {
    static constexpr bool PERM = true, AFTER_DRAIN = false;
    bf16_t* O0; int ld0, n0; bf16_t* KR; const f32x2* cs; float* ssp;
    struct Pre {};
    __device__ __forceinline__ Pre pre(const Unit&, int, int, int, int) const { return Pre{}; }
    __device__ __forceinline__ void operator()(const f32x4 (&acc)[2][2][4][2], const Unit& u, int wr, int wc, int fr, int fq, const Pre&) const {
        const int row0 = u.pm * BM + wr * 64 + fr, col0 = u.pn * BM + wc * 32 + 8 * fq;
#pragma unroll
        for (int ai = 0; ai < 2; ++ai)
#pragma unroll
            for (int m = 0; m < 4; ++m) { const int row = row0 + ai * HALF + m * 16; float ss = 0.f;
#pragma unroll
                for (int bj = 0; bj < 2; ++bj) { const int c = col0 + bj * HALF; f32x4 v0 = acc[ai][bj][m][0], v1 = acc[ai][bj][m][1];
                    if (c < n0) {
                        ss += (v0[0] * v0[0] + v0[1] * v0[1]) + (v0[2] * v0[2] + v0[3] * v0[3]) + (v1[0] * v1[0] + v1[1] * v1[1]) + (v1[2] * v1[2] + v1[3] * v1[3]);
                        u32x4 w; w.x = cvt_pk_bf16(v0[0], v0[1]); w.y = cvt_pk_bf16(v0[2], v0[3]); w.z = cvt_pk_bf16(v1[0], v1[1]); w.w = cvt_pk_bf16(v1[2], v1[3]);
                        *(u32x4*)(O0 + (size_t)row * ld0 + c) = w;
                    } else if (KR && c < n0 + DROPE) { const int k4 = ((c - n0) >> 3) * 4; const f32x4 t0 = *(const f32x4*)(cs + (size_t)row * 32 + k4), t1 = *(const f32x4*)(cs + (size_t)row * 32 + k4 + 2);
                        const float co[4] = {t0[0], t0[2], t1[0], t1[2]}, si[4] = {t0[1], t0[3], t1[1], t1[3]};
#pragma unroll
                        for (int j = 0; j < 4; ++j) { const float x1 = v0[j], x2 = v1[j]; v0[j] = x1 * co[j] - x2 * si[j]; v1[j] = x2 * co[j] + x1 * si[j]; }
                        u32x4 w; w.x = cvt_pk_bf16(v0[0], v0[1]); w.y = cvt_pk_bf16(v0[2], v0[3]); w.z = cvt_pk_bf16(v1[0], v1[1]); w.w = cvt_pk_bf16(v1[2], v1[3]);
                        *(u32x4*)(KR + (size_t)row * DROPE + (c - n0)) = w; } }
                ss += __shfl_xor(ss, 16); ss += __shfl_xor(ss, 32);
                if (fq == 0) ssp[(size_t)row * 8 + u.pn * 4 + wc] = ss;
                asm volatile("" ::: "memory"); }
    }
};
struct EpiScaled {
    static constexpr bool PERM = true, AFTER_DRAIN = false;
    bf16_t* O; int ldo; const float* ssp; int mode, np; float inv_nd;
    struct Pre {};
    __device__ __forceinline__ Pre pre(const Unit&, int, int, int, int) const { return Pre{}; }
    __device__ __forceinline__ float rstd_of(int t) const { const f32x4 a = *(const f32x4*)(ssp + (size_t)t * 8); float s = (a[0] + a[1]) + (a[2] + a[3]);
        if (np == 8) { const f32x4 b = *(const f32x4*)(ssp + (size_t)t * 8 + 4); s += (b[0] + b[1]) + (b[2] + b[3]); } return rsqrtf(s * inv_nd + EPS); }
    __device__ __forceinline__ void operator()(const f32x4 (&acc)[2][2][4][2], const Unit& u, int wr, int wc, int fr, int fq, const Pre&) const {
        const int row0 = u.pm * BM + wr * 64 + fr, col0 = u.pn * BM + wc * 32 + 8 * fq;
        if (mode == 1) {
#pragma unroll
            for (int bj = 0; bj < 2; ++bj) { const int c = col0 + bj * HALF; float rc[8];
#pragma unroll
                for (int j = 0; j < 8; ++j) rc[j] = rstd_of(c + j);
#pragma unroll
                for (int ai = 0; ai < 2; ++ai)
#pragma unroll
                    for (int m = 0; m < 4; ++m) { const f32x4 v0 = acc[ai][bj][m][0], v1 = acc[ai][bj][m][1];
                        u32x4 w; w.x = cvt_pk_bf16(v0[0] * rc[0], v0[1] * rc[1]); w.y = cvt_pk_bf16(v0[2] * rc[2], v0[3] * rc[3]); w.z = cvt_pk_bf16(v1[0] * rc[4], v1[1] * rc[5]); w.w = cvt_pk_bf16(v1[2] * rc[6], v1[3] * rc[7]);
                        *(u32x4*)(O + (size_t)(row0 + ai * HALF + m * 16) * ldo + c) = w; }
                asm volatile("" ::: "memory"); }
        } else {
#pragma unroll
            for (int ai = 0; ai < 2; ++ai)
#pragma unroll
                for (int m = 0; m < 4; ++m) { const int row = row0 + ai * HALF + m * 16; const float r = rstd_of(row);
#pragma unroll
                    for (int bj = 0; bj < 2; ++bj) { const f32x4 v0 = acc[ai][bj][m][0] * r, v1 = acc[ai][bj][m][1] * r;
                        u32x4 w; w.x = cvt_pk_bf16(v0[0], v0[1]); w.y = cvt_pk_bf16(v0[2], v0[3]); w.z = cvt_pk_bf16(v1[0], v1[1]); w.w = cvt_pk_bf16(v1[2], v1[3]);
                        *(u32x4*)(O + (size_t)row * ldo + col0 + bj * HALF) = w; }
                    asm volatile("" ::: "memory"); }
        }
    }
};

#if NAIVE_GEMM
template <class Epi, class Sched>
__device__ __forceinline__ void gemm_phase_naive(PG8_LAS unsigned char*, const Gemm g, const Sched& S, const Epi& E) {
    const int tid = threadIdx.x, wid = tid >> 6, lane = tid & 63, wr = wid >> 2, wc = wid & 3, fr = lane & 15, fq = lane >> 4;
    const size_t tstep = (size_t)BM * g.K * 2;
    Unit u;
    for (int i = 0; S.next(i, u); ++i) {
        f32x4 acc[2][2][4][2];
        const bf16_t* Bb = (const bf16_t*)((const char*)g.Bt + S.boff(u, tstep));
#pragma unroll 1
        for (int ai = 0; ai < 2; ++ai)
#pragma unroll 1
            for (int m = 0; m < 4; ++m) {
                const bf16_t* ar = g.A + (size_t)(u.pm * BM + ai * HALF + wr * 64 + m * 16 + fr) * g.K;
#pragma unroll
                for (int bj = 0; bj < 2; ++bj)
#pragma unroll
                    for (int n = 0; n < 2; ++n) {
                        const int cs = Epi::PERM ? (bj * HALF + wc * 32 + 8 * fq + 4 * n) : (bj * HALF + wc * 32 + 16 * n + 4 * fq);
                        float s[4] = {0.f, 0.f, 0.f, 0.f};
                        for (int k = 0; k < g.K; k += 8) {
                            const u32x4 av = *(const u32x4*)(ar + k);
#pragma unroll
                            for (int j = 0; j < 4; ++j) { const u32x4 bv = *(const u32x4*)(Bb + (size_t)(cs + j) * g.K + k);
                                s[j] += bflo(av.x) * bflo(bv.x) + bfhi(av.x) * bfhi(bv.x) + bflo(av.y) * bflo(bv.y) + bfhi(av.y) * bfhi(bv.y)
                                      + bflo(av.z) * bflo(bv.z) + bfhi(av.z) * bfhi(bv.z) + bflo(av.w) * bflo(bv.w) + bfhi(av.w) * bfhi(bv.w); } }
                        f32x4 r = {s[0], s[1], s[2], s[3]};
#pragma unroll
                        for (int a2 = 0; a2 < 2; ++a2)
#pragma unroll
                            for (int m2 = 0; m2 < 4; ++m2) if (a2 == ai && m2 == m) acc[a2][bj][m2][n] = r;
                    }
            }
        E(acc, u, wr, wc, fr, fq, E.pre(u, wr, wc, fr, fq));
    }
}
#endif
}

#if NAIVE_GEMM
#define GEMM_PHASE pg8::gemm_phase_naive
#else
#define GEMM_PHASE pg8::gemm_phase
#endif
struct Frame {
    LAS unsigned char* lds; GAS unsigned char* ws; const Args* a;
    int tid, lane, wave, G, blk;
};
__device__ __forceinline__ const float* modp(const Frame& F, int l, int b, int part) { return (const float*)(F.ws + WS_MOD) + ((size_t)(l * NB + b) * 6 + part) * D; }

enum { CM_ID = 0, CM_GLU = 1, CM_UQ = 2, CM_DKV = 3 };
__device__ __forceinline__ int cvt_srccol(int mode, int n, int nvalid, int nh) {
    if (mode == CM_GLU) { const int pn = n >> 8, r = n & 255; return r < 128 ? pn * 128 + r : nh + pn * 128 + (r - 128); }
    if (mode == CM_UQ) { const int h = n / DQK, w = n - h * DQK; if (w < DNOPE) return n; const int p = w - DNOPE, blk = p >> 3, wi = p & 7, i = 4 * blk + (wi & 3); return h * DQK + (wi < 4 ? DNOPE + i : DNOPE + 32 + i); }
    if (mode == CM_DKV) { if (n < KVLORA) return n; if (n >= KVLORA + DROPE) return -1; const int p = n - KVLORA, blk = p >> 3, wi = p & 7, i = 4 * blk + (wi & 3); return KVLORA + (wi < 4 ? i : 32 + i); }
    return n < nvalid ? n : -1;
}
struct CvtJob { const float* src; bf16_t* dst; int K, ld, ndst, nvalid, mode, batch; size_t sstride, dstride; float scale; const float* kgain; };
__device__ __forceinline__ int cvt_tiles(const CvtJob& j) { return j.batch * (j.ndst / 128) * (j.K / 128); }
struct CvtTile { const float* src; bf16_t* dst; int n0, k0, sc; };
__device__ __forceinline__ CvtTile cvt_locate(const Frame& F, const CvtJob& J, int t) {
    const int nkt = J.K / 128, nnt = J.ndst / 128, per = nkt * nnt, bi = t / per, r = t - bi * per, nt = r / nkt, kt = r - nt * nkt;
    CvtTile T; T.src = J.src + (size_t)bi * J.sstride; T.dst = J.dst + (size_t)bi * J.dstride; T.n0 = nt * 128; T.k0 = kt * 128;
    T.sc = cvt_srccol(J.mode, T.n0 + 4 * (F.tid & 31), J.nvalid, J.ndst / 2); return T;
}
__device__ __forceinline__ void cvt_load(const Frame& F, const CvtJob& J, const CvtTile& T, f32x4 (&v)[8]) {
    const int kg = F.tid >> 5;
#pragma unroll
    for (int i = 0; i < 8; ++i) v[i] = T.sc >= 0 ? *(const f32x4*)(T.src + (size_t)(T.k0 + 8 * kg + i) * J.ld + T.sc) : (f32x4){0.f, 0.f, 0.f, 0.f};
}
__device__ __forceinline__ void cvt_to_lds(const Frame& F, const CvtJob& J, const CvtTile& T, const f32x4 (&v)[8], LAS unsigned char* img) {
    const int nq = F.tid & 31, kg = F.tid >> 5; float sc[8];
#pragma unroll
    for (int i = 0; i < 8; ++i) sc[i] = J.kgain ? J.scale * J.kgain[T.k0 + 8 * kg + i] : J.scale;
#pragma unroll
    for (int j = 0; j < 4; ++j) {
        u32x4 w; w.x = cvt_pk_bf16(v[0][j] * sc[0], v[1][j] * sc[1]); w.y = cvt_pk_bf16(v[2][j] * sc[2], v[3][j] * sc[3]); w.z = cvt_pk_bf16(v[4][j] * sc[4], v[5][j] * sc[5]); w.w = cvt_pk_bf16(v[6][j] * sc[6], v[7][j] * sc[7]);
        *(LAS u32x4*)(img + (4 * nq + j) * 256 + ((kg ^ (nq & 7)) << 4)) = w; }
}
__device__ __forceinline__ void cvt_from_lds(const Frame& F, const CvtJob& J, const CvtTile& T, const LAS unsigned char* img) {
#pragma unroll
    for (int p = 0; p < 4; ++p) { const int row = p * 32 + (F.tid >> 4), c = F.tid & 15;
        const u32x4 w = *(const LAS u32x4*)(img + row * 256 + ((c ^ ((row >> 2) & 7)) << 4));
        *(u32x4*)(T.dst + (size_t)(T.n0 + row) * J.K + T.k0 + c * 8) = w; }
}
__device__ __forceinline__ void cvt_job(const Frame& F, const CvtJob& J, int t0, int nt) {
    for (int t = t0; t < nt; t += 2 * F.G) {
        const bool two = t + F.G < nt;
        const CvtTile A = cvt_locate(F, J, t), B = cvt_locate(F, J, two ? t + F.G : t);
        f32x4 va[8], vb[8];
        cvt_load(F, J, A, va); if (two) cvt_load(F, J, B, vb);
        cvt_to_lds(F, J, A, va, F.lds); if (two) cvt_to_lds(F, J, B, vb, F.lds + 32768);
        __syncthreads();
        cvt_from_lds(F, J, A, F.lds); if (two) cvt_from_lds(F, J, B, F.lds + 32768);
        __syncthreads();
    }
}
__device__ __forceinline__ void sincos_small(float r, float& s, float& c) {
    const float q = rintf(r * 0.63661977236758134f); const float y = fmaf(q, -1.5707963267948966f, r) + q * 4.371139e-8f; const int qi = (int)q & 3;
    const float y2 = y * y;
    const float sp = y + y * y2 * (-1.6666654611e-1f + y2 * (8.3321608736e-3f + y2 * (-1.9515295891e-4f)));
    const float cp = 1.0f - 0.5f * y2 + y2 * y2 * (4.166664568298827e-2f + y2 * (-1.388731625493765e-3f + y2 * 2.443315711809948e-5f));
    s = (qi == 0) ? sp : (qi == 1) ? cp : (qi == 2) ? -sp : -cp;
    c = (qi == 0) ? cp : (qi == 1) ? -sp : (qi == 2) ? -cp : sp;
}
__device__ __forceinline__ void ph_prologue(const Frame& F) {
    const Args& A = *F.a; GAS unsigned char* ws = F.ws;
    const float qscale = 0.07216878364870322f * 1.4426950408889634f;
    CvtJob J[10];
    J[0] = {GPTR(const float, A.in[I_PW1W]), (bf16_t*)(ws + WS_WPW1), 1024, 2048, 2048, 2048, CM_GLU, 1, 0, 0, 1.f, nullptr};
    J[1] = {GPTR(const float, A.in[I_PW2W]), (bf16_t*)(ws + WS_WPW2), 1024, 1024, 1024, 1024, CM_ID, 1, 0, 0, 1.f, nullptr};
    J[2] = {GPTR(const float, A.in[I_WDKV]), (bf16_t*)(ws + WS_WDKV), 1024, 320, 512, 320, CM_DKV, 1, 0, 0, 1.f, nullptr};
    J[3] = {GPTR(const float, A.in[I_WDQ]), (bf16_t*)(ws + WS_WDQ), 1024, 384, 512, 384, CM_ID, 1, 0, 0, 1.f, nullptr};
    J[4] = {GPTR(const float, A.in[I_WUK]), (bf16_t*)(ws + WS_WUK), 256, 1024, 1024, 1024, CM_ID, 1, 0, 0, 1.f, GPTR(const float, A.in[I_CKVG])};
    J[5] = {GPTR(const float, A.in[I_WUV]), (bf16_t*)(ws + WS_WUV), 256, 1024, 1024, 1024, CM_ID, 1, 0, 0, 1.f, GPTR(const float, A.in[I_CKVG])};
    J[6] = {GPTR(const float, A.in[I_WUQ]), (bf16_t*)(ws + WS_WUQ), 384, 1536, 1536, 1536, CM_UQ, 1, 0, 0, qscale, GPTR(const float, A.in[I_CQG])};
    J[7] = {GPTR(const float, A.in[I_WO]), (bf16_t*)(ws + WS_WO), 1024, 1024, 1024, 1024, CM_ID, 1, 0, 0, 1.f, nullptr};
    J[8] = {GPTR(const float, A.in[I_WGU]), (bf16_t*)(ws + WS_WGU), 1024, 2048, 2048, 2048, CM_GLU, 64, (size_t)1024 * 2048, (size_t)2048 * 1024, 1.f, nullptr};
    J[9] = {GPTR(const float, A.in[I_WDN]), (bf16_t*)(ws + WS_WDN), 1024, 1024, 1024, 1024, CM_ID, 64, (size_t)1024 * 1024, (size_t)1024 * 1024, 1.f, nullptr};
    int base = 0;
#pragma unroll
    for (int j = 0; j < 10; ++j) { const int nt = cvt_tiles(J[j]);
        int t = F.blk - (base % F.G); if (t < 0) t += F.G;
        cvt_job(F, J[j], t, nt);
        base += nt; }
    {
        LAS float* cact = (LAS float*)F.lds;
        LAS float* red = cact + 4096;
        for (int i = F.tid; i < NB * D; i += NTHR) { const float c = GPTR(const float, A.in[I_C])[i]; cact[i] = c * sigmoidf_(c); }
        __syncthreads();
        for (int it = F.blk; it < 2 * 96; it += F.G) {
            const int l = it / 96, j0 = (it - l * 96) * 64, col = F.tid & 63, dg = F.tid >> 6;
            const float* wp = GPTR(const float, A.in[I_MODW]) + (size_t)l * D * 6 * D + (size_t)(dg * 128) * (6 * D) + j0 + col;
            float a0 = 0.f, a1 = 0.f, a2 = 0.f, a3 = 0.f;
#pragma unroll 32
            for (int d = 0; d < 128; ++d) { const float w = wp[(size_t)d * (6 * D)]; const int dd = dg * 128 + d;
                a0 += w * cact[dd]; a1 += w * cact[1024 + dd]; a2 += w * cact[2048 + dd]; a3 += w * cact[3072 + dd]; }
            red[(dg * 4 + 0) * 64 + col] = a0; red[(dg * 4 + 1) * 64 + col] = a1; red[(dg * 4 + 2) * 64 + col] = a2; red[(dg * 4 + 3) * 64 + col] = a3;
            __syncthreads();
            if (F.tid < 256) { const int b = F.tid >> 6, c2 = F.tid & 63; float s = GPTR(const float, A.in[I_MODB])[l * 6 * D + j0 + c2];
#pragma unroll
                for (int g = 0; g < 8; ++g) s += red[(g * 4 + b) * 64 + c2];
                ((float*)(ws + WS_MOD))[(size_t)(l * NB + b) * (6 * D) + j0 + c2] = s; }
            __syncthreads();
        }
    }
    {
        const int* pos = (const int*)GPTR(const float, A.in[I_POS]); f32x2* cs = (f32x2*)(ws + WS_CS);
        for (int idx = F.blk * NTHR + F.tid; idx < NTOK * 32; idx += F.G * NTHR) {
            const int tok = idx >> 5, i = idx & 31;
            const double inv = exp(-(2.0 * 9.210340371976184 / 64.0) * (double)i);
            const double ang = (double)pos[tok] * inv, rev = ang * 0.15915494309189535, fr = rev - rint(rev);
            float s, c; sincos_small((float)(fr * 6.283185307179586), s, c);
            cs[idx] = (f32x2){c, s};
        }
    }
}

__device__ __forceinline__ void row_ld16(const float* p, int lane, f32x4 (&v)[4]) {
#pragma unroll
    for (int i = 0; i < 4; ++i) v[i] = *(const f32x4*)(p + i * 256 + lane * 4);
}
__device__ __forceinline__ void row_st16_bf16(bf16_t* p, int lane, const f32x4 (&v)[4]) {
#pragma unroll
    for (int i = 0; i < 4; ++i) { u32x2 w; w.x = cvt_pk_bf16(v[i][0], v[i][1]); w.y = cvt_pk_bf16(v[i][2], v[i][3]); *(u32x2*)(p + i * 256 + lane * 4) = w; }
}
__device__ __forceinline__ float row_rstd(const f32x4 (&v)[4]) {
    float s = 0.f;
#pragma unroll
    for (int i = 0; i < 4; ++i) s += v[i][0] * v[i][0] + v[i][1] * v[i][1] + v[i][2] * v[i][2] + v[i][3] * v[i][3];
    s = wave_sum(s);
    return rsqrtf(s * (1.0f / D) + EPS);
}

__device__ __forceinline__ void ph_norm1(const Frame& F) {
    const Args& A = *F.a; bf16_t* HA = (bf16_t*)(F.ws + WS_HA); const float* g = GPTR(const float, A.in[I_N1G]);
    for (int row = F.blk * NWAVE + F.wave; row < NTOK; row += F.G * NWAVE) {
        const int b = row / SEQ; f32x4 v[4], gv[4], sh[4], sc[4];
        row_ld16(GPTR(const float, A.in[I_X]) + (size_t)row * D, F.lane, v); row_ld16(g, F.lane, gv); row_ld16(modp(F, 0, b, 0), F.lane, sh); row_ld16(modp(F, 0, b, 1), F.lane, sc);
        const float rs = row_rstd(v);
#pragma unroll
        for (int i = 0; i < 4; ++i) v[i] = v[i] * rs * gv[i] * (sc[i] + 1.0f) + sh[i];
        row_st16_bf16(HA + (size_t)row * D, F.lane, v);
    }
}

__device__ __forceinline__ void ph_conv(const Frame& F) {
    const Args& A = *F.a; const bf16_t* U = (const bf16_t*)(F.ws + WS_HB); bf16_t* O = (bf16_t*)(F.ws + WS_HC);
    LAS unsigned char* tile = F.lds;
    LAS f32x2* part = (LAS f32x2*)(F.lds + 62 * 2048);
    LAS f32x2* red = part + 8 * NTHR;
    const int c2 = F.tid * 2;
    f32x2 w[CONVW];
#pragma unroll
    for (int j = 0; j < CONVW; ++j) w[j] = *(const f32x2*)(GPTR(const float, A.in[I_DWW]) + j * D + c2);
    const f32x2 db = *(const f32x2*)(GPTR(const float, A.in[I_DWB]) + c2), lg = *(const f32x2*)(GPTR(const float, A.in[I_LNG]) + c2), lb = *(const f32x2*)(GPTR(const float, A.in[I_LNB]) + c2);
    for (int t = F.blk; t < NTOK / 32; t += F.G) {
        const int tok0 = t * 32, s0 = tok0 % SEQ;
        for (int ch = F.tid; ch < 62 * 128; ch += NTHR) { const int r = ch >> 7, cc = ch & 127; u32x4 v = {0u, 0u, 0u, 0u};
            if (s0 + r - 30 >= 0) v = *(const u32x4*)(U + (size_t)(tok0 + r - 30) * D + cc * 8);
            *(LAS u32x4*)(tile + r * 2048 + cc * 16) = v; }
        __syncthreads();
#pragma unroll 1
        for (int g = 0; g < 4; ++g) {
            f32x2 acc[8];
#pragma unroll
            for (int r = 0; r < 8; ++r) acc[r] = db;
#pragma unroll
            for (int j = 0; j < 38; ++j) { const unsigned u = *(const LAS unsigned*)(tile + (g * 8 + j) * 2048 + F.tid * 4); const f32x2 x = {bflo(u), bfhi(u)};
#pragma unroll
                for (int r = 0; r < 8; ++r) { const int tap = j - r; if (tap >= 0 && tap < CONVW) acc[r] += x * w[tap]; } }
#pragma unroll
            for (int r = 0; r < 8; ++r) part[r * NTHR + F.tid] = (f32x2){acc[r][0] + acc[r][1], acc[r][0] * acc[r][0] + acc[r][1] * acc[r][1]};
            __syncthreads();
            { float s = 0.f, q = 0.f;
#pragma unroll
              for (int i = 0; i < 8; ++i) { const f32x2 p = part[F.wave * NTHR + i * 64 + F.lane]; s += p[0]; q += p[1]; }
              s = wave_sum(s); q = wave_sum(q);
              if (F.lane == 0) { const float mean = s * (1.0f / D), var = fmaxf(q * (1.0f / D) - mean * mean, 0.f); red[F.wave] = (f32x2){mean, rsqrtf(var + EPS)}; } }
            __syncthreads();
#pragma unroll
            for (int r = 0; r < 8; ++r) { const f32x2 st = red[r]; const float mean = st[0], rs = st[1];
                const float y0 = (acc[r][0] - mean) * rs * lg[0] + lb[0], y1 = (acc[r][1] - mean) * rs * lg[1] + lb[1];
                *(unsigned*)(O + (size_t)(tok0 + g * 8 + r) * D + c2) = cvt_pk_bf16(y0 * sigmoidf_(y0), y1 * sigmoidf_(y1)); }
            __syncthreads();
        }
    }
}

__device__ __forceinline__ void ph_router_prep(const Frame& F) {
    const Args& A = *F.a; bf16_t* rwf = (bf16_t*)(F.ws + WS_RWF); float* rbias = (float*)(F.ws + WS_RBIAS);
    for (int it = F.blk; it < 8 * 64; it += F.G) {
        const int lb = it >> 6, s = it & 63, l = lb >> 2, b = lb & 3, hh = F.tid >> 8, e = (F.tid >> 3) & 31, j = F.tid & 7, k = 16 * s + 8 * hh + j;
        const float v = GPTR(const float, A.in[I_N2G])[l * D + k] * (1.0f + modp(F, l, b, 4)[k]) * GPTR(const float, A.in[I_RW])[(size_t)l * D * NE + k * NE + e];
        const unsigned hi = cvt_pk_bf16(v, 0.f) & 0xffffu; const float rem = v - bflo(hi); const unsigned lo = cvt_pk_bf16(rem, 0.f) & 0xffffu;
        const size_t o = ((size_t)lb * 2 * 64 * 2 * 32 + ((size_t)s * 2 + hh) * 32 + e) * 8 + j;
        rwf[o] = (bf16_t)hi; rwf[o + (size_t)64 * 2 * 32 * 8] = (bf16_t)lo;
    }
    if (F.blk < 8) { const int l = F.blk >> 2, b = F.blk & 3, e = F.tid >> 4, q = F.tid & 15; float s = 0.f;
        for (int k = q; k < D; k += 16) s += modp(F, l, b, 3)[k] * GPTR(const float, A.in[I_RW])[(size_t)l * D * NE + k * NE + e];
        s += __shfl_xor(s, 8); s += __shfl_xor(s, 4); s += __shfl_xor(s, 2); s += __shfl_xor(s, 1);
        if (q == 0) rbias[F.blk * NE + e] = s + GPTR(const float, A.in[I_RB])[l * NE + e]; }
}

__device__ __forceinline__ void moe_layout(const Frame& F, int l, LAS int* tab, LAS int* fb) {
    const unsigned* tot = (const unsigned*)(F.ws + WS_MOETOT) + l * NE;
    LAS int* nbv = fb + 40;
    if (F.tid < NE) nbv[F.tid] = (int)((tot[F.tid] + EBLK - 1) / EBLK);
    __syncthreads();
    if (F.tid <= NE) { int s = 0; for (int e = 0; e < F.tid; ++e) s += nbv[e]; fb[F.tid] = s; if (F.tid == NE && tab) tab[0] = s; }
    __syncthreads();
    if (tab) for (int i = F.tid; i < MAXBLK; i += NTHR) { int e = 0;
#pragma unroll 1
        for (int q = 1; q < NE; ++q) e = (i >= fb[q]) ? q : e;
        tab[1 + i] = e; }
    __syncthreads();
}

__device__ __forceinline__ void ph_router(const Frame& F, int l) {
    const Args& A = *F.a; const bf16_t* X = (const bf16_t*)(F.ws + WS_X); bf16_t* HA = (bf16_t*)(F.ws + WS_HA);
    const int ntok_blk = NTOK / F.G, tok0 = F.blk * ntok_blk, b = tok0 / SEQ;
    LAS unsigned char* wl_ = F.lds;
    LAS int* cnt = (LAS int*)(F.lds + 131072 + 2304);
    LAS float* cx = (LAS float*)(F.lds + 135168);
    LAS float* sq = (LAS float*)(F.lds + 135168 + 16384);
    { const u32x4* src = (const u32x4*)(F.ws + WS_RWF + (size_t)(l * NB + b) * 131072);
      for (int i = F.tid; i < 131072 / 16; i += NTHR) *(LAS u32x4*)(wl_ + i * 16) = src[i]; }
    if (F.tid < NE) cnt[F.tid] = 0;
    __syncthreads();
    const int w = F.wave, lane = F.lane, grp = w & 3, kh = w >> 2, r = lane & 31, hi = lane >> 5;
    {
        const bf16_t* xr = X + (size_t)(tok0 + grp * 32 + r) * D + kh * 512 + hi * 8;
        const LAS unsigned char* bw = wl_ + ((kh * 32 * 2 + hi) * 32 + r) * 16;
        f32x16 acc;
#pragma unroll
        for (int i = 0; i < 16; ++i) acc[i] = 0.f;
        float ssq = 0.f;
        u32x4 xa[8], xb[8];
#define RT_LD(dst, s0) do { _Pragma("unroll") for (int u = 0; u < 8; ++u) dst[u] = *(const u32x4*)(xr + ((s0) + u) * 16); } while (0)
#define RT_DO(src, s0) do { _Pragma("unroll") for (int u = 0; u < 8; ++u) { const u32x4 xw = src[u]; \
            { const float a0 = bflo(xw.x), a1 = bfhi(xw.x), a2 = bflo(xw.y), a3 = bfhi(xw.y), a4 = bflo(xw.z), a5 = bfhi(xw.z), a6 = bflo(xw.w), a7 = bfhi(xw.w); \
              ssq += (a0 * a0 + a1 * a1) + (a2 * a2 + a3 * a3) + (a4 * a4 + a5 * a5) + (a6 * a6 + a7 * a7); } \
            const bf16x8 ah = *(const bf16x8*)&xw; \
            const bf16x8 bh = *(const LAS bf16x8*)(bw + ((s0) + u) * 1024), bl = *(const LAS bf16x8*)(bw + ((s0) + u) * 1024 + 65536); \
            acc = __builtin_amdgcn_mfma_f32_32x32x16_bf16(ah, bh, acc, 0, 0, 0); acc = __builtin_amdgcn_mfma_f32_32x32x16_bf16(ah, bl, acc, 0, 0, 0); } } while (0)
        RT_LD(xa, 0);
#pragma unroll 1
        for (int s0 = 0; s0 < 32; s0 += 16) { RT_LD(xb, s0 + 8); RT_DO(xa, s0); if (s0 + 16 < 32) RT_LD(xa, s0 + 16); RT_DO(xb, s0 + 8); }
#undef RT_LD
#undef RT_DO
        sq[(grp * 32 + r) * 4 + kh * 2 + hi] = ssq;
        if (kh == 1) { LAS float* c = cx + (grp * 64 + lane) * 16;
#pragma unroll
            for (int i = 0; i < 4; ++i) *(LAS f32x4*)(c + i * 4) = (f32x4){acc[4 * i], acc[4 * i + 1], acc[4 * i + 2], acc[4 * i + 3]}; }
        __syncthreads();
        if (kh == 0) { const LAS float* c = cx + (grp * 64 + lane) * 16;
#pragma unroll
            for (int i = 0; i < 4; ++i) { const f32x4 p = *(const LAS f32x4*)(c + i * 4); acc[4 * i] += p[0]; acc[4 * i + 1] += p[1]; acc[4 * i + 2] += p[2]; acc[4 * i + 3] += p[3]; } }
        __syncthreads();
        if (kh == 0) {
#pragma unroll
            for (int i = 0; i < 16; ++i) cx[(grp * 32 + (i & 3) + 8 * (i >> 2) + 4 * hi) * 32 + r] = acc[i]; }
        __syncthreads();
    }
    float* gate = (float*)(F.ws + WS_GATE);
    LAS int* asg_e = (LAS int*)(F.lds + 155648); LAS int* asg_r = asg_e + 512; LAS int* basel = asg_r + 512;
    if (F.tid < 128) {
        const int row = tok0 + F.tid; const f32x4 q4 = *(const LAS f32x4*)(sq + F.tid * 4);
        const float rs = rsqrtf(((q4[0] + q4[1]) + (q4[2] + q4[3])) * (1.0f / D) + EPS); sq[512 + F.tid] = rs;
        const float* bias = (const float*)(F.ws + WS_RBIAS) + (l * NB + b) * NE;
        float lg[NE];
#pragma unroll
        for (int i = 0; i < 8; ++i) { const f32x4 c = *(const LAS f32x4*)(cx + F.tid * 32 + i * 4), bb = *(const f32x4*)(bias + i * 4);
            lg[4 * i] = c[0] * rs + bb[0]; lg[4 * i + 1] = c[1] * rs + bb[1]; lg[4 * i + 2] = c[2] * rs + bb[2]; lg[4 * i + 3] = c[3] * rs + bb[3]; }
        float tv[4]; int ti[4];
#pragma unroll
        for (int k = 0; k < 4; ++k) { float bv = lg[0]; int bi = 0;
#pragma unroll
            for (int e2 = 1; e2 < NE; ++e2) { if (lg[e2] > bv) { bv = lg[e2]; bi = e2; } }
            tv[k] = bv; ti[k] = bi;
#pragma unroll
            for (int e2 = 0; e2 < NE; ++e2) lg[e2] = (e2 == bi) ? -__builtin_inff() : lg[e2]; }
        const float e1 = __expf(tv[1] - tv[0]), e2 = __expf(tv[2] - tv[0]), e3 = __expf(tv[3] - tv[0]), inv = 1.0f / (1.0f + e1 + e2 + e3);
        *(f32x4*)(gate + (size_t)row * 4) = (f32x4){inv, e1 * inv, e2 * inv, e3 * inv};
        int4 tq, rq; tq.x = ti[0]; tq.y = ti[1]; tq.z = ti[2]; tq.w = ti[3];
        rq.x = __hip_atomic_fetch_add(&cnt[ti[0]], 1, __ATOMIC_RELAXED, __HIP_MEMORY_SCOPE_WORKGROUP); rq.y = __hip_atomic_fetch_add(&cnt[ti[1]], 1, __ATOMIC_RELAXED, __HIP_MEMORY_SCOPE_WORKGROUP);
        rq.z = __hip_atomic_fetch_add(&cnt[ti[2]], 1, __ATOMIC_RELAXED, __HIP_MEMORY_SCOPE_WORKGROUP); rq.w = __hip_atomic_fetch_add(&cnt[ti[3]], 1, __ATOMIC_RELAXED, __HIP_MEMORY_SCOPE_WORKGROUP);
        asg_e[F.tid * 4] = tq.x; asg_e[F.tid * 4 + 1] = tq.y; asg_e[F.tid * 4 + 2] = tq.z; asg_e[F.tid * 4 + 3] = tq.w;
        asg_r[F.tid * 4] = rq.x; asg_r[F.tid * 4 + 1] = rq.y; asg_r[F.tid * 4 + 2] = rq.z; asg_r[F.tid * 4 + 3] = rq.w;
    }
    __syncthreads();
    if (F.tid < NE) basel[F.tid] = (int)__hip_atomic_fetch_add((unsigned*)(F.ws + WS_MOETOT) + l * NE + F.tid, (unsigned)cnt[F.tid], __ATOMIC_RELAXED, __HIP_MEMORY_SCOPE_AGENT);
    __syncthreads();
    { int* slotp = (int*)(F.ws + WS_SLOT); int* rowtab2 = (int*)(F.ws + WS_ROWTAB2);
      for (int it = F.tid; it < ntok_blk * 4 * 8; it += NTHR) { const int a = it >> 3, c8 = it & 7, e = asg_e[a], gr = basel[e] + asg_r[a];
          if (c8 == 0) slotp[(size_t)tok0 * 4 + a] = e * 32768 + gr;
          const int blk = gr >> 8, r = gr & 255, hh = r >> 7, R = r & 127, bb = pg8::lds_byte(R, c8 * 8), pi = bb >> 13, lt = (bb & 8191) >> 4;
          rowtab2[((((size_t)e * 128 + blk) * 512 + lt) * 2 + hh) * 2 + pi] = tok0 + (a >> 2); } }
    { const float* g = GPTR(const float, A.in[I_N2G]) + l * D; f32x4 gv[4], sh[4], sc[4];
      row_ld16(g, F.lane, gv); row_ld16(modp(F, l, b, 3), F.lane, sh); row_ld16(modp(F, l, b, 4), F.lane, sc);
#pragma unroll
      for (int i = 0; i < 4; ++i) gv[i] = gv[i] * (sc[i] + 1.0f);
      for (int it = F.wave; it < ntok_blk; it += 2 * NWAVE) { const bool two = it + NWAVE < ntok_blk;
          u32x2 w0[4], w1[4];
#pragma unroll
          for (int i = 0; i < 4; ++i) { w0[i] = *(const u32x2*)(X + (size_t)(tok0 + it) * D + i * 256 + F.lane * 4); if (two) w1[i] = *(const u32x2*)(X + (size_t)(tok0 + it + NWAVE) * D + i * 256 + F.lane * 4); }
          const float r0 = sq[512 + it], r1 = two ? sq[512 + it + NWAVE] : 0.f;
          f32x4 v0[4], v1[4];
#pragma unroll
          for (int i = 0; i < 4; ++i) v0[i] = (f32x4){bflo(w0[i].x), bfhi(w0[i].x), bflo(w0[i].y), bfhi(w0[i].y)} * r0 * gv[i] + sh[i];
          row_st16_bf16(HA + (size_t)(tok0 + it) * D, F.lane, v0);
          if (two) {
#pragma unroll
              for (int i = 0; i < 4; ++i) v1[i] = (f32x4){bflo(w1[i].x), bfhi(w1[i].x), bflo(w1[i].y), bfhi(w1[i].y)} * r1 * gv[i] + sh[i];
              row_st16_bf16(HA + (size_t)(tok0 + it + NWAVE) * D, F.lane, v1); } } }
    __syncthreads();
}

__device__ __forceinline__ void ph_combine(const Frame& F, int l, const LAS int* fbk) {
    const Args& A = *F.a; const bf16_t* X = (const bf16_t*)(F.ws + WS_X); bf16_t* XO = (bf16_t*)(F.ws + WS_X2); const bf16_t* Y = (const bf16_t*)(F.ws + WS_XG);
    const int* slot = (const int*)(F.ws + WS_SLOT); const float* gate = (const float*)(F.ws + WS_GATE);

    const int stride = F.G * NWAVE; int row = F.blk * NWAVE + F.wave;
    if (row >= NTOK) return;
    int4 sq_c = *(const int4*)(slot + (size_t)row * 4); f32x4 gq_c = *(const f32x4*)(gate + (size_t)row * 4);
    int4 sq_n = sq_c; f32x4 gq_n = gq_c;
    if (row + stride < NTOK) { sq_n = *(const int4*)(slot + (size_t)(row + stride) * 4); gq_n = *(const f32x4*)(gate + (size_t)(row + stride) * 4); }
    u32x4 yc[4][2], yn[4][2]; f32x4 xc[4], xn[4];
#define CMB_LOAD(yv, xq, sq, r_) do { const int ss_[4] = {fbk[sq.x >> 15] * EBLK + (sq.x & 32767), fbk[sq.y >> 15] * EBLK + (sq.y & 32767), fbk[sq.z >> 15] * EBLK + (sq.z & 32767), fbk[sq.w >> 15] * EBLK + (sq.w & 32767)}; \
        _Pragma("unroll") for (int k = 0; k < 4; ++k) _Pragma("unroll") for (int i = 0; i < 2; ++i) yv[k][i] = *(const u32x4*)(Y + (size_t)ss_[k] * D + i * 512 + F.lane * 8); \
        _Pragma("unroll") for (int i = 0; i < 2; ++i) { const u32x4 xw_ = *(const u32x4*)(X + (size_t)(r_) * D + i * 512 + F.lane * 8); \
            xq[i * 2] = (f32x4){bflo(xw_.x), bfhi(xw_.x), bflo(xw_.y), bfhi(xw_.y)}; xq[i * 2 + 1] = (f32x4){bflo(xw_.z), bfhi(xw_.z), bflo(xw_.w), bfhi(xw_.w)}; } } while (0)
    CMB_LOAD(yc, xc, sq_c, row);
    for (; row < NTOK; row += stride) {
        const int b = row / SEQ; const bool has_n = row + stride < NTOK;
        const f32x4 gq = gq_c;
        if (has_n) CMB_LOAD(yn, xn, sq_n, row + stride);
        int4 sq_nn = sq_n; f32x4 gq_nn = gq_n;
        if (row + 2 * stride < NTOK) { sq_nn = *(const int4*)(slot + (size_t)(row + 2 * stride) * 4); gq_nn = *(const f32x4*)(gate + (size_t)(row + 2 * stride) * 4); }
        float acc[16];
#pragma unroll
        for (int i = 0; i < 16; ++i) acc[i] = 0.f;
#pragma unroll
        for (int k = 0; k < 4; ++k) { const float gk = gq[k];
#pragma unroll
            for (int i = 0; i < 2; ++i) { const u32x4 w = yc[k][i];
                acc[i * 8 + 0] += gk * bflo(w.x); acc[i * 8 + 1] += gk * bfhi(w.x); acc[i * 8 + 2] += gk * bflo(w.y); acc[i * 8 + 3] += gk * bfhi(w.y);
                acc[i * 8 + 4] += gk * bflo(w.z); acc[i * 8 + 5] += gk * bfhi(w.z); acc[i * 8 + 6] += gk * bflo(w.w); acc[i * 8 + 7] += gk * bfhi(w.w); } }
        const float* g2 = modp(F, l, b, 5);
        float xv[16]; float ssq = 0.f;
#pragma unroll
        for (int i = 0; i < 2; ++i)
#pragma unroll
            for (int h = 0; h < 2; ++h) { const int c = i * 512 + F.lane * 8 + h * 4; const f32x4 x0 = xc[i * 2 + h], gg = *(const f32x4*)(g2 + c);
#pragma unroll
                for (int j = 0; j < 4; ++j) { const float x = x0[j] + gg[j] * acc[i * 8 + h * 4 + j]; xv[i * 8 + h * 4 + j] = x; ssq += x * x; } }
        ssq = wave_sum(ssq); const float rs = rsqrtf(ssq * (1.0f / D) + EPS);
        if (l == 0) {
            bf16_t* HB = (bf16_t*)(F.ws + WS_HB); bf16_t* HA = (bf16_t*)(F.ws + WS_HA);
            const float* kvg = GPTR(const float, A.in[I_KVG]); const float* g1 = GPTR(const float, A.in[I_N1G]) + D; const float* sh = modp(F, 1, b, 0); const float* sc = modp(F, 1, b, 1);
#pragma unroll
            for (int i = 0; i < 2; ++i) { const int c = i * 512 + F.lane * 8; float o1[8], o2[8];
#pragma unroll
                for (int h = 0; h < 2; ++h) { const f32x4 kg = *(const f32x4*)(kvg + c + h * 4), gg = *(const f32x4*)(g1 + c + h * 4), s1 = *(const f32x4*)(sh + c + h * 4), s2 = *(const f32x4*)(sc + c + h * 4);
#pragma unroll
                    for (int j = 0; j < 4; ++j) { const float xh = xv[i * 8 + h * 4 + j] * rs; o1[h * 4 + j] = xh * kg[j]; o2[h * 4 + j] = xh * gg[j] * (s2[j] + 1.0f) + s1[j]; } }
                u32x4 w1, w2; w1.x = cvt_pk_bf16(o1[0], o1[1]); w1.y = cvt_pk_bf16(o1[2], o1[3]); w1.z = cvt_pk_bf16(o1[4], o1[5]); w1.w = cvt_pk_bf16(o1[6], o1[7]);
                w2.x = cvt_pk_bf16(o2[0], o2[1]); w2.y = cvt_pk_bf16(o2[2], o2[3]); w2.z = cvt_pk_bf16(o2[4], o2[5]); w2.w = cvt_pk_bf16(o2[6], o2[7]);
                u32x4 w0; w0.x = cvt_pk_bf16(xv[i * 8], xv[i * 8 + 1]); w0.y = cvt_pk_bf16(xv[i * 8 + 2], xv[i * 8 + 3]); w0.z = cvt_pk_bf16(xv[i * 8 + 4], xv[i * 8 + 5]); w0.w = cvt_pk_bf16(xv[i * 8 + 6], xv[i * 8 + 7]);
                *(u32x4*)(XO + (size_t)row * D + c) = w0; *(u32x4*)(HB + (size_t)row * D + c) = w1; *(u32x4*)(HA + (size_t)row * D + c) = w2; }
        } else {
            const float* fg = GPTR(const float, A.in[I_FG]);
#pragma unroll
            for (int i = 0; i < 2; ++i)
#pragma unroll
                for (int h = 0; h < 2; ++h) { const int c = i * 512 + F.lane * 8 + h * 4; const f32x4 gg = *(const f32x4*)(fg + c);
                    *(f32x4*)(GPTR(float, A.out) + (size_t)row * D + c) = (f32x4){xv[i * 8 + h * 4] * rs * gg[0], xv[i * 8 + h * 4 + 1] * rs * gg[1], xv[i * 8 + h * 4 + 2] * rs * gg[2], xv[i * 8 + h * 4 + 3] * rs * gg[3]}; }
        }
#pragma unroll
        for (int k = 0; k < 4; ++k) { yc[k][0] = yn[k][0]; yc[k][1] = yn[k][1]; xc[k] = xn[k]; }
        sq_c = sq_n; gq_c = gq_n; sq_n = sq_nn; gq_n = gq_nn;
    }
#undef CMB_LOAD
}

__device__ __forceinline__ void ph_latpost(const Frame& F) {
    const Args& A = *F.a; const float* LAT = (const float*)(F.ws + WS_LAT); const float* CQP = (const float*)(F.ws + WS_CQP);
    bf16_t* CKV = (bf16_t*)(F.ws + WS_CKV); bf16_t* KR = (bf16_t*)(F.ws + WS_KR); bf16_t* CQ = (bf16_t*)(F.ws + WS_CQ); const f32x2* cs = (const f32x2*)(F.ws + WS_CS);
    for (int row = F.blk * NWAVE + F.wave; row < NTOK; row += F.G * NWAVE) {
        const float* lr = LAT + (size_t)row * 512;
        { const f32x4 v = *(const f32x4*)(lr + F.lane * 4), g = *(const f32x4*)(GPTR(const float, A.in[I_CKVG]) + F.lane * 4);
          float s = wave_sum(v[0] * v[0] + v[1] * v[1] + v[2] * v[2] + v[3] * v[3]); const float rs = rsqrtf(s * (1.0f / KVLORA) + EPS);
          u32x2 w; w.x = cvt_pk_bf16(v[0] * rs * g[0], v[1] * rs * g[1]); w.y = cvt_pk_bf16(v[2] * rs * g[2], v[3] * rs * g[3]); *(u32x2*)(CKV + (size_t)row * KVLORA + F.lane * 4) = w; }
        if (F.lane < 32) { const int i = F.lane; const float x1 = lr[KVLORA + i], x2 = lr[KVLORA + 32 + i]; const f32x2 t = cs[(size_t)row * 32 + i];
          const float r1 = x1 * t[0] - x2 * t[1], r2 = x2 * t[0] + x1 * t[1]; const int p = (i >> 2) * 8 + (i & 3);
          KR[(size_t)row * DROPE + p] = (bf16_t)(cvt_pk_bf16(r1, r1) & 0xffffu); KR[(size_t)row * DROPE + p + 4] = (bf16_t)(cvt_pk_bf16(r2, r2) & 0xffffu); }
        { const float* qr = CQP + (size_t)row * 512; f32x2 v[3]; float s = 0.f;
#pragma unroll
          for (int i = 0; i < 3; ++i) { v[i] = *(const f32x2*)(qr + i * 128 + F.lane * 2); s += v[i][0] * v[i][0] + v[i][1] * v[i][1]; }
          s = wave_sum(s); const float rs = rsqrtf(s * (1.0f / QLORA) + EPS);
#pragma unroll
          for (int i = 0; i < 3; ++i) { const f32x2 g = *(const f32x2*)(GPTR(const float, A.in[I_CQG]) + i * 128 + F.lane * 2);
              *(unsigned*)(CQ + (size_t)row * QLORA + i * 128 + F.lane * 2) = cvt_pk_bf16(v[i][0] * rs * g[0], v[i][1] * rs * g[1]); } }
    }
}
constexpr int AT_KB = 24576, AT_VB0 = 49152, AT_VB = 16384;
#define AT_UPTR(p) ({ const GAS char* p_ = (const GAS char*)(p); asm volatile("" : "+s"(p_)); p_; })
#define AT_BAR() do { asm volatile("s_waitcnt lgkmcnt(0)" ::: "memory"); __builtin_amdgcn_s_barrier(); asm volatile("" ::: "memory"); } while (0)
#define AT_SB() __builtin_amdgcn_sched_barrier(0x6)
__device__ __forceinline__ void at_glds16(unsigned voff, const GAS char* sbase, unsigned lds_dst) {
    unsigned keep;
    asm volatile("s_mov_b32 %0, m0\n\ts_mov_b32 m0, %3\n\ts_nop 0\n\tglobal_load_lds_dwordx4 %1, %2\n\ts_mov_b32 m0, %0" : "=&s"(keep) : "v"(voff), "s"(sbase), "s"(lds_dst) : "memory");
}
#define AT_GLDS(sbase, voff, dstoff) at_glds16((voff), (sbase), ldsb_ + (unsigned)(dstoff))

__device__ __forceinline__ int swap23(int k) { return (k & ~0xC) | ((k & 4) << 1) | ((k & 8) >> 1); }

#if !NAIVE_ATTN
template <int VAR>
__device__ __forceinline__ void ph_attn(const Frame& F) {
    const char* Qg = (const char*)(F.ws + WS_Q); const char* KNg = (const char*)(F.ws + WS_KN); const char* KRg = (const char*)(F.ws + WS_KR); const char* VTg = (const char*)(F.ws + WS_VT);
    bf16_t* Og = (bf16_t*)(F.ws + (VAR == 0 ? WS_HC : WS_HB));
    const int lane = F.lane, w = F.wave, r32 = lane & 31, hi = lane >> 5;
    const unsigned ldsb_ = (unsigned)(size_t)F.lds;
    unsigned offK[3], offVt[2];
#pragma unroll
    for (int i = 0; i < 3; ++i) { const int g = (i * 8 + w) * 64 + lane, d0 = g >> 7, rho = (g & 127) >> 1, hh = (g & 1) ^ ((rho >> 3) & 1), key = swap23(rho);
        offK[i] = d0 < 8 ? (unsigned)key * 2048u + (unsigned)(d0 * 32 + hh * 16) : (unsigned)key * 128u + (unsigned)((d0 - 8) * 32 + hh * 16); }
#pragma unroll
    for (int i = 0; i < 2; ++i) { const int g = (i * 8 + w) * 64 + lane, ks = g >> 8, d = (g & 255) >> 1, hh = (g & 1) ^ ((d >> 3) & 1);
        offVt[i] = (unsigned)d * (unsigned)(NTOK * 2) + (unsigned)(ks * 32 + hh * 16); }
    const int rdoff = r32 * 32 + ((hi ^ ((r32 >> 3) & 1)) << 4);
    for (int item = F.blk; item < 512; item += F.G) {
        const int xcd = item & 7, kk = item >> 3, bh = xcd * 4 + (kk >> 4), x = kk & 15, b = bh >> 3, h = bh & 7;
#pragma unroll 1
        for (int pass = 0; pass < 2; ++pass) {
            const int j = pass ? 31 - x : x, NT = 4 * j + 4, cw = 4 * j + (w >> 1);
            const size_t tokb = (size_t)b * SEQ;
            const char* knb = KNg + tokb * 2048 + h * 256; const char* krb = KRg + tokb * 128; const char* vtb = VTg + ((size_t)h * 128 * NTOK + tokb) * 2;
            bf16x8 qr[12];
            { const GAS char* qp = AT_UPTR(Qg + (tokb + (size_t)j * 256 + w * 32) * (NH * DQK * 2) + h * (DQK * 2)) + (unsigned)(r32 * (NH * DQK * 2) + hi * 16);
#pragma unroll
              for (int d0 = 0; d0 < 12; ++d0) qr[d0] = *(const bf16x8*)(qp + d0 * 32);
              const float* csr = (const float*)(AT_UPTR((const float*)(F.ws + WS_CS) + (tokb + (size_t)j * 256 + w * 32) * 64) + (unsigned)(r32 * 256));
#pragma unroll
              for (int dd = 0; dd < 4; ++dd) { const int k4 = (dd * 2 + hi) * 4; const f32x4 t0 = *(const f32x4*)(csr + 2 * k4), t1 = *(const f32x4*)(csr + 2 * k4 + 4);
                  const u32x4 wq = *(const u32x4*)&qr[8 + dd];
                  const float x1[4] = {bflo(wq.x), bfhi(wq.x), bflo(wq.y), bfhi(wq.y)}, x2[4] = {bflo(wq.z), bfhi(wq.z), bflo(wq.w), bfhi(wq.w)};
                  const float co[4] = {t0[0], t0[2], t1[0], t1[2]}, si[4] = {t0[1], t0[3], t1[1], t1[3]}; float r1[4], r2[4];
#pragma unroll
                  for (int jj = 0; jj < 4; ++jj) { r1[jj] = x1[jj] * co[jj] - x2[jj] * si[jj]; r2[jj] = x2[jj] * co[jj] + x1[jj] * si[jj]; }
                  u32x4 wo = {cvt_pk_bf16(r1[0], r1[1]), cvt_pk_bf16(r1[2], r1[3]), cvt_pk_bf16(r2[0], r2[1]), cvt_pk_bf16(r2[2], r2[3])}; qr[8 + dd] = *(bf16x8*)&wo; } }
            f32x16 o[4];
#pragma unroll
            for (int d0 = 0; d0 < 4; ++d0)
#pragma unroll
                for (int r = 0; r < 16; ++r) o[d0][r] = 0.f;
            float m_run = -1e30f, l_run = 0.f;
#define AT_ISSUE_K(t, st) do { const int t_ = (t); \
                const GAS char* kp_ = AT_UPTR(knb + (size_t)t_ * (64 * 2048)); const GAS char* rp_ = AT_UPTR(krb + (size_t)t_ * (64 * 128)); \
                AT_GLDS(kp_, offK[0], (st) + w * 1024); AT_GLDS(kp_, offK[1], (st) + (8 + w) * 1024); \
                AT_GLDS(rp_, offK[2], (st) + (16 + w) * 1024); } while (0)
#define AT_ISSUE_V(t, st) do { const int t_ = (t); \
                const GAS char* vp_ = AT_UPTR(vtb + (size_t)t_ * 128); \
                AT_GLDS(vp_, offVt[0], AT_VB0 + (st) + w * 1024); AT_GLDS(vp_, offVt[1], AT_VB0 + (st) + (8 + w) * 1024); } while (0)
#define AT_DSRD(dst, ad, off) asm volatile("ds_read_b128 %0, %1 offset:%2" : "=v"(dst) : "v"(ad), "i"(off))
#define AT_LGKM(n) asm volatile("s_waitcnt lgkmcnt(%0)" :: "i"(n))
#define AT_SB0() __builtin_amdgcn_sched_barrier(0)
#define AT_KR(d_, x0, x1) do { AT_DSRD(x0, kad_, (d_) * 2048); AT_DSRD(x1, kad_, (d_) * 2048 + 1024); } while (0)
#define AT_MM(x0, x1, q_, PN0, PN1) do { AT_SB0(); __builtin_amdgcn_s_setprio(1); PN0 = __builtin_amdgcn_mfma_f32_32x32x16_bf16(x0, q_, PN0, 0, 0, 0); PN1 = __builtin_amdgcn_mfma_f32_32x32x16_bf16(x1, q_, PN1, 0, 0, 0); __builtin_amdgcn_s_setprio(0); AT_SB0(); } while (0)
#define AT_E1(PC0, PC1, e_) do { if ((e_) < 16) { PC0[(e_) & 15] = __builtin_amdgcn_exp2f(PC0[(e_) & 15] - m_run); ps_ += PC0[(e_) & 15]; } else if ((e_) < 32) { PC1[(e_) & 15] = __builtin_amdgcn_exp2f(PC1[(e_) & 15] - m_run); ps_ += PC1[(e_) & 15]; } } while (0)
#define AT_EX(PC0, PC1, i_) do { if (SM) { AT_E1(PC0, PC1, 3 * (i_)); AT_E1(PC0, PC1, 3 * (i_) + 1); AT_E1(PC0, PC1, 3 * (i_) + 2); } } while (0)
#define AT_QKX(st, P0, P1) do { \
                const unsigned kad_ = (unsigned)(size_t)((const LAS char*)F.lds + (st) + rdoff); \
                bf16x8 ka0, ka1, kb0, kb1, kc0, kc1; \
                AT_KR(0, ka0, ka1); AT_KR(1, kb0, kb1); \
                _Pragma("unroll") for (int r = 0; r < 16; ++r) { P0[r] = 0.f; P1[r] = 0.f; } \
                AT_KR(2, kc0, kc1); AT_LGKM(4); AT_MM(ka0, ka1, qr[0], P0, P1); \
                AT_KR(3, ka0, ka1); AT_LGKM(4); AT_MM(kb0, kb1, qr[1], P0, P1); \
                AT_KR(4, kb0, kb1); AT_LGKM(4); AT_MM(kc0, kc1, qr[2], P0, P1); \
                AT_KR(5, kc0, kc1); AT_LGKM(4); AT_MM(ka0, ka1, qr[3], P0, P1); \
                AT_KR(6, ka0, ka1); AT_LGKM(4); AT_MM(kb0, kb1, qr[4], P0, P1); \
                AT_KR(7, kb0, kb1); AT_LGKM(4); AT_MM(kc0, kc1, qr[5], P0, P1); \
                AT_KR(8, kc0, kc1); AT_LGKM(4); AT_MM(ka0, ka1, qr[6], P0, P1); \
                AT_KR(9, ka0, ka1); AT_LGKM(4); AT_MM(kb0, kb1, qr[7], P0, P1); \
                AT_KR(10, kb0, kb1); AT_LGKM(4); AT_MM(kc0, kc1, qr[8], P0, P1); \
                AT_KR(11, kc0, kc1); AT_LGKM(4); AT_MM(ka0, ka1, qr[9], P0, P1); \
                AT_LGKM(2); AT_MM(kb0, kb1, qr[10], P0, P1); \
                AT_LGKM(0); AT_MM(kc0, kc1, qr[11], P0, P1); } while (0)
#define AT_VR(ks_, v0, v1, v2, v3) do { AT_DSRD(v0, vad_, (ks_) * 4096); AT_DSRD(v1, vad_, (ks_) * 4096 + 1024); AT_DSRD(v2, vad_, (ks_) * 4096 + 2048); AT_DSRD(v3, vad_, (ks_) * 4096 + 3072); } while (0)
#define AT_PF(PX, b8) ({ u32x4 tp_ = {cvt_pk_bf16(PX[b8], PX[b8 + 1]), cvt_pk_bf16(PX[b8 + 2], PX[b8 + 3]), cvt_pk_bf16(PX[b8 + 4], PX[b8 + 5]), cvt_pk_bf16(PX[b8 + 6], PX[b8 + 7])}; *(bf16x8*)&tp_; })
#define AT_M4(pf_, v0, v1, v2, v3) do { AT_SB0(); __builtin_amdgcn_s_setprio(1); o[0] = __builtin_amdgcn_mfma_f32_32x32x16_bf16(v0, pf_, o[0], 0, 0, 0); o[1] = __builtin_amdgcn_mfma_f32_32x32x16_bf16(v1, pf_, o[1], 0, 0, 0); \
                o[2] = __builtin_amdgcn_mfma_f32_32x32x16_bf16(v2, pf_, o[2], 0, 0, 0); o[3] = __builtin_amdgcn_mfma_f32_32x32x16_bf16(v3, pf_, o[3], 0, 0, 0); __builtin_amdgcn_s_setprio(0); AT_SB0(); } while (0)
#define AT_MX8(PX, b8) do { _Pragma("unroll") for (int r = 0; r < 8; ++r) mxn_ = fmaxf(mxn_, PX[(b8) + r]); } while (0)
#define AT_PVX(st, PC0, PC1) do { const unsigned vad_ = (unsigned)(size_t)((const LAS char*)F.lds + AT_VB0 + (st) + rdoff); \
                bf16x8 va0, va1, va2, va3, vb0, vb1, vb2, vb3, pf_; \
                AT_VR(0, va0, va1, va2, va3); AT_VR(1, vb0, vb1, vb2, vb3); pf_ = AT_PF(PC0, 0); AT_LGKM(4); AT_M4(pf_, va0, va1, va2, va3); \
                AT_VR(2, va0, va1, va2, va3); pf_ = AT_PF(PC0, 8); AT_LGKM(4); AT_M4(pf_, vb0, vb1, vb2, vb3); \
                AT_VR(3, vb0, vb1, vb2, vb3); pf_ = AT_PF(PC1, 0); AT_LGKM(4); AT_M4(pf_, va0, va1, va2, va3); \
                pf_ = AT_PF(PC1, 8); AT_LGKM(0); AT_M4(pf_, vb0, vb1, vb2, vb3); } while (0)
#define AT_SMAX(P0, P1) do { \
                float mx = P0[0]; _Pragma("unroll") for (int r = 1; r < 16; ++r) mx = fmaxf(mx, P0[r]); _Pragma("unroll") for (int r = 0; r < 16; ++r) mx = fmaxf(mx, P1[r]); \
                mx = fmaxf(mx, __shfl_xor(mx, 32)); \
                if (!__all(mx - m_run <= 11.0f)) { const float mn = fmaxf(m_run, mx), al = __builtin_amdgcn_exp2f(m_run - mn); m_run = mn; l_run *= al; \
                    _Pragma("unroll") for (int d0 = 0; d0 < 4; ++d0) _Pragma("unroll") for (int r = 0; r < 16; ++r) o[d0][r] *= al; } } while (0)
#define AT_SEXP(P0, P1) do { \
                float ps = 0.f; \
                _Pragma("unroll") for (int r = 0; r < 16; ++r) { P0[r] = __builtin_amdgcn_exp2f(P0[r] - m_run); P1[r] = __builtin_amdgcn_exp2f(P1[r] - m_run); ps += P0[r] + P1[r]; } \
                l_run += ps; } while (0)
#define AT_STEP(t, st) do { \
                if (VAR != 1 && VAR != 6 && VAR != 7 && (t) + 1 < NT) { AT_ISSUE_K((t) + 1, (1 - (st)) * AT_KB); AT_ISSUE_V((t) + 1, (1 - (st)) * AT_VB); } \
                if (VAR != 2 && (t) <= cw) { f32x16 p0, p1; if (VAR != 5 && VAR != 7) AT_QKX((st) * AT_KB, p0, p1); else { _Pragma("unroll") for (int r = 0; r < 16; ++r) { p0[r] = m_run; p1[r] = l_run; } } \
                    if (VAR == 0 || VAR == 1) { AT_SMAX(p0, p1); AT_SEXP(p0, p1); } if (VAR != 4 && VAR != 6) AT_PVX((st) * AT_VB, p0, p1); else { m_run += p0[3] + p1[5]; } } \
                asm volatile("s_waitcnt vmcnt(0)" ::: "memory"); AT_BAR(); } while (0)
            AT_ISSUE_K(0, 0); AT_ISSUE_V(0, 0);
            asm volatile("s_waitcnt vmcnt(0)" ::: "memory"); AT_BAR();
#pragma unroll 1
            for (int t = 0; t < NT; t += 2) {
                AT_STEP(t, 0);
                AT_STEP(t + 1, 1);
            }
#undef AT_ISSUE_K
#undef AT_ISSUE_V
#undef AT_STEP
            const float lt = l_run + __shfl_xor(l_run, 32), inv = 1.0f / lt;
            bf16_t* op = (bf16_t*)(AT_UPTR(Og + (tokb + (size_t)j * 256 + w * 32) * D + h * DV) + (unsigned)(r32 * (D * 2) + 8 * hi));
#pragma unroll
            for (int d0 = 0; d0 < 4; ++d0)
#pragma unroll
                for (int g4 = 0; g4 < 4; ++g4) { u32x2 wv; wv.x = cvt_pk_bf16(o[d0][4 * g4] * inv, o[d0][4 * g4 + 1] * inv); wv.y = cvt_pk_bf16(o[d0][4 * g4 + 2] * inv, o[d0][4 * g4 + 3] * inv);
                    *(u32x2*)(op + d0 * 32 + 8 * g4) = wv; }
        }
    }
}
#else
template <int VAR>
__device__ __forceinline__ void ph_attn(const Frame& F) {
    const bf16_t* Qg = (const bf16_t*)(F.ws + WS_Q); const bf16_t* KNg = (const bf16_t*)(F.ws + WS_KN); const bf16_t* KRg = (const bf16_t*)(F.ws + WS_KR); const bf16_t* VTg = (const bf16_t*)(F.ws + WS_VT);
    bf16_t* Og = (bf16_t*)(F.ws + WS_HC);
    for (int it = F.blk * NWAVE + F.wave; it < NTOK * NH; it += F.G * NWAVE) {
        const int n = it >> 3, h = it & 7, b = n / SEQ, s = n - b * SEQ, nkb = s / 64 + 1; const size_t tokb = (size_t)b * SEQ;
        const bf16_t* q = Qg + (size_t)n * (NH * DQK) + h * DQK;
        float m = -1e30f, l = 0.f, o0 = 0.f, o1 = 0.f;
        for (int kb = 0; kb < nkb; ++kb) {
            const size_t key = tokb + kb * 64 + F.lane; float sc = 0.f;
            for (int d = 0; d < DNOPE; d += 8) { const u32x4 kv = *(const u32x4*)(KNg + key * D + h * DNOPE + d), qv = *(const u32x4*)(q + d);
                sc += bflo(kv.x) * bflo(qv.x) + bfhi(kv.x) * bfhi(qv.x) + bflo(kv.y) * bflo(qv.y) + bfhi(kv.y) * bfhi(qv.y) + bflo(kv.z) * bflo(qv.z) + bfhi(kv.z) * bfhi(qv.z) + bflo(kv.w) * bflo(qv.w) + bfhi(kv.w) * bfhi(qv.w); }
            for (int d = 0; d < DROPE; d += 8) { const u32x4 kv = *(const u32x4*)(KRg + key * DROPE + d), qv = *(const u32x4*)(q + DNOPE + d);
                sc += bflo(kv.x) * bflo(qv.x) + bfhi(kv.x) * bfhi(qv.x) + bflo(kv.y) * bflo(qv.y) + bfhi(kv.y) * bfhi(qv.y) + bflo(kv.z) * bflo(qv.z) + bfhi(kv.z) * bfhi(qv.z) + bflo(kv.w) * bflo(qv.w) + bfhi(kv.w) * bfhi(qv.w); }
            float mx = sc;
#pragma unroll
            for (int of = 32; of >= 1; of >>= 1) mx = fmaxf(mx, __shfl_xor(mx, of));
            const float mn = fmaxf(m, mx), al = exp2f(m - mn), p = exp2f(sc - mn); m = mn;
            l = l * al + wave_sum(p); o0 *= al; o1 *= al;
            for (int d = 0; d < DV; ++d) { const float v = bf2f(VTg[(size_t)(h * DV + d) * NTOK + key]); const float tot = wave_sum(p * v);
                if (F.lane == (d & 63)) { if (d < 64) o0 += tot; else o1 += tot; } }
        }
        const float inv = 1.0f / l;
        Og[(size_t)n * D + h * DV + F.lane] = (bf16_t)(cvt_pk_bf16(o0 * inv, 0.f) & 0xffffu);
        Og[(size_t)n * D + h * DV + 64 + F.lane] = (bf16_t)(cvt_pk_bf16(o1 * inv, 0.f) & 0xffffu);
    }
}
#endif
constexpr int NPH = 20;
__global__ void __launch_bounds__(NTHR, 2) yoco_fwd(Args args) {
    extern __shared__ __attribute__((aligned(16))) unsigned char lds_raw[];
    Frame F; F.lds = (LAS unsigned char*)lds_raw; F.ws = (GAS unsigned char*)args.ws; F.a = &args;
    F.tid = threadIdx.x; F.lane = F.tid & 63; F.wave = __builtin_amdgcn_readfirstlane(F.tid >> 6); F.G = gridDim.x; F.blk = blockIdx.x;
    volatile LAS unsigned* misc = (volatile LAS unsigned*)(F.lds + LDS_MISC);
    if (F.tid < 16) misc[F.tid] = 0u;
    __syncthreads();
    const int lo = args.ph_lo, hi = args.ph_hi;
    XcdBarrier bar; bar.bar = (unsigned*)(F.ws + WS_CTL); bar.x = 0; bar.st = misc;
    if (hi - lo > 1) bar = xcd_barrier_post((unsigned*)(F.ws + WS_CTL), misc);
#ifndef PH_MASK
#define PH_MASK 0xFFFFFu
#endif
#define IN(k) (((PH_MASK >> ((k) % 20 >= 15 ? (k) - 10 : (k))) & 1u) && lo <= (k) && (k) < hi)
#define FRESH() do { F.tid = threadIdx.x; asm volatile("" : "+v"(F.tid)); F.lane = F.tid & 63; F.wave = __builtin_amdgcn_readfirstlane(F.tid >> 6); F.ws = (GAS unsigned char*)args.ws; asm volatile("" : "+s"(F.ws)); } while (0)
#ifndef REPEAT_MASK
#define REPEAT_MASK 0u
#endif
#define PHBIT(k) ((k) >= 15 ? (k) - 10 : (k))
#define REPEAT(k) _Pragma("unroll 1") for (int rep_ = 0, nrep_ = ((REPEAT_MASK >> PHBIT(k)) & 1u) ? 2 : 1; rep_ < nrep_; ++rep_, (void)((rep_ < nrep_) ? (xcd_barrier(bar), 0) : 0))
#define SEAM(k) do { if (IN(k) && IN((k) + 1)) xcd_barrier(bar); } while (0)
    LAS unsigned char* stage = F.lds;
#define MOD ((const float*)(F.ws + WS_MOD))

    if (IN(0)) REPEAT(0) { FRESH(); ph_prologue(F); } SEAM(0);
    if (IN(1)) REPEAT(1) { FRESH(); ph_norm1(F); ph_router_prep(F); } SEAM(1);
    if (IN(2)) REPEAT(2) { FRESH();
        pg8::Gemm g{(const bf16_t*)(F.ws + WS_HA), (const bf16_t*)(F.ws + WS_WPW1), NTOK, 2 * D, D}; pg8::StaticOrder S; S.init(NTOK, 2 * D, F.G, F.blk);
        pg8::EpiGated<0> E{(bf16_t*)(F.ws + WS_HB), D, GPTR(const float, args.in[I_PW1B]), D, nullptr};
        GEMM_PHASE<pg8::EpiGated<0>, pg8::StaticOrder>(stage, g, S, E);
    } SEAM(2);
    if (IN(3)) REPEAT(3) { FRESH(); ph_conv(F); } SEAM(3);
    if (IN(4)) REPEAT(4) { FRESH();
        pg8::Gemm g{(const bf16_t*)(F.ws + WS_HC), (const bf16_t*)(F.ws + WS_WPW2), NTOK, D, D}; pg8::StaticOrder S; S.init(NTOK, D, F.G, F.blk);
        pg8::EpiResidB<false> E{GPTR(const float, args.in[I_X]), (bf16_t*)(F.ws + WS_X), GPTR(const float, args.in[I_PW2B]), MOD + 2 * D};
        GEMM_PHASE<pg8::EpiResidB<false>, pg8::StaticOrder>(stage, g, S, E);
    } SEAM(4);
#pragma unroll 1
    for (int l = 0; l < 2; ++l) {
        const int pb = 5 + 10 * l;
        if (IN(pb)) REPEAT(pb) { FRESH(); ph_router(F, l); } do { if (IN(pb) && IN(pb + 2)) xcd_barrier(bar); } while (0);
        LAS int* lbexp = (LAS int*)(F.lds + 131072);
        LAS int* lfb = (LAS int*)(F.lds + 131072 + 2304);
        if (IN(pb + 2)) REPEAT(pb + 2) { FRESH();
            moe_layout(F, l, lbexp, lfb); const int nblk = __builtin_amdgcn_readfirstlane(lbexp[0]);
            pg8::Gemm g{(const bf16_t*)(F.ws + WS_HA), (const bf16_t*)(F.ws + WS_WGU) + (size_t)l * NE * 2 * DE * D, nblk * 256, 2 * DE, D};
            pg8::MoeGatherOrder S; S.init(nblk * 256, 2 * DE, F.G, F.blk); S.bexp = lbexp; S.estride = (size_t)2 * DE * D * 2; S.rowtab = (const unsigned*)(F.ws + WS_ROWTAB2); S.nrows_src = NTOK; S.fblk = lfb;
            pg8::EpiGated<1> E{(bf16_t*)(F.ws + WS_ACT), DE, GPTR(const float, args.in[I_BGU]) + (size_t)l * NE * 2 * DE, DE, lbexp};
            GEMM_PHASE<pg8::EpiGated<1>, pg8::MoeGatherOrder>(stage, g, S, E);
        } SEAM(pb + 2);
        if (IN(pb + 3)) REPEAT(pb + 3) { FRESH();
            if (!IN(pb + 2)) moe_layout(F, l, lbexp, lfb);
            const int nblk = __builtin_amdgcn_readfirstlane(lbexp[0]);
            pg8::Gemm g{(const bf16_t*)(F.ws + WS_ACT), (const bf16_t*)(F.ws + WS_WDN) + (size_t)l * NE * DE * D, nblk * 256, D, DE};
            pg8::MoeOrder S; S.init(nblk * 256, D, F.G, F.blk); S.bexp = lbexp; S.estride = (size_t)DE * D * 2; S.rev = true;
            pg8::EpiBf16P E{(bf16_t*)(F.ws + WS_XG), D, GPTR(const float, args.in[I_BDN]) + (size_t)l * NE * D, D, lbexp};
            GEMM_PHASE<pg8::EpiBf16P, pg8::MoeOrder>(stage, g, S, E);
        } SEAM(pb + 3);
        if (IN(pb + 4)) REPEAT(pb + 4) { FRESH(); if (!IN(pb + 2)) moe_layout(F, l, nullptr, lfb); ph_combine(F, l, lfb); } SEAM(pb + 4);
        if (l == 0) {
            if (IN(10)) REPEAT(10) { FRESH();
#pragma unroll 1
                for (int gi = 0; gi < 2; ++gi) {
                    pg8::Gemm g{(const bf16_t*)(F.ws + (gi ? WS_HA : WS_HB)), (const bf16_t*)(F.ws + (gi ? WS_WDQ : WS_WDKV)), NTOK, 512, D}; pg8::StaticOrder S; S.init(NTOK, 512, F.G, F.blk);
                    pg8::EpiLatQ E{(bf16_t*)(F.ws + (gi ? WS_CQ : WS_CKV)), gi ? QLORA : KVLORA, gi ? QLORA : KVLORA, gi ? (bf16_t*)nullptr : (bf16_t*)(F.ws + WS_KR), (const f32x2*)(F.ws + WS_CS), (float*)(F.ws + (gi ? WS_SSPQ : WS_SSPKV))};
                    GEMM_PHASE<pg8::EpiLatQ, pg8::StaticOrder>(stage, g, S, E);
                    __syncthreads(); }
            } do { if (IN(10) && IN(12)) xcd_barrier(bar); } while (0);
            if (IN(12)) REPEAT(12) { FRESH();
#pragma unroll 1
                for (int gi = 0; gi < 3; ++gi) {
                    pg8::Gemm g{(const bf16_t*)(F.ws + (gi == 0 ? WS_CKV : gi == 1 ? WS_WUV : WS_CQ)), (const bf16_t*)(F.ws + (gi == 0 ? WS_WUK : gi == 1 ? WS_CKV : WS_WUQ)),
                                gi == 1 ? D : NTOK, gi == 0 ? D : gi == 1 ? NTOK : NH * DQK, gi == 2 ? QLORA : KVLORA};
                    pg8::StaticOrder S; S.init(g.M, g.N, F.G, F.blk);
                    pg8::EpiScaled E{(bf16_t*)(F.ws + (gi == 0 ? WS_KN : gi == 1 ? WS_VT : WS_Q)), g.N, (const float*)(F.ws + (gi == 2 ? WS_SSPQ : WS_SSPKV)), gi == 1 ? 1 : 0, gi == 2 ? 8 : 4, gi == 2 ? 1.0f / QLORA : 1.0f / KVLORA};
                    GEMM_PHASE<pg8::EpiScaled, pg8::StaticOrder>(stage, g, S, E);
                    __syncthreads(); }
            } SEAM(12);
            if (IN(13)) REPEAT(13) { FRESH(); ph_attn<0>(F);
#ifdef ATTN_PROBE
                xcd_barrier(bar); FRESH(); ph_attn<ATTN_PROBE>(F);
#endif
            } SEAM(13);
            if (IN(14)) REPEAT(14) { FRESH();
                pg8::Gemm g{(const bf16_t*)(F.ws + WS_HC), (const bf16_t*)(F.ws + WS_WO), NTOK, D, D}; pg8::StaticOrder S; S.init(NTOK, D, F.G, F.blk);
                pg8::EpiResidB<true> E{(const bf16_t*)(F.ws + WS_X2), (bf16_t*)(F.ws + WS_X), nullptr, MOD + (size_t)NB * 6 * D + 2 * D};
                GEMM_PHASE<pg8::EpiResidB<true>, pg8::StaticOrder>(stage, g, S, E);
            } SEAM(14);
        }
    }
#undef IN
#undef SEAM
#undef MOD
#undef FRESH
}

extern "C" void kernel_launch(void* const* d_in, const int* in_sizes, int n_in, void* d_out, int out_size, void* d_ws, size_t ws_size, hipStream_t stream) {
    static int grid = 0;
    if (grid == 0) {
        if (n_in != 31 || out_size != NTOK * D || ws_size < WS_END) { fprintf(stderr, "kernel_launch: unexpected shapes (n_in %d, out %d, ws %zu < %zu)\n", n_in, out_size, ws_size, (size_t)WS_END); grid = -1; return; }
        int dev = 0, cus = 0, per_cu = 0;
        if (hipGetDevice(&dev) != hipSuccess || hipDeviceGetAttribute(&cus, hipDeviceAttributeMultiprocessorCount, dev) != hipSuccess) { grid = -1; return; }
        if (hipFuncSetAttribute((const void*)yoco_fwd, hipFuncAttributeMaxDynamicSharedMemorySize, LDS_BYTES) != hipSuccess) { fprintf(stderr, "kernel_launch: hipFuncSetAttribute failed\n"); grid = -1; return; }
        if (hipOccupancyMaxActiveBlocksPerMultiprocessor(&per_cu, (const void*)yoco_fwd, NTHR, LDS_BYTES) != hipSuccess || per_cu < 1) fprintf(stderr, "kernel_launch: occupancy query says %d\n", per_cu);
        (void)hipGetLastError();
        grid = cus;
        if (grid != 256) fprintf(stderr, "kernel_launch: %d CUs (built for 256)\n", grid);
        if (grid > 256) grid = 256;
    }
    if (grid < 0) return;
    (void)hipMemsetAsync((char*)d_ws + WS_CTL, 0, WS_CTL_BYTES, stream);
    Args a{};
    for (int i = 0; i < 31; ++i) a.in[i] = (const float*)d_in[i];
    a.out = (float*)d_out; a.ws = (unsigned char*)d_ws;
#if N_LAUNCH_MODE == 1
    a.ph_lo = 0; a.ph_hi = NPH;
    hipLaunchKernelGGL(yoco_fwd, dim3(grid), dim3(NTHR), LDS_BYTES, stream, a);
#else
    for (int p = 0; p < NPH; ++p) { a.ph_lo = p; a.ph_hi = p + 1; hipLaunchKernelGGL(yoco_fwd, dim3(grid), dim3(NTHR), LDS_BYTES, stream, a); }
#endif
}
```

```cpp
#include <hip/hip_runtime.h>
#include <cstdio>
#include <cstdint>

#ifndef N_LAUNCH_MODE
#define N_LAUNCH_MODE 1
#endif
#ifndef NAIVE_GEMM
#define NAIVE_GEMM 0
#endif
#ifndef NAIVE_ATTN
#define NAIVE_ATTN 0
#endif

#define LAS __attribute__((address_space(3)))
#define GAS __attribute__((address_space(1)))
__device__ __forceinline__ const void* assume_global_(const void* p) {
#if defined(__HIP_DEVICE_COMPILE__)
    __builtin_assume(!__builtin_amdgcn_is_shared(p) && !__builtin_amdgcn_is_private(p));
#endif
    return p; }
#define GPTR(T, p) ((T*)assume_global_((const void*)(p)))
typedef unsigned short bf16_t;
typedef short bf16x8 __attribute__((ext_vector_type(8)));
typedef float f32x4 __attribute__((ext_vector_type(4)));
typedef float f32x2 __attribute__((ext_vector_type(2)));
typedef float f32x16 __attribute__((ext_vector_type(16)));
typedef unsigned u32x4 __attribute__((ext_vector_type(4)));
typedef unsigned u32x2 __attribute__((ext_vector_type(2)));

constexpr int D = 1024, NB = 4, SEQ = 8192, NTOK = NB * SEQ;
constexpr int CONVW = 31, NH = 8, DNOPE = 128, DROPE = 64, DQK = 192, DV = 128, QLORA = 384, KVLORA = 256;
constexpr int NE = 32, TOPK = 4, DE = 1024, EBLK = 256;
constexpr int NASSIGN = NTOK * TOPK;
constexpr int NROWS = ((NASSIGN + NE * (EBLK - 1) + EBLK - 1) / EBLK) * EBLK;
constexpr int MAXBLK = NROWS / EBLK;
constexpr float EPS = 1e-6f;
constexpr int NTHR = 512, NWAVE = 8;
constexpr int LDS_BYTES = 163840;
constexpr int LDS_MISC = 163328;

constexpr size_t MiB = (size_t)1 << 20;
constexpr size_t WS_CTL = 0;
constexpr size_t WS_MOETOT = 16 * 1024;
constexpr size_t WS_CTL_BYTES = WS_MOETOT + 256;
constexpr size_t WS_BLKCNT = 64 * 1024;
constexpr size_t WS_BEXP = 192 * 1024;
constexpr size_t WS_MOD = 1 * MiB;
constexpr size_t WS_TOPI = 2 * MiB;
constexpr size_t WS_GATE = WS_TOPI + 512 * 1024;
constexpr size_t WS_RANK = WS_GATE + 512 * 1024;
constexpr size_t WS_SLOT = WS_RANK + 512 * 1024;
constexpr size_t WS_CS = 4 * MiB;
constexpr size_t WS_RWF = 12 * MiB;
constexpr size_t WS_RBIAS = 13 * MiB;
constexpr size_t WS_WPW1 = 16 * MiB;
constexpr size_t WS_WPW2 = WS_WPW1 + 4 * MiB;
constexpr size_t WS_WDKV = WS_WPW2 + 2 * MiB;
constexpr size_t WS_WDQ = WS_WDKV + 1 * MiB;
constexpr size_t WS_WUK = WS_WDQ + 1 * MiB;
constexpr size_t WS_WUV = WS_WUK + MiB / 2;
constexpr size_t WS_WUQ = WS_WUV + MiB / 2;
constexpr size_t WS_WO = WS_WUQ + 2 * MiB;
constexpr size_t WS_WGU = 32 * MiB;
constexpr size_t WS_WDN = WS_WGU + 256 * MiB;
constexpr size_t WS_X = WS_WDN + 128 * MiB;
constexpr size_t WS_HA = WS_X + 128 * MiB;
constexpr size_t WS_HB = WS_HA + 64 * MiB;
constexpr size_t WS_HC = WS_HB + 64 * MiB;
constexpr size_t WS_XG = WS_HC + 64 * MiB;
constexpr size_t WS_ACT = WS_XG + 272 * MiB;
constexpr size_t WS_ROWTAB = WS_ACT + 272 * MiB;
constexpr size_t WS_X2 = WS_ROWTAB + 8 * MiB;
constexpr size_t WS_ROWTAB2 = WS_X2 + 64 * MiB;
constexpr size_t WS_END = WS_X2 + 128 * MiB;
constexpr size_t WS_LAT = WS_XG;
constexpr size_t WS_SSPKV = WS_XG;
constexpr size_t WS_SSPQ = WS_XG + 2 * MiB;
constexpr size_t WS_CQP = WS_LAT + 64 * MiB;
constexpr size_t WS_CKV = WS_CQP + 64 * MiB;
constexpr size_t WS_KR = WS_CKV + 16 * MiB;
constexpr size_t WS_CQ = WS_KR + 4 * MiB;
constexpr size_t WS_KN = WS_CQ + 28 * MiB;
constexpr size_t WS_VT = WS_KN + 64 * MiB;
constexpr size_t WS_Q = WS_VT + 64 * MiB;
static_assert(WS_Q + 96 * MiB <= WS_END, "ws map");

struct Args {
    const float* in[31]; float* out; unsigned char* ws; int ph_lo, ph_hi;
};
enum { I_X = 0, I_C, I_POS, I_MODW, I_MODB, I_N1G, I_N2G, I_PW1W, I_PW1B, I_DWW, I_DWB, I_LNG, I_LNB, I_PW2W, I_PW2B, I_KVG, I_WDKV, I_CKVG, I_WUK, I_WUV,
       I_WDQ, I_CQG, I_WUQ, I_WO, I_RW, I_RB, I_WGU, I_BGU, I_WDN, I_BDN, I_FG };

__device__ __forceinline__ unsigned cvt_pk_bf16(float lo, float hi) { unsigned r; asm volatile("v_cvt_pk_bf16_f32 %0, %1, %2" : "=v"(r) : "v"(lo), "v"(hi)); return r; }
__device__ __forceinline__ float bf2f(unsigned short b) { return __uint_as_float(((unsigned)b) << 16); }
__device__ __forceinline__ float bflo(unsigned w) { return __uint_as_float(w << 16); }
__device__ __forceinline__ float bfhi(unsigned w) { return __uint_as_float(w & 0xffff0000u); }
__device__ __forceinline__ float wave_sum(float v) {
#pragma unroll
    for (int o = 32; o >= 1; o >>= 1) v += __shfl_xor(v, o);
    return v;
}
__device__ __forceinline__ float sigmoidf_(float x) { return __builtin_amdgcn_rcpf(1.0f + __builtin_amdgcn_exp2f(-1.4426950408889634f * x)); }
#define XB_TMO      128
#define XB_XCNT(j)  (256  + 64 * (j))
#define XB_XSUB(j)  (1280 + 64 * (j))
#define XB_XGEN(j)  (2304 + 64 * (j))
#define XB_TOP      3328
#define XB_TOPGEN   3392
#define XCD_BAR_WORDS 3456
#define XB_SPIN_CAP (1u << 18)

__device__ __forceinline__ unsigned xb_ld(unsigned* p)              { return __hip_atomic_load(p, __ATOMIC_RELAXED, __HIP_MEMORY_SCOPE_AGENT); }
__device__ __forceinline__ unsigned xb_add(unsigned* p, unsigned v) { return __hip_atomic_fetch_add(p, v, __ATOMIC_RELAXED, __HIP_MEMORY_SCOPE_AGENT); }
__device__ __forceinline__ unsigned xb_xcc_id() { return (unsigned)__builtin_amdgcn_s_getreg((3 << 11) | 20) & 0xFu; }
#define XB_SPIN(cond, bar) do { unsigned _sp = 0; while (cond) { __builtin_amdgcn_s_sleep(1); \
    if ((++_sp & 255u) == 0u) { if (xb_ld(&(bar)[XB_TMO])) break; if (_sp > XB_SPIN_CAP) { atomicAdd(&(bar)[XB_TMO], 1u); break; } } } } while (0)

struct XcdBarrier {
    unsigned* bar; unsigned x;
    volatile LAS unsigned* st;
};

__device__ __forceinline__ XcdBarrier xcd_barrier_post(unsigned* bar, volatile LAS unsigned* st) {
    XcdBarrier b; b.bar = bar; b.x = xb_xcc_id(); b.st = st;
    if (threadIdx.x == 0) (void)xb_add(&bar[XB_XCNT(b.x)], 1u);
    return b;
}
__device__ __forceinline__ void xcd_barrier_complete(unsigned* bar, unsigned x, unsigned& nloc, unsigned& nx) {
    const unsigned G = gridDim.x * gridDim.y * gridDim.z;
    unsigned sum, cnt, mine, sp = 0u;
    for (;;) {
        sum = 0u; cnt = 0u; mine = 0u;
#pragma unroll
        for (unsigned j = 0; j < 16; ++j) { const unsigned c = xb_ld(&bar[XB_XCNT(j)]); sum += c; cnt += (c > 0u) ? 1u : 0u; mine = (j == x) ? c : mine; }
        if (sum == G) break;
        __builtin_amdgcn_s_sleep(1);
        if ((++sp & 255u) == 0u) { if (xb_ld(&bar[XB_TMO])) break; if (sp > XB_SPIN_CAP) { atomicAdd(&bar[XB_TMO], 1u); break; } }
    }
    nloc = mine > 0u ? mine : 1u; nx = cnt > 0u ? cnt : 1u;
}

__device__ __forceinline__ void xcd_barrier(const XcdBarrier& b) {
    asm volatile("s_waitcnt vmcnt(0)" ::: "memory");
    __syncthreads();
    if (threadIdx.x == 0) {
        unsigned* bar = b.bar;
        __builtin_amdgcn_s_waitcnt(0);
        unsigned nloc = b.st[0], nx = b.st[1];
        if (nloc == 0u) { xcd_barrier_complete(bar, b.x, nloc, nx); b.st[0] = nloc; b.st[1] = nx; }
        const unsigned old = xb_add(&bar[XB_XSUB(b.x)], 1u);
        const unsigned gen = old / nloc;
        if (old + 1u == (gen + 1u) * nloc) {
            __builtin_amdgcn_fence(__ATOMIC_RELEASE, "agent");
            asm volatile("s_waitcnt vmcnt(0)" ::: "memory");
            const unsigned og = xb_add(&bar[XB_TOP], 1u);
            const unsigned tg = og / nx;
            if (og + 1u == (tg + 1u) * nx) xb_add(&bar[XB_TOPGEN], 1u);
            else XB_SPIN(xb_ld(&bar[XB_TOPGEN]) == tg, bar);
            __builtin_amdgcn_fence(__ATOMIC_ACQUIRE, "agent");
            xb_add(&bar[XB_XGEN(b.x)], 1u);
            asm volatile("s_waitcnt vmcnt(0)" ::: "memory");
        } else {
            XB_SPIN(xb_ld(&bar[XB_XGEN(b.x)]) == gen, bar);
            __builtin_amdgcn_fence(__ATOMIC_ACQUIRE, "agent");
            asm volatile("s_waitcnt vmcnt(0)" ::: "memory");
        }
    }
    __syncthreads();
}
namespace pg8 {
#define PG8_LAS __attribute__((address_space(3)))
constexpr int BM = 256, BK = 64, HALF = 128, HTB = HALF * BK * 2  , STAGE_BYTES = 8 * HTB, NXCD = 8, WGM = 8;

__host__ __device__ __forceinline__ int lds_byte(int r, int c) { const int st = (r >> 4) * 2 + (c >> 5), rr = r & 15, cc = c & 31, ob = rr * 64 + cc * 2; return st * 1024 + (ob ^ (((ob >> 9) & 1) << 5)); }
__host__ __device__ __forceinline__ void stage_rc(int b, int& R, int& C) { const int st = b / 1024, sb = b % 1024, swz = sb ^ (((sb >> 9) & 1) << 5); R = (st >> 1) * 16 + swz / 64; C = (st & 1) * 32 + (swz % 64) / 2; }
__host__ __device__ __forceinline__ int perm32(int rho) { const int n = rho >> 4, i = rho & 15; return 8 * (i >> 2) + 4 * n + (i & 3); }

struct Unit { int pm, pn; };
struct Gemm { const bf16_t* A; const bf16_t* Bt; int M, N, K; };

struct StaticOrder {
    static constexpr bool GATHER = false;
    int nM, nN, nwg, G, c;
    __host__ __device__ void init(int M, int N, int G_, int c_) { nM = M / BM; nN = N / BM; nwg = nM * nN; G = G_; c = c_; }
    __host__ __device__ bool next(int i, Unit& u) const {
        const long L = (long)i * G + c; if (L >= nwg) return false;
        int wgid = (int)L; { const int q = nwg / NXCD, r = nwg % NXCD, xcd = wgid % NXCD, off = wgid / NXCD; wgid = (xcd < r ? xcd * (q + 1) : r * (q + 1) + (xcd - r) * q) + off; }
        const int nig = WGM * nN, gid = wgid / nig, fm = gid * WGM, gsz = (nM - fm) < WGM ? (nM - fm) : WGM;
        u.pm = fm + ((wgid % nig) % gsz); u.pn = (wgid % nig) / gsz; return true;
    }
    __device__ __forceinline__ void a_ready(const Unit&) const {}
    __device__ __forceinline__ size_t boff(const Unit& u, size_t tstep) const { return (size_t)u.pn * tstep; }
    __device__ __forceinline__ void done(const Unit&) const {}
};
template <class Epi, class Sched>
__device__ __forceinline__ void gemm_phase(PG8_LAS unsigned char* lds, const Gemm g, const Sched& S, const Epi& E) {
    constexpr bool STAMP = false; unsigned long long* stamps = nullptr;
    int tid_ = threadIdx.x; asm volatile("" : "+v"(tid_));
    const int tid = tid_, wid = __builtin_amdgcn_readfirstlane(tid >> 6), lane = tid & 63, wr = wid >> 2, wc = wid & 3, fr = lane & 15, fq = lane >> 4;
    const int K = g.K, nt = K / BK;
    int ts_lo = 0, ts_hi = 0, nts = 0; const unsigned long long rt_entry = STAMP ? (unsigned long long)wall_clock64() : 0ull;
#define PG8_STAMP() do { if (STAMP && wid == 0 && nts < 64) { const unsigned long long _c = (unsigned long long)clock64(); \
        ts_lo = (lane == nts) ? (int)(unsigned)_c : ts_lo; ts_hi = (lane == nts) ? (int)(unsigned)(_c >> 32) : ts_hi; ++nts; } } while (0)
    PG8_STAMP();
    unsigned voffA[2], voffB[2];
#pragma unroll
    for (int i = 0; i < 2; ++i) { int R, C; stage_rc(tid * 16 + i * 8192, R, C); const int Rb = Epi::PERM ? ((R & ~31) + perm32(R & 31)) : R;
        voffA[i] = (unsigned)(R * K + C) * 2u; voffB[i] = (unsigned)(Rb * K + C) * 2u; }
    unsigned gc[2][2], gn[2][2], gnn[2][2];
#define PG8_LOOKUP_LD(t4_, u) t4_ = *(const u32x4*)(S.rowtab + ((size_t)S.rt_blk(u) * 512 + tid) * 4)
#define PG8_LOOKUP_FIN(dst, t4_) do { const unsigned tk_[4] = {t4_.x, t4_.y, t4_.z, t4_.w}; \
        _Pragma("unroll") for (int h_ = 0; h_ < 2; ++h_) _Pragma("unroll") for (int i_ = 0; i_ < 2; ++i_) { int R_, C_; stage_rc(tid * 16 + i_ * 8192, R_, C_); \
        const unsigned tc_ = tk_[h_ * 2 + i_] < S.nrows_src ? tk_[h_ * 2 + i_] : S.nrows_src - 1u; dst[h_][i_] = (tc_ * (unsigned)K + (unsigned)C_) * 2u; } } while (0)
#define PG8_LOOKUP(dst, u) do { u32x4 t4x_; PG8_LOOKUP_LD(t4x_, u); PG8_LOOKUP_FIN(dst, t4x_); } while (0)
#define PG8_STAGE_G(bufoff, kbytes, off2) do { _Pragma("unroll") for (int _i = 0; _i < 2; ++_i) \
        __builtin_amdgcn_global_load_lds((const unsigned*)((const char*)g.A + (kbytes) + (off2)[_i]), (PG8_LAS unsigned*)(lds + (bufoff) + ldsw + _i * 8192), 16, 0, 0); } while (0)
    const size_t kstep = (size_t)(BK * 2);
    const size_t hstep = (size_t)HALF * K * 2;
    const size_t tstep = 2 * hstep;
    const unsigned ldsw = (unsigned)wid * 1024u;
    const int aoff = lds_byte(wr * 64 + fr, fq * 8), boff = lds_byte(wc * 32 + fr, fq * 8);
#define PG8_SA(b, h) (((b) * 2 + (h)) * HTB)
#define PG8_SB(b, h) ((4 + (b) * 2 + (h)) * HTB)
#define PG8_STAGE(bufoff, gbase, voff) do { _Pragma("unroll") for (int _i = 0; _i < 2; ++_i) \
        __builtin_amdgcn_global_load_lds((const unsigned*)((const char*)(gbase) + (voff)[_i]), (PG8_LAS unsigned*)(lds + (bufoff) + ldsw + _i * 8192), 16, 0, 0); } while (0)
#define PG8_LDA(dst, b, h) do { _Pragma("unroll") for (int m = 0; m < 4; ++m) _Pragma("unroll") for (int k = 0; k < 2; ++k) dst[m][k] = *(const PG8_LAS bf16x8*)(lds + PG8_SA(b, h) + aoff + m * 2048 + k * 1024); } while (0)
#define PG8_LDB(dst, b, h) do { _Pragma("unroll") for (int n = 0; n < 2; ++n) _Pragma("unroll") for (int k = 0; k < 2; ++k) dst[n][k] = *(const PG8_LAS bf16x8*)(lds + PG8_SB(b, h) + boff + n * 2048 + k * 1024); } while (0)
#define PG8_MMA(ai, bj, At, Bt) do { __builtin_amdgcn_s_setprio(1); _Pragma("unroll") for (int m = 0; m < 4; ++m) _Pragma("unroll") for (int n = 0; n < 2; ++n) _Pragma("unroll") for (int k = 0; k < 2; ++k) \
        acc[ai][bj][m][n] = __builtin_amdgcn_mfma_f32_16x16x32_bf16(Bt[n][k], At[m][k], acc[ai][bj][m][n], 0, 0, 0); __builtin_amdgcn_s_setprio(0); } while (0)
#define PG8_WAIT_V(n) asm volatile("s_waitcnt vmcnt(" #n ")" ::: "memory")
#define PG8_WAIT_L(n) asm volatile("s_waitcnt lgkmcnt(" #n ")" ::: "memory")
#define PG8_BAR __builtin_amdgcn_s_barrier()
#define PG8_SCHED __builtin_amdgcn_sched_barrier(0)
    Unit cur, nxt; int ui = 0;
    if (!S.next(0, cur)) return;
    f32x4 acc[2][2][4][2];
#pragma unroll
    for (int a = 0; a < 2; ++a)
#pragma unroll
        for (int b = 0; b < 2; ++b)
#pragma unroll
            for (int m = 0; m < 4; ++m)
#pragma unroll
                for (int n = 0; n < 2; ++n) acc[a][b][m][n] = (f32x4){0.f, 0.f, 0.f, 0.f};
    bf16x8 At[4][2], B0[2][2], B1[2][2];
    const char* cA = (const char*)g.A + (size_t)cur.pm * tstep; const char* cB = (const char*)g.Bt + S.boff(cur, tstep);
    S.a_ready(cur);
    if constexpr (Sched::GATHER) { PG8_LOOKUP(gc, cur); Unit u1_; if (S.next(1, u1_)) PG8_LOOKUP(gn, u1_); else { _Pragma("unroll") for (int h_ = 0; h_ < 2; ++h_) _Pragma("unroll") for (int i_ = 0; i_ < 2; ++i_) gn[h_][i_] = gc[h_][i_]; } }
    PG8_STAGE(PG8_SB(0, 0), cB, voffB); if constexpr (Sched::GATHER) PG8_STAGE_G(PG8_SA(0, 0), 0, gc[0]); else PG8_STAGE(PG8_SA(0, 0), cA, voffA);
    PG8_STAGE(PG8_SB(0, 1), cB + hstep, voffB); if constexpr (Sched::GATHER) PG8_STAGE_G(PG8_SA(0, 1), 0, gc[1]); else PG8_STAGE(PG8_SA(0, 1), cA + hstep, voffA);
    if (wr == 1) PG8_BAR;
    PG8_WAIT_V(4); PG8_BAR;
    PG8_STAGE(PG8_SB(1, 0), cB + kstep, voffB); if constexpr (Sched::GATHER) PG8_STAGE_G(PG8_SA(1, 0), kstep, gc[0]); else PG8_STAGE(PG8_SA(1, 0), cA + kstep, voffA);
    PG8_STAGE(PG8_SB(1, 1), cB + hstep + kstep, voffB);
    PG8_WAIT_V(6); PG8_BAR;
    PG8_STAMP();
    for (;;) {
        const bool has_next = S.next(ui + 1, nxt);
        const char* nA = has_next ? (const char*)g.A + (size_t)nxt.pm * tstep : cA; const char* nB = has_next ? (const char*)g.Bt + S.boff(nxt, tstep) : cB;
        const typename Epi::Pre pre = E.pre(cur, wr, wc, fr, fq);
        if constexpr (Sched::GATHER) { if (!has_next) { _Pragma("unroll") for (int h_ = 0; h_ < 2; ++h_) _Pragma("unroll") for (int i_ = 0; i_ < 2; ++i_) gn[h_][i_] = gc[h_][i_]; } }
        for (int t = 0; t < nt; t += 2) {
            const bool last = (t == nt - 2);
            unsigned gs[2][2]; size_t k1 = 0, k2 = 0;
            if constexpr (Sched::GATHER) { k1 = (size_t)(t + 1) * kstep; k2 = last ? 0 : (size_t)(t + 2) * kstep;
                _Pragma("unroll") for (int h_ = 0; h_ < 2; ++h_) _Pragma("unroll") for (int i_ = 0; i_ < 2; ++i_) gs[h_][i_] = last ? gn[h_][i_] : gc[h_][i_]; }
            const char* a1 = cA + (size_t)(t + 1) * kstep;
            const char* a2 = last ? nA : cA + (size_t)(t + 2) * kstep; const char* b2 = last ? nB : cB + (size_t)(t + 2) * kstep;
            const char* a3 = a2 + kstep; const char* b3 = b2 + kstep;
            if (last && has_next) S.a_ready(nxt);
            PG8_LDB(B0, 0, 0); PG8_SCHED; PG8_LDA(At, 0, 0); if constexpr (Sched::GATHER) PG8_STAGE_G(PG8_SA(1, 1), k1, gc[1]); else PG8_STAGE(PG8_SA(1, 1), a1 + hstep, voffA);
            PG8_WAIT_L(8); PG8_BAR; PG8_WAIT_L(0); PG8_MMA(0, 0, At, B0); PG8_BAR; PG8_SCHED;
            PG8_LDB(B1, 0, 1); PG8_STAGE(PG8_SB(0, 0), b2, voffB);
            PG8_BAR; PG8_WAIT_L(0); PG8_MMA(0, 1, At, B1); PG8_BAR;
            PG8_LDA(At, 0, 1); if constexpr (Sched::GATHER) PG8_STAGE_G(PG8_SA(0, 0), k2, gs[0]); else PG8_STAGE(PG8_SA(0, 0), a2, voffA);
            PG8_BAR; PG8_WAIT_L(0); PG8_MMA(1, 0, At, B0); PG8_BAR; PG8_SCHED;
            PG8_STAGE(PG8_SB(0, 1), b2 + hstep, voffB);
            PG8_WAIT_V(6); PG8_BAR; PG8_MMA(1, 1, At, B1); PG8_BAR;
            PG8_LDB(B0, 1, 0); PG8_SCHED; PG8_LDA(At, 1, 0); if constexpr (Sched::GATHER) PG8_STAGE_G(PG8_SA(0, 1), k2, gs[1]); else PG8_STAGE(PG8_SA(0, 1), a2 + hstep, voffA);
            PG8_WAIT_L(8); PG8_BAR; PG8_WAIT_L(0); PG8_MMA(0, 0, At, B0); PG8_BAR; PG8_SCHED;
            PG8_LDB(B1, 1, 1); PG8_STAGE(PG8_SB(1, 0), b3, voffB);
            PG8_BAR; PG8_WAIT_L(0); PG8_MMA(0, 1, At, B1); PG8_BAR;
            PG8_LDA(At, 1, 1); if constexpr (Sched::GATHER) PG8_STAGE_G(PG8_SA(1, 0), k2 + kstep, gs[0]); else PG8_STAGE(PG8_SA(1, 0), a3, voffA);
            PG8_BAR; PG8_WAIT_L(0); PG8_MMA(1, 0, At, B0); PG8_BAR; PG8_SCHED;
            PG8_STAGE(PG8_SB(1, 1), b3 + hstep, voffB);
            PG8_WAIT_V(6); PG8_BAR; PG8_MMA(1, 1, At, B1); PG8_BAR;
        }
        PG8_STAMP();
        u32x4 t4n_ = {0u, 0u, 0u, 0u}; bool has_nn_ = false;
        if constexpr (Sched::GATHER) { Unit u2_; has_nn_ = S.next(ui + 2, u2_); if (has_nn_) PG8_LOOKUP_LD(t4n_, u2_); }
        if constexpr (!Epi::AFTER_DRAIN) { if (wr == 0) PG8_BAR; E(acc, cur, wr, wc, fr, fq, pre); S.done(cur); if (wr == 1) PG8_BAR; }
        if constexpr (Sched::GATHER) { if (has_nn_) PG8_LOOKUP_FIN(gnn, t4n_); else { _Pragma("unroll") for (int h_ = 0; h_ < 2; ++h_) _Pragma("unroll") for (int i_ = 0; i_ < 2; ++i_) gnn[h_][i_] = gn[h_][i_]; } }
        PG8_STAMP();
        if (!has_next) break;
#pragma unroll
        for (int a = 0; a < 2; ++a)
#pragma unroll
            for (int b = 0; b < 2; ++b)
#pragma unroll
                for (int m = 0; m < 4; ++m)
#pragma unroll
                    for (int n = 0; n < 2; ++n) acc[a][b][m][n] = (f32x4){0.f, 0.f, 0.f, 0.f};
        cur = nxt; cA = nA; cB = nB; ++ui;
        if constexpr (Sched::GATHER) { _Pragma("unroll") for (int h_ = 0; h_ < 2; ++h_) _Pragma("unroll") for (int i_ = 0; i_ < 2; ++i_) { gc[h_][i_] = gn[h_][i_]; gn[h_][i_] = gnn[h_][i_]; } }
    }
    PG8_WAIT_V(0);
    if (wr == 0) PG8_BAR;
    PG8_BAR;
    if constexpr (Epi::AFTER_DRAIN) { E.fused(acc, cur, wr, wc, fr, fq, lds, wid, lane); S.done(cur); }
    PG8_STAMP();
    if (STAMP && wid == 0) { stamps[lane] = lane < nts ? (((unsigned long long)(unsigned)ts_hi << 32) | (unsigned)ts_lo) : 0ull;
        if (lane == 62) stamps[62] = rt_entry; if (lane == 63) stamps[63] = (unsigned long long)wall_clock64(); }
#undef PG8_STAMP
#undef PG8_SA
#undef PG8_SB
#undef PG8_STAGE
#undef PG8_STAGE_G
#undef PG8_LOOKUP
#undef PG8_LOOKUP_LD
#undef PG8_LOOKUP_FIN
#undef PG8_LDA
#undef PG8_LDB
#undef PG8_MMA
#undef PG8_WAIT_V
#undef PG8_WAIT_L
#undef PG8_BAR
#undef PG8_SCHED
}
}
namespace pg8 {
struct MoeOrder : StaticOrder {
    static constexpr bool GATHER = false;
    const LAS int* bexp; size_t estride;
    bool rev = false; bool same = false;
    __device__ __forceinline__ bool next(int i, Unit& u) const { const bool ok = StaticOrder::next(i, u); if (ok && rev) u.pm = nM - 1 - u.pm; if (ok && same) { u.pm = 0; u.pn = 0; } return ok; }
    __device__ __forceinline__ size_t boff(const Unit& u, size_t tstep) const { return (size_t)__builtin_amdgcn_readfirstlane(bexp[1 + u.pm]) * estride + (size_t)u.pn * tstep; }
};

struct MoeGatherOrder : MoeOrder {
    static constexpr bool GATHER = true;
    const unsigned* rowtab; unsigned nrows_src; const LAS int* fblk;
    __device__ __forceinline__ int rt_blk(const Unit& u) const { const int e = __builtin_amdgcn_readfirstlane(bexp[1 + u.pm]); return e * 128 + (u.pm - __builtin_amdgcn_readfirstlane(fblk[e])); }
};

template <int MODE> struct EpiGated {
    static constexpr bool PERM = true, AFTER_DRAIN = false;
    bf16_t* O; int ldo; const float* bias; int nh; const LAS int* bexp;
    struct Pre { f32x4 b0[2], b1[2]; };
    __device__ __forceinline__ Pre pre(const Unit& u, int wr, int wc, int fr, int fq) const {
        const int colh = u.pn * HALF + wc * 32 + 8 * fq; Pre p;
        const float* bp = bias; if (MODE == 1) bp += (size_t)__builtin_amdgcn_readfirstlane(bexp[1 + u.pm]) * (size_t)(2 * nh);
#pragma unroll
        for (int n = 0; n < 2; ++n) { p.b0[n] = *(const f32x4*)(bp + colh + 4 * n); p.b1[n] = *(const f32x4*)(bp + nh + colh + 4 * n); }
        return p; }
    __device__ __forceinline__ void operator()(const f32x4 (&acc)[2][2][4][2], const Unit& u, int wr, int wc, int fr, int fq, const Pre& P) const {
        const int row0 = u.pm * BM + wr * 64 + fr, colh = u.pn * HALF + wc * 32 + 8 * fq;
        f32x4 b0[2], b1[2];
#pragma unroll
        for (int n = 0; n < 2; ++n) { b0[n] = P.b0[n]; b1[n] = P.b1[n]; }
#pragma unroll
        for (int ai = 0; ai < 2; ++ai)
#pragma unroll
            for (int m = 0; m < 4; ++m) {
                float o[8];
#pragma unroll
                for (int n = 0; n < 2; ++n) { const f32x4 a = acc[ai][0][m][n] + b0[n], g = acc[ai][1][m][n] + b1[n];
#pragma unroll
                    for (int j = 0; j < 4; ++j) {
                        if (MODE == 0) o[4 * n + j] = a[j] * sigmoidf_(g[j]);
                        else { const float gg = fminf(a[j], 7.0f), uu = fminf(fmaxf(g[j], -7.0f), 7.0f);
                            o[4 * n + j] = fmaf(uu, gg, gg) * __builtin_amdgcn_rcpf(1.0f + __builtin_amdgcn_exp2f(gg * (-1.702f * 1.4426950408889634f))); } } }
                u32x4 w; w.x = cvt_pk_bf16(o[0], o[1]); w.y = cvt_pk_bf16(o[2], o[3]); w.z = cvt_pk_bf16(o[4], o[5]); w.w = cvt_pk_bf16(o[6], o[7]);
                *(u32x4*)(O + (size_t)(row0 + ai * HALF + m * 16) * ldo + colh) = w; }
    }
};
struct EpiBf16P {
    static constexpr bool PERM = true, AFTER_DRAIN = false;
    bf16_t* O; int ldo; const float* bias; int nbias; const LAS int* bexp; int probe = 0;
    struct Pre { f32x4 bv[2][2]; };
    __device__ __forceinline__ Pre pre(const Unit& u, int wr, int wc, int fr, int fq) const {
        const int col0 = u.pn * BM + wc * 32 + 8 * fq; Pre p;
        const float* bp = bias; if (bias && bexp) bp += (size_t)__builtin_amdgcn_readfirstlane(bexp[1 + u.pm]) * (size_t)nbias;
#pragma unroll
        for (int bj = 0; bj < 2; ++bj)
#pragma unroll
            for (int n = 0; n < 2; ++n) p.bv[bj][n] = bias ? *(const f32x4*)(bp + col0 + bj * HALF + 4 * n) : (f32x4){0.f, 0.f, 0.f, 0.f};
        return p; }
    __device__ __forceinline__ void operator()(const f32x4 (&acc)[2][2][4][2], const Unit& u_, int wr, int wc, int fr, int fq, const Pre& P) const {
        if (probe == 1) return;
        Unit u = u_; if (probe >= 2) { u.pm = 0; }
        const int row0 = u.pm * BM + wr * 64 + fr, col0 = u.pn * BM + wc * 32 + 8 * fq;
        f32x4 bv[2][2];
#pragma unroll
        for (int bj = 0; bj < 2; ++bj)
#pragma unroll
            for (int n = 0; n < 2; ++n) bv[bj][n] = P.bv[bj][n];
#pragma unroll
        for (int ai = 0; ai < 2; ++ai)
#pragma unroll
            for (int m = 0; m < 4; ++m) { bf16_t* rowp = O + (size_t)(row0 + ai * HALF + m * 16) * ldo + col0;
#pragma unroll
                for (int bj = 0; bj < 2; ++bj) { const f32x4 v0 = acc[ai][bj][m][0] + bv[bj][0], v1 = acc[ai][bj][m][1] + bv[bj][1];
                    u32x4 w; w.x = cvt_pk_bf16(v0[0], v0[1]); w.y = cvt_pk_bf16(v0[2], v0[3]); w.z = cvt_pk_bf16(v1[0], v1[1]); w.w = cvt_pk_bf16(v1[2], v1[3]);
                    if (probe == 3 && (ai | m)) { asm volatile("" :: "v"(w)); continue; }
                    *(u32x4*)(rowp + bj * HALF) = w; } }
    }
};
struct EpiF32P {
    static constexpr bool PERM = false, AFTER_DRAIN = false;
    float* C; int ldc;
    struct Pre {};
    __device__ __forceinline__ Pre pre(const Unit&, int, int, int, int) const { return Pre{}; }
    __device__ __forceinline__ void operator()(const f32x4 (&acc)[2][2][4][2], const Unit& u, int wr, int wc, int fr, int fq, const Pre&) const {
        const int row0 = u.pm * BM + wr * 64 + fr, col0 = u.pn * BM + wc * 32 + 4 * fq;
#pragma unroll
        for (int ai = 0; ai < 2; ++ai)
#pragma unroll
            for (int m = 0; m < 4; ++m) { float* rowp = C + (size_t)(row0 + ai * HALF + m * 16) * ldc + col0;
#pragma unroll
                for (int bj = 0; bj < 2; ++bj)
#pragma unroll
                    for (int n = 0; n < 2; ++n) *(f32x4*)(rowp + bj * HALF + n * 16) = acc[ai][bj][m][n]; }
    }
};
struct EpiResid {
    static constexpr bool PERM = false, AFTER_DRAIN = false;
    const float* base; float* X; const float* bias; const float* gate;
    struct Pre {};
    __device__ __forceinline__ Pre pre(const Unit&, int, int, int, int) const { return Pre{}; }
    __device__ __forceinline__ void operator()(const f32x4 (&acc)[2][2][4][2], const Unit& u, int wr, int wc, int fr, int fq, const Pre&) const {
        const int row0 = u.pm * BM + wr * 64 + fr, col0 = u.pn * BM + wc * 32 + 4 * fq;
        const float* gp = gate + (size_t)((u.pm * BM) / SEQ) * (6 * D);
        f32x4 bv[2][2], gv[2][2];
#pragma unroll
        for (int bj = 0; bj < 2; ++bj)
#pragma unroll
            for (int n = 0; n < 2; ++n) { bv[bj][n] = bias ? *(const f32x4*)(bias + col0 + bj * HALF + n * 16) : (f32x4){0.f, 0.f, 0.f, 0.f}; gv[bj][n] = *(const f32x4*)(gp + col0 + bj * HALF + n * 16); }
#pragma unroll
        for (int ai = 0; ai < 2; ++ai)
#pragma unroll
            for (int m = 0; m < 4; ++m) { const size_t off = (size_t)(row0 + ai * HALF + m * 16) * D + col0;
                f32x4 bs[2][2];
#pragma unroll
                for (int bj = 0; bj < 2; ++bj)
#pragma unroll
                    for (int n = 0; n < 2; ++n) bs[bj][n] = *(const f32x4*)(base + off + bj * HALF + n * 16);
#pragma unroll
                for (int bj = 0; bj < 2; ++bj)
#pragma unroll
                    for (int n = 0; n < 2; ++n) *(f32x4*)(X + off + bj * HALF + n * 16) = bs[bj][n] + gv[bj][n] * (acc[ai][bj][m][n] + bv[bj][n]); }
    }
};
struct EpiQRope {
    static constexpr bool PERM = true, AFTER_DRAIN = false;
    bf16_t* O; const f32x2* cs;
    struct Pre {};
    __device__ __forceinline__ Pre pre(const Unit&, int, int, int, int) const { return Pre{}; }
    __device__ __forceinline__ void operator()(const f32x4 (&acc)[2][2][4][2], const Unit& u, int wr, int wc, int fr, int fq, const Pre&) const {
        const int row0 = u.pm * BM + wr * 64 + fr, col0 = u.pn * BM + wc * 32 + 8 * fq;
#pragma unroll
        for (int bj = 0; bj < 2; ++bj) {
            const int c = col0 + bj * HALF, w = c % DQK; const bool rope = w >= DNOPE; const int k4 = rope ? ((w - DNOPE) >> 3) * 4 : 0;
#pragma unroll
            for (int ai = 0; ai < 2; ++ai)
#pragma unroll
                for (int m = 0; m < 4; ++m) { const int row = row0 + ai * HALF + m * 16;
                    f32x4 v0 = acc[ai][bj][m][0], v1 = acc[ai][bj][m][1];
                    if (rope) { const f32x4 t0 = *(const f32x4*)(cs + (size_t)row * 32 + k4), t1 = *(const f32x4*)(cs + (size_t)row * 32 + k4 + 2);
                        const float co[4] = {t0[0], t0[2], t1[0], t1[2]}, si[4] = {t0[1], t0[3], t1[1], t1[3]};
#pragma unroll
                        for (int j = 0; j < 4; ++j) { const float x1 = v0[j], x2 = v1[j]; v0[j] = x1 * co[j] - x2 * si[j]; v1[j] = x2 * co[j] + x1 * si[j]; } }
                    u32x4 wv; wv.x = cvt_pk_bf16(v0[0], v0[1]); wv.y = cvt_pk_bf16(v0[2], v0[3]); wv.z = cvt_pk_bf16(v1[0], v1[1]); wv.w = cvt_pk_bf16(v1[2], v1[3]);
                    *(u32x4*)(O + (size_t)row * (NH * DQK) + c) = wv;
                    asm volatile("" ::: "memory"); } }
    }
};

template <bool BF> struct EpiResidB {
    static constexpr bool PERM = true, AFTER_DRAIN = false;
    const void* base; bf16_t* X; const float* bias; const float* gate;
    struct Pre {};
    __device__ __forceinline__ Pre pre(const Unit&, int, int, int, int) const { return Pre{}; }
    __device__ __forceinline__ void operator()(const f32x4 (&acc)[2][2][4][2], const Unit& u, int wr, int wc, int fr, int fq, const Pre&) const {
        const int row0 = u.pm * BM + wr * 64 + fr, col0 = u.pn * BM + wc * 32 + 8 * fq;
        const float* gp = gate + (size_t)((u.pm * BM) / SEQ) * (6 * D);
        f32x4 bv[2][2], gv[2][2];
#pragma unroll
        for (int bj = 0; bj < 2; ++bj)
#pragma unroll
            for (int n = 0; n < 2; ++n) { bv[bj][n] = bias ? *(const f32x4*)(bias + col0 + bj * HALF + 4 * n) : (f32x4){0.f, 0.f, 0.f, 0.f}; gv[bj][n] = *(const f32x4*)(gp + col0 + bj * HALF + 4 * n); }
#pragma unroll
        for (int ai = 0; ai < 2; ++ai)
#pragma unroll
            for (int m = 0; m < 4; ++m) { const size_t off = (size_t)(row0 + ai * HALF + m * 16) * D + col0;
                f32x4 b0[2], b1[2];
#pragma unroll
                for (int bj = 0; bj < 2; ++bj) {
                    if (BF) { const u32x4 w = *(const u32x4*)((const bf16_t*)base + off + bj * HALF); b0[bj] = (f32x4){bflo(w.x), bfhi(w.x), bflo(w.y), bfhi(w.y)}; b1[bj] = (f32x4){bflo(w.z), bfhi(w.z), bflo(w.w), bfhi(w.w)}; }
                    else { b0[bj] = *(const f32x4*)((const float*)base + off + bj * HALF); b1[bj] = *(const f32x4*)((const float*)base + off + bj * HALF + 4); } }
#pragma unroll
                for (int bj = 0; bj < 2; ++bj) { const f32x4 v0 = b0[bj] + gv[bj][0] * (acc[ai][bj][m][0] + bv[bj][0]), v1 = b1[bj] + gv[bj][1] * (acc[ai][bj][m][1] + bv[bj][1]);
                    u32x4 w; w.x = cvt_pk_bf16(v0[0], v0[1]); w.y = cvt_pk_bf16(v0[2], v0[3]); w.z = cvt_pk_bf16(v1[0], v1[1]); w.w = cvt_pk_bf16(v1[2], v1[3]);
                    *(u32x4*)(X + off + bj * HALF) = w; } }
    }
};
struct EpiLatQ {
    static constexpr bool PERM = true, AFTER_DRAIN = false;
    bf16_t* O0; int ld0, n0; bf16_t* KR; const f32x2* cs; float* ssp;
    struct Pre {};
    __device__ __forceinline__ Pre pre(const Unit&, int, int, int, int) const { return Pre{}; }
    __device__ __forceinline__ void operator()(const f32x4 (&acc)[2][2][4][2], const Unit& u, int wr, int wc, int fr, int fq, const Pre&) const {
        const int row0 = u.pm * BM + wr * 64 + fr, col0 = u.pn * BM + wc * 32 + 8 * fq;
#pragma unroll
        for (int ai = 0; ai < 2; ++ai)
#pragma unroll
            for (int m = 0; m < 4; ++m) { const int row = row0 + ai * HALF + m * 16; float ss = 0.f;
#pragma unroll
                for (int bj = 0; bj < 2; ++bj) { const int c = col0 + bj * HALF; f32x4 v0 = acc[ai][bj][m][0], v1 = acc[ai][bj][m][1];
                    if (c < n0) {
                        ss += (v0[0] * v0[0] + v0[1] * v0[1]) + (v0[2] * v0[2] + v0[3] * v0[3]) + (v1[0] * v1[0] + v1[1] * v1[1]) + (v1[2] * v1[2] + v1[3] * v1[3]);
                        u32x4 w; w.x = cvt_pk_bf16(v0[0], v0[1]); w.y = cvt_pk_bf16(v0[2], v0[3]); w.z = cvt_pk_bf16(v1[0], v1[1]); w.w = cvt_pk_bf16(v1[2], v1[3]);
                        *(u32x4*)(O0 + (size_t)row * ld0 + c) = w;
                    } else if (KR && c < n0 + DROPE) { const int k4 = ((c - n0) >> 3) * 4; const f32x4 t0 = *(const f32x4*)(cs + (size_t)row * 32 + k4), t1 = *(const f32x4*)(cs + (size_t)row * 32 + k4 + 2);
                        const float co[4] = {t0[0], t0[2], t1[0], t1[2]}, si[4] = {t0[1], t0[3], t1[1], t1[3]};
#pragma unroll
                        for (int j = 0; j < 4; ++j) { const float x1 = v0[j], x2 = v1[j]; v0[j] = x1 * co[j] - x2 * si[j]; v1[j] = x2 * co[j] + x1 * si[j]; }
                        u32x4 w; w.x = cvt_pk_bf16(v0[0], v0[1]); w.y = cvt_pk_bf16(v0[2], v0[3]); w.z = cvt_pk_bf16(v1[0], v1[1]); w.w = cvt_pk_bf16(v1[2], v1[3]);
                        *(u32x4*)(KR + (size_t)row * DROPE + (c - n0)) = w; } }
                ss += __shfl_xor(ss, 16); ss += __shfl_xor(ss, 32);
                if (fq == 0) ssp[(size_t)row * 8 + u.pn * 4 + wc] = ss;
                asm volatile("" ::: "memory"); }
    }
};
struct EpiScaled {
    static constexpr bool PERM = true, AFTER_DRAIN = false;
    bf16_t* O; int ldo; const float* ssp; int mode, np; float inv_nd;
    struct Pre {};
    __device__ __forceinline__ Pre pre(const Unit&, int, int, int, int) const { return Pre{}; }
    __device__ __forceinline__ float rstd_of(int t) const { const f32x4 a = *(const f32x4*)(ssp + (size_t)t * 8); float s = (a[0] + a[1]) + (a[2] + a[3]);
        if (np == 8) { const f32x4 b = *(const f32x4*)(ssp + (size_t)t * 8 + 4); s += (b[0] + b[1]) + (b[2] + b[3]); } return rsqrtf(s * inv_nd + EPS); }
    __device__ __forceinline__ void operator()(const f32x4 (&acc)[2][2][4][2], const Unit& u, int wr, int wc, int fr, int fq, const Pre&) const {
        const int row0 = u.pm * BM + wr * 64 + fr, col0 = u.pn * BM + wc * 32 + 8 * fq;
        if (mode == 1) {
#pragma unroll
            for (int bj = 0; bj < 2; ++bj) { const int c = col0 + bj * HALF; float rc[8];
#pragma unroll
                for (int j = 0; j < 8; ++j) rc[j] = rstd_of(c + j);
#pragma unroll
                for (int ai = 0; ai < 2; ++ai)
#pragma unroll
                    for (int m = 0; m < 4; ++m) { const f32x4 v0 = acc[ai][bj][m][0], v1 = acc[ai][bj][m][1];
                        u32x4 w; w.x = cvt_pk_bf16(v0[0] * rc[0], v0[1] * rc[1]); w.y = cvt_pk_bf16(v0[2] * rc[2], v0[3] * rc[3]); w.z = cvt_pk_bf16(v1[0] * rc[4], v1[1] * rc[5]); w.w = cvt_pk_bf16(v1[2] * rc[6], v1[3] * rc[7]);
                        *(u32x4*)(O + (size_t)(row0 + ai * HALF + m * 16) * ldo + c) = w; }
                asm volatile("" ::: "memory"); }
        } else {
#pragma unroll
            for (int ai = 0; ai < 2; ++ai)
#pragma unroll
                for (int m = 0; m < 4; ++m) { const int row = row0 + ai * HALF + m * 16; const float r = rstd_of(row);
#pragma unroll
                    for (int bj = 0; bj < 2; ++bj) { const f32x4 v0 = acc[ai][bj][m][0] * r, v1 = acc[ai][bj][m][1] * r;
                        u32x4 w; w.x = cvt_pk_bf16(v0[0], v0[1]); w.y = cvt_pk_bf16(v0[2], v0[3]); w.z = cvt_pk_bf16(v1[0], v1[1]); w.w = cvt_pk_bf16(v1[2], v1[3]);
                        *(u32x4*)(O + (size_t)row * ldo + col0 + bj * HALF) = w; }
                    asm volatile("" ::: "memory"); }
        }
    }
};

#if NAIVE_GEMM
template <class Epi, class Sched>
__device__ __forceinline__ void gemm_phase_naive(PG8_LAS unsigned char*, const Gemm g, const Sched& S, const Epi& E) {
    const int tid = threadIdx.x, wid = tid >> 6, lane = tid & 63, wr = wid >> 2, wc = wid & 3, fr = lane & 15, fq = lane >> 4;
    const size_t tstep = (size_t)BM * g.K * 2;
    Unit u;
    for (int i = 0; S.next(i, u); ++i) {
        f32x4 acc[2][2][4][2];
        const bf16_t* Bb = (const bf16_t*)((const char*)g.Bt + S.boff(u, tstep));
#pragma unroll 1
        for (int ai = 0; ai < 2; ++ai)
#pragma unroll 1
            for (int m = 0; m < 4; ++m) {
                const bf16_t* ar = g.A + (size_t)(u.pm * BM + ai * HALF + wr * 64 + m * 16 + fr) * g.K;
#pragma unroll
                for (int bj = 0; bj < 2; ++bj)
#pragma unroll
                    for (int n = 0; n < 2; ++n) {
                        const int cs = Epi::PERM ? (bj * HALF + wc * 32 + 8 * fq + 4 * n) : (bj * HALF + wc * 32 + 16 * n + 4 * fq);
                        float s[4] = {0.f, 0.f, 0.f, 0.f};
                        for (int k = 0; k < g.K; k += 8) {
                            const u32x4 av = *(const u32x4*)(ar + k);
#pragma unroll
                            for (int j = 0; j < 4; ++j) { const u32x4 bv = *(const u32x4*)(Bb + (size_t)(cs + j) * g.K + k);
                                s[j] += bflo(av.x) * bflo(bv.x) + bfhi(av.x) * bfhi(bv.x) + bflo(av.y) * bflo(bv.y) + bfhi(av.y) * bfhi(bv.y)
                                      + bflo(av.z) * bflo(bv.z) + bfhi(av.z) * bfhi(bv.z) + bflo(av.w) * bflo(bv.w) + bfhi(av.w) * bfhi(bv.w); } }
                        f32x4 r = {s[0], s[1], s[2], s[3]};
#pragma unroll
                        for (int a2 = 0; a2 < 2; ++a2)
#pragma unroll
                            for (int m2 = 0; m2 < 4; ++m2) if (a2 == ai && m2 == m) acc[a2][bj][m2][n] = r;
                    }
            }
        E(acc, u, wr, wc, fr, fq, E.pre(u, wr, wc, fr, fq));
    }
}
#endif
}

#if NAIVE_GEMM
#define GEMM_PHASE pg8::gemm_phase_naive
#else
#define GEMM_PHASE pg8::gemm_phase
#endif
struct Frame {
    LAS unsigned char* lds; GAS unsigned char* ws; const Args* a;
    int tid, lane, wave, G, blk;
};
__device__ __forceinline__ const float* modp(const Frame& F, int l, int b, int part) { return (const float*)(F.ws + WS_MOD) + ((size_t)(l * NB + b) * 6 + part) * D; }

enum { CM_ID = 0, CM_GLU = 1, CM_UQ = 2, CM_DKV = 3 };
__device__ __forceinline__ int cvt_srccol(int mode, int n, int nvalid, int nh) {
    if (mode == CM_GLU) { const int pn = n >> 8, r = n & 255; return r < 128 ? pn * 128 + r : nh + pn * 128 + (r - 128); }
    if (mode == CM_UQ) { const int h = n / DQK, w = n - h * DQK; if (w < DNOPE) return n; const int p = w - DNOPE, blk = p >> 3, wi = p & 7, i = 4 * blk + (wi & 3); return h * DQK + (wi < 4 ? DNOPE + i : DNOPE + 32 + i); }
    if (mode == CM_DKV) { if (n < KVLORA) return n; if (n >= KVLORA + DROPE) return -1; const int p = n - KVLORA, blk = p >> 3, wi = p & 7, i = 4 * blk + (wi & 3); return KVLORA + (wi < 4 ? i : 32 + i); }
    return n < nvalid ? n : -1;
}
struct CvtJob { const float* src; bf16_t* dst; int K, ld, ndst, nvalid, mode, batch; size_t sstride, dstride; float scale; const float* kgain; };
__device__ __forceinline__ int cvt_tiles(const CvtJob& j) { return j.batch * (j.ndst / 128) * (j.K / 128); }
struct CvtTile { const float* src; bf16_t* dst; int n0, k0, sc; };
__device__ __forceinline__ CvtTile cvt_locate(const Frame& F, const CvtJob& J, int t) {
    const int nkt = J.K / 128, nnt = J.ndst / 128, per = nkt * nnt, bi = t / per, r = t - bi * per, nt = r / nkt, kt = r - nt * nkt;
    CvtTile T; T.src = J.src + (size_t)bi * J.sstride; T.dst = J.dst + (size_t)bi * J.dstride; T.n0 = nt * 128; T.k0 = kt * 128;
    T.sc = cvt_srccol(J.mode, T.n0 + 4 * (F.tid & 31), J.nvalid, J.ndst / 2); return T;
}
template <bool NT = false>
__device__ __forceinline__ void cvt_load(const Frame& F, const CvtJob& J, const CvtTile& T, f32x4 (&v)[8]) {
    const int kg = F.tid >> 5;
#pragma unroll
    for (int i = 0; i < 8; ++i) { const f32x4* p = (const f32x4*)(T.src + (size_t)(T.k0 + 8 * kg + i) * J.ld + T.sc);
        v[i] = T.sc >= 0 ? (NT ? __builtin_nontemporal_load(p) : *p) : (f32x4){0.f, 0.f, 0.f, 0.f}; }
}
__device__ __forceinline__ void cvt_to_lds(const Frame& F, const CvtJob& J, const CvtTile& T, const f32x4 (&v)[8], LAS unsigned char* img) {
    const int nq = F.tid & 31, kg = F.tid >> 5; float sc[8];
#pragma unroll
    for (int i = 0; i < 8; ++i) sc[i] = J.kgain ? J.scale * J.kgain[T.k0 + 8 * kg + i] : J.scale;
#pragma unroll
    for (int j = 0; j < 4; ++j) {
        u32x4 w; w.x = cvt_pk_bf16(v[0][j] * sc[0], v[1][j] * sc[1]); w.y = cvt_pk_bf16(v[2][j] * sc[2], v[3][j] * sc[3]); w.z = cvt_pk_bf16(v[4][j] * sc[4], v[5][j] * sc[5]); w.w = cvt_pk_bf16(v[6][j] * sc[6], v[7][j] * sc[7]);
        *(LAS u32x4*)(img + (4 * nq + j) * 256 + ((kg ^ (nq & 7)) << 4)) = w; }
}
template <bool NT = false>
__device__ __forceinline__ void cvt_from_lds(const Frame& F, const CvtJob& J, const CvtTile& T, const LAS unsigned char* img) {
#pragma unroll
    for (int p = 0; p < 4; ++p) { const int row = p * 32 + (F.tid >> 4), c = F.tid & 15;
        const u32x4 w = *(const LAS u32x4*)(img + row * 256 + ((c ^ ((row >> 2) & 7)) << 4));
        u32x4* q = (u32x4*)(T.dst + (size_t)(T.n0 + row) * J.K + T.k0 + c * 8);
        if (NT) __builtin_nontemporal_store(w, q); else *q = w; }
}
template <bool NT = false>
__device__ __forceinline__ void cvt_job(const Frame& F, const CvtJob& J, int t0, int nt, int stride) {
    for (int t = t0; t < nt; t += 2 * stride) {
        const bool two = t + stride < nt;
        const CvtTile A = cvt_locate(F, J, t), B = cvt_locate(F, J, two ? t + stride : t);
        f32x4 va[8], vb[8];
        cvt_load<NT>(F, J, A, va); if (two) cvt_load<NT>(F, J, B, vb);
        cvt_to_lds(F, J, A, va, F.lds); if (two) cvt_to_lds(F, J, B, vb, F.lds + 32768);
        __syncthreads();
        cvt_from_lds<NT>(F, J, A, F.lds); if (two) cvt_from_lds<NT>(F, J, B, F.lds + 32768);
        __syncthreads();
    }
}
#ifndef TF_NA
#define TF_NA 1024
#endif
#ifndef TF_NB
#define TF_NB 1280
#endif
#ifndef TF_ND
#define TF_ND 1024
#endif
constexpr int TF_A0 = 8192 - TF_NA - TF_NB, TF_A1 = 8192 - TF_NB, TF_D0 = 4096 - TF_ND;
static_assert(TF_A0 >= 4096 && TF_D0 >= 2048, "only layer-1 expert weights can be deferred");
__device__ __forceinline__ CvtJob expert_job(const Frame& F, bool down) {
    const Args& A = *F.a;
    if (down) return CvtJob{GPTR(const float, A.in[I_WDN]), (bf16_t*)(F.ws + WS_WDN), 1024, 1024, 1024, 1024, CM_ID, 64, (size_t)1024 * 1024, (size_t)1024 * 1024, 1.f, nullptr};
    return CvtJob{GPTR(const float, A.in[I_WGU]), (bf16_t*)(F.ws + WS_WGU), 1024, 2048, 2048, 2048, CM_GLU, 64, (size_t)1024 * 2048, (size_t)2048 * 1024, 1.f, nullptr};
}
__device__ __forceinline__ void tail_fill(const Frame& F, int nwg, bool down, int t_lo, int t_hi) {
    const int rem = nwg % F.G, nidle = rem ? F.G - rem : F.G, rank = rem ? F.blk - rem : F.blk;
    if (rank < 0 || t_lo >= t_hi) return;
    __syncthreads();
    const CvtJob J = expert_job(F, down);
    cvt_job<true>(F, J, t_lo + rank, t_hi, nidle);
}
__device__ __forceinline__ void sincos_small(float r, float& s, float& c) {
    const float q = rintf(r * 0.63661977236758134f); const float y = fmaf(q, -1.5707963267948966f, r) + q * 4.371139e-8f; const int qi = (int)q & 3;
    const float y2 = y * y;
    const float sp = y + y * y2 * (-1.6666654611e-1f + y2 * (8.3321608736e-3f + y2 * (-1.9515295891e-4f)));
    const float cp = 1.0f - 0.5f * y2 + y2 * y2 * (4.166664568298827e-2f + y2 * (-1.388731625493765e-3f + y2 * 2.443315711809948e-5f));
    s = (qi == 0) ? sp : (qi == 1) ? cp : (qi == 2) ? -sp : -cp;
    c = (qi == 0) ? cp : (qi == 1) ? -sp : (qi == 2) ? -cp : sp;
}
__device__ __forceinline__ void ph_prologue(const Frame& F) {
    const Args& A = *F.a; GAS unsigned char* ws = F.ws;
    const float qscale = 0.07216878364870322f * 1.4426950408889634f;
    CvtJob J[10];
    J[0] = {GPTR(const float, A.in[I_PW1W]), (bf16_t*)(ws + WS_WPW1), 1024, 2048, 2048, 2048, CM_GLU, 1, 0, 0, 1.f, nullptr};
    J[1] = {GPTR(const float, A.in[I_PW2W]), (bf16_t*)(ws + WS_WPW2), 1024, 1024, 1024, 1024, CM_ID, 1, 0, 0, 1.f, nullptr};
    J[2] = {GPTR(const float, A.in[I_WDKV]), (bf16_t*)(ws + WS_WDKV), 1024, 320, 512, 320, CM_DKV, 1, 0, 0, 1.f, nullptr};
    J[3] = {GPTR(const float, A.in[I_WDQ]), (bf16_t*)(ws + WS_WDQ), 1024, 384, 512, 384, CM_ID, 1, 0, 0, 1.f, nullptr};
    J[4] = {GPTR(const float, A.in[I_WUK]), (bf16_t*)(ws + WS_WUK), 256, 1024, 1024, 1024, CM_ID, 1, 0, 0, 1.f, GPTR(const float, A.in[I_CKVG])};
    J[5] = {GPTR(const float, A.in[I_WUV]), (bf16_t*)(ws + WS_WUV), 256, 1024, 1024, 1024, CM_ID, 1, 0, 0, 1.f, GPTR(const float, A.in[I_CKVG])};
    J[6] = {GPTR(const float, A.in[I_WUQ]), (bf16_t*)(ws + WS_WUQ), 384, 1536, 1536, 1536, CM_UQ, 1, 0, 0, qscale, GPTR(const float, A.in[I_CQG])};
    J[7] = {GPTR(const float, A.in[I_WO]), (bf16_t*)(ws + WS_WO), 1024, 1024, 1024, 1024, CM_ID, 1, 0, 0, 1.f, nullptr};
    J[8] = expert_job(F, false);
    J[9] = expert_job(F, true);
    int base = 0;
#pragma unroll
    for (int j = 0; j < 10; ++j) { const int nt = j == 8 ? TF_A0 : j == 9 ? TF_D0 : cvt_tiles(J[j]);
        int t = F.blk - (base % F.G); if (t < 0) t += F.G;
        cvt_job(F, J[j], t, nt, F.G);
        base += nt; }
    {
        LAS float* cact = (LAS float*)F.lds;
        LAS float* red = cact + 4096;
        for (int i = F.tid; i < NB * D; i += NTHR) { const float c = GPTR(const float, A.in[I_C])[i]; cact[i] = c * sigmoidf_(c); }
        __syncthreads();
        for (int it = F.blk; it < 2 * 96; it += F.G) {
            const int l = it / 96, j0 = (it - l * 96) * 64, col = F.tid & 63, dg = F.tid >> 6;
            const float* wp = GPTR(const float, A.in[I_MODW]) + (size_t)l * D * 6 * D + (size_t)(dg * 128) * (6 * D) + j0 + col;
            float a0 = 0.f, a1 = 0.f, a2 = 0.f, a3 = 0.f;
#pragma unroll 32
            for (int d = 0; d < 128; ++d) { const float w = wp[(size_t)d * (6 * D)]; const int dd = dg * 128 + d;
                a0 += w * cact[dd]; a1 += w * cact[1024 + dd]; a2 += w * cact[2048 + dd]; a3 += w * cact[3072 + dd]; }
            red[(dg * 4 + 0) * 64 + col] = a0; red[(dg * 4 + 1) * 64 + col] = a1; red[(dg * 4 + 2) * 64 + col] = a2; red[(dg * 4 + 3) * 64 + col] = a3;
            __syncthreads();
            if (F.tid < 256) { const int b = F.tid >> 6, c2 = F.tid & 63; float s = GPTR(const float, A.in[I_MODB])[l * 6 * D + j0 + c2];
#pragma unroll
                for (int g = 0; g < 8; ++g) s += red[(g * 4 + b) * 64 + c2];
                ((float*)(ws + WS_MOD))[(size_t)(l * NB + b) * (6 * D) + j0 + c2] = s; }
            __syncthreads();
        }
    }
    {
        const int* pos = (const int*)GPTR(const float, A.in[I_POS]); f32x2* cs = (f32x2*)(ws + WS_CS);
        for (int idx = F.blk * NTHR + F.tid; idx < NTOK * 32; idx += F.G * NTHR) {
            const int tok = idx >> 5, i = idx & 31;
            const double inv = exp(-(2.0 * 9.210340371976184 / 64.0) * (double)i);
            const double ang = (double)pos[tok] * inv, rev = ang * 0.15915494309189535, fr = rev - rint(rev);
            float s, c; sincos_small((float)(fr * 6.283185307179586), s, c);
            cs[idx] = (f32x2){c, s};
        }
    }
}

__device__ __forceinline__ void row_ld16(const float* p, int lane, f32x4 (&v)[4]) {
#pragma unroll
    for (int i = 0; i < 4; ++i) v[i] = *(const f32x4*)(p + i * 256 + lane * 4);
}
__device__ __forceinline__ void row_st16_bf16(bf16_t* p, int lane, const f32x4 (&v)[4]) {
#pragma unroll
    for (int i = 0; i < 4; ++i) { u32x2 w; w.x = cvt_pk_bf16(v[i][0], v[i][1]); w.y = cvt_pk_bf16(v[i][2], v[i][3]); *(u32x2*)(p + i * 256 + lane * 4) = w; }
}
__device__ __forceinline__ float row_rstd(const f32x4 (&v)[4]) {
    float s = 0.f;
#pragma unroll
    for (int i = 0; i < 4; ++i) s += v[i][0] * v[i][0] + v[i][1] * v[i][1] + v[i][2] * v[i][2] + v[i][3] * v[i][3];
    s = wave_sum(s);
    return rsqrtf(s * (1.0f / D) + EPS);
}

__device__ __forceinline__ void ph_norm1(const Frame& F) {
    const Args& A = *F.a; bf16_t* HA = (bf16_t*)(F.ws + WS_HA); const float* g = GPTR(const float, A.in[I_N1G]);
    for (int row = F.blk * NWAVE + F.wave; row < NTOK; row += F.G * NWAVE) {
        const int b = row / SEQ; f32x4 v[4], gv[4], sh[4], sc[4];
        row_ld16(GPTR(const float, A.in[I_X]) + (size_t)row * D, F.lane, v); row_ld16(g, F.lane, gv); row_ld16(modp(F, 0, b, 0), F.lane, sh); row_ld16(modp(F, 0, b, 1), F.lane, sc);
        const float rs = row_rstd(v);
#pragma unroll
        for (int i = 0; i < 4; ++i) v[i] = v[i] * rs * gv[i] * (sc[i] + 1.0f) + sh[i];
        row_st16_bf16(HA + (size_t)row * D, F.lane, v);
    }
}

__device__ __forceinline__ void ph_conv(const Frame& F) {
    const Args& A = *F.a; const bf16_t* U = (const bf16_t*)(F.ws + WS_HB); bf16_t* O = (bf16_t*)(F.ws + WS_HC);
    LAS unsigned char* tile = F.lds;
    LAS f32x2* part = (LAS f32x2*)(F.lds + 62 * 2048);
    LAS f32x2* red = part + 8 * NTHR;
    const int c2 = F.tid * 2;
    f32x2 w[CONVW];
#pragma unroll
    for (int j = 0; j < CONVW; ++j) w[j] = *(const f32x2*)(GPTR(const float, A.in[I_DWW]) + j * D + c2);
    const f32x2 db = *(const f32x2*)(GPTR(const float, A.in[I_DWB]) + c2), lg = *(const f32x2*)(GPTR(const float, A.in[I_LNG]) + c2), lb = *(const f32x2*)(GPTR(const float, A.in[I_LNB]) + c2);
    for (int t = F.blk; t < NTOK / 32; t += F.G) {
        const int tok0 = t * 32, s0 = tok0 % SEQ;
        for (int ch = F.tid; ch < 62 * 128; ch += NTHR) { const int r = ch >> 7, cc = ch & 127; u32x4 v = {0u, 0u, 0u, 0u};
            if (s0 + r - 30 >= 0) v = *(const u32x4*)(U + (size_t)(tok0 + r - 30) * D + cc * 8);
            *(LAS u32x4*)(tile + r * 2048 + cc * 16) = v; }
        __syncthreads();
#pragma unroll 1
        for (int g = 0; g < 4; ++g) {
            f32x2 acc[8];
#pragma unroll
            for (int r = 0; r < 8; ++r) acc[r] = db;
#pragma unroll
            for (int j = 0; j < 38; ++j) { const unsigned u = *(const LAS unsigned*)(tile + (g * 8 + j) * 2048 + F.tid * 4); const f32x2 x = {bflo(u), bfhi(u)};
#pragma unroll
                for (int r = 0; r < 8; ++r) { const int tap = j - r; if (tap >= 0 && tap < CONVW) acc[r] += x * w[tap]; } }
#pragma unroll
            for (int r = 0; r < 8; ++r) part[r * NTHR + F.tid] = (f32x2){acc[r][0] + acc[r][1], acc[r][0] * acc[r][0] + acc[r][1] * acc[r][1]};
            __syncthreads();
            { float s = 0.f, q = 0.f;
#pragma unroll
              for (int i = 0; i < 8; ++i) { const f32x2 p = part[F.wave * NTHR + i * 64 + F.lane]; s += p[0]; q += p[1]; }
              s = wave_sum(s); q = wave_sum(q);
              if (F.lane == 0) { const float mean = s * (1.0f / D), var = fmaxf(q * (1.0f / D) - mean * mean, 0.f); red[F.wave] = (f32x2){mean, rsqrtf(var + EPS)}; } }
            __syncthreads();
#pragma unroll
            for (int r = 0; r < 8; ++r) { const f32x2 st = red[r]; const float mean = st[0], rs = st[1];
                const float y0 = (acc[r][0] - mean) * rs * lg[0] + lb[0], y1 = (acc[r][1] - mean) * rs * lg[1] + lb[1];
                *(unsigned*)(O + (size_t)(tok0 + g * 8 + r) * D + c2) = cvt_pk_bf16(y0 * sigmoidf_(y0), y1 * sigmoidf_(y1)); }
            __syncthreads();
        }
    }
}

__device__ __forceinline__ void ph_router_prep(const Frame& F) {
    const Args& A = *F.a; bf16_t* rwf = (bf16_t*)(F.ws + WS_RWF); float* rbias = (float*)(F.ws + WS_RBIAS);
    for (int it = F.blk; it < 8 * 64; it += F.G) {
        const int lb = it >> 6, s = it & 63, l = lb >> 2, b = lb & 3, hh = F.tid >> 8, e = (F.tid >> 3) & 31, j = F.tid & 7, k = 16 * s + 8 * hh + j;
        const float v = GPTR(const float, A.in[I_N2G])[l * D + k] * (1.0f + modp(F, l, b, 4)[k]) * GPTR(const float, A.in[I_RW])[(size_t)l * D * NE + k * NE + e];
        const unsigned hi = cvt_pk_bf16(v, 0.f) & 0xffffu; const float rem = v - bflo(hi); const unsigned lo = cvt_pk_bf16(rem, 0.f) & 0xffffu;
        const size_t o = ((size_t)lb * 2 * 64 * 2 * 32 + ((size_t)s * 2 + hh) * 32 + e) * 8 + j;
        rwf[o] = (bf16_t)hi; rwf[o + (size_t)64 * 2 * 32 * 8] = (bf16_t)lo;
    }
    if (F.blk < 8) { const int l = F.blk >> 2, b = F.blk & 3, e = F.tid >> 4, q = F.tid & 15; float s = 0.f;
        for (int k = q; k < D; k += 16) s += modp(F, l, b, 3)[k] * GPTR(const float, A.in[I_RW])[(size_t)l * D * NE + k * NE + e];
        s += __shfl_xor(s, 8); s += __shfl_xor(s, 4); s += __shfl_xor(s, 2); s += __shfl_xor(s, 1);
        if (q == 0) rbias[F.blk * NE + e] = s + GPTR(const float, A.in[I_RB])[l * NE + e]; }
}

__device__ __forceinline__ void moe_layout(const Frame& F, int l, LAS int* tab, LAS int* fb) {
    const unsigned* tot = (const unsigned*)(F.ws + WS_MOETOT) + l * NE;
    LAS int* nbv = fb + 40;
    if (F.tid < NE) nbv[F.tid] = (int)((tot[F.tid] + EBLK - 1) / EBLK);
    __syncthreads();
    if (F.tid <= NE) { int s = 0; for (int e = 0; e < F.tid; ++e) s += nbv[e]; fb[F.tid] = s; if (F.tid == NE && tab) tab[0] = s; }
    __syncthreads();
    if (tab) for (int i = F.tid; i < MAXBLK; i += NTHR) { int e = 0;
#pragma unroll 1
        for (int q = 1; q < NE; ++q) e = (i >= fb[q]) ? q : e;
        tab[1 + i] = e; }
    __syncthreads();
}

__device__ __forceinline__ void ph_router(const Frame& F, int l) {
    const Args& A = *F.a; const bf16_t* X = (const bf16_t*)(F.ws + WS_X); bf16_t* HA = (bf16_t*)(F.ws + WS_HA);
    const int ntok_blk = NTOK / F.G, tok0 = F.blk * ntok_blk, b = tok0 / SEQ;
    LAS unsigned char* wl_ = F.lds;
    LAS int* cnt = (LAS int*)(F.lds + 131072 + 2304);
    LAS float* cx = (LAS float*)(F.lds + 135168);
    LAS float* sq = (LAS float*)(F.lds + 135168 + 16384);
    { const u32x4* src = (const u32x4*)(F.ws + WS_RWF + (size_t)(l * NB + b) * 131072);
      for (int i = F.tid; i < 131072 / 16; i += NTHR) *(LAS u32x4*)(wl_ + i * 16) = src[i]; }
    if (F.tid < NE) cnt[F.tid] = 0;
    __syncthreads();
    const int w = F.wave, lane = F.lane, grp = w & 3, kh = w >> 2, r = lane & 31, hi = lane >> 5;
    {
        const bf16_t* xr = X + (size_t)(tok0 + grp * 32 + r) * D + kh * 512 + hi * 8;
        const LAS unsigned char* bw = wl_ + ((kh * 32 * 2 + hi) * 32 + r) * 16;
        f32x16 acc;
#pragma unroll
        for (int i = 0; i < 16; ++i) acc[i] = 0.f;
        float ssq = 0.f;
        u32x4 xa[8], xb[8];
#define RT_LD(dst, s0) do { _Pragma("unroll") for (int u = 0; u < 8; ++u) dst[u] = *(const u32x4*)(xr + ((s0) + u) * 16); } while (0)
#define RT_DO(src, s0) do { _Pragma("unroll") for (int u = 0; u < 8; ++u) { const u32x4 xw = src[u]; \
            { const float a0 = bflo(xw.x), a1 = bfhi(xw.x), a2 = bflo(xw.y), a3 = bfhi(xw.y), a4 = bflo(xw.z), a5 = bfhi(xw.z), a6 = bflo(xw.w), a7 = bfhi(xw.w); \
              ssq += (a0 * a0 + a1 * a1) + (a2 * a2 + a3 * a3) + (a4 * a4 + a5 * a5) + (a6 * a6 + a7 * a7); } \
            const bf16x8 ah = *(const bf16x8*)&xw; \
            const bf16x8 bh = *(const LAS bf16x8*)(bw + ((s0) + u) * 1024), bl = *(const LAS bf16x8*)(bw + ((s0) + u) * 1024 + 65536); \
            acc = __builtin_amdgcn_mfma_f32_32x32x16_bf16(ah, bh, acc, 0, 0, 0); acc = __builtin_amdgcn_mfma_f32_32x32x16_bf16(ah, bl, acc, 0, 0, 0); } } while (0)
        RT_LD(xa, 0);
#pragma unroll 1
        for (int s0 = 0; s0 < 32; s0 += 16) { RT_LD(xb, s0 + 8); RT_DO(xa, s0); if (s0 + 16 < 32) RT_LD(xa, s0 + 16); RT_DO(xb, s0 + 8); }
#undef RT_LD
#undef RT_DO
        sq[(grp * 32 + r) * 4 + kh * 2 + hi] = ssq;
        if (kh == 1) { LAS float* c = cx + (grp * 64 + lane) * 16;
#pragma unroll
            for (int i = 0; i < 4; ++i) *(LAS f32x4*)(c + i * 4) = (f32x4){acc[4 * i], acc[4 * i + 1], acc[4 * i + 2], acc[4 * i + 3]}; }
        __syncthreads();
        if (kh == 0) { const LAS float* c = cx + (grp * 64 + lane) * 16;
#pragma unroll
            for (int i = 0; i < 4; ++i) { const f32x4 p = *(const LAS f32x4*)(c + i * 4); acc[4 * i] += p[0]; acc[4 * i + 1] += p[1]; acc[4 * i + 2] += p[2]; acc[4 * i + 3] += p[3]; } }
        __syncthreads();
        if (kh == 0) {
#pragma unroll
            for (int i = 0; i < 16; ++i) cx[(grp * 32 + (i & 3) + 8 * (i >> 2) + 4 * hi) * 32 + r] = acc[i]; }
        __syncthreads();
    }
    float* gate = (float*)(F.ws + WS_GATE);
    LAS int* asg_e = (LAS int*)(F.lds + 155648); LAS int* asg_r = asg_e + 512; LAS int* basel = asg_r + 512;
    if (F.tid < 128) {
        const int row = tok0 + F.tid; const f32x4 q4 = *(const LAS f32x4*)(sq + F.tid * 4);
        const float rs = rsqrtf(((q4[0] + q4[1]) + (q4[2] + q4[3])) * (1.0f / D) + EPS); sq[512 + F.tid] = rs;
        const float* bias = (const float*)(F.ws + WS_RBIAS) + (l * NB + b) * NE;
        float lg[NE];
#pragma unroll
        for (int i = 0; i < 8; ++i) { const f32x4 c = *(const LAS f32x4*)(cx + F.tid * 32 + i * 4), bb = *(const f32x4*)(bias + i * 4);
            lg[4 * i] = c[0] * rs + bb[0]; lg[4 * i + 1] = c[1] * rs + bb[1]; lg[4 * i + 2] = c[2] * rs + bb[2]; lg[4 * i + 3] = c[3] * rs + bb[3]; }
        float tv[4]; int ti[4];
#pragma unroll
        for (int k = 0; k < 4; ++k) { float bv = lg[0]; int bi = 0;
#pragma unroll
            for (int e2 = 1; e2 < NE; ++e2) { if (lg[e2] > bv) { bv = lg[e2]; bi = e2; } }
            tv[k] = bv; ti[k] = bi;
#pragma unroll
            for (int e2 = 0; e2 < NE; ++e2) lg[e2] = (e2 == bi) ? -__builtin_inff() : lg[e2]; }
        const float e1 = __expf(tv[1] - tv[0]), e2 = __expf(tv[2] - tv[0]), e3 = __expf(tv[3] - tv[0]), inv = 1.0f / (1.0f + e1 + e2 + e3);
        *(f32x4*)(gate + (size_t)row * 4) = (f32x4){inv, e1 * inv, e2 * inv, e3 * inv};
        int4 tq, rq; tq.x = ti[0]; tq.y = ti[1]; tq.z = ti[2]; tq.w = ti[3];
        rq.x = __hip_atomic_fetch_add(&cnt[ti[0]], 1, __ATOMIC_RELAXED, __HIP_MEMORY_SCOPE_WORKGROUP); rq.y = __hip_atomic_fetch_add(&cnt[ti[1]], 1, __ATOMIC_RELAXED, __HIP_MEMORY_SCOPE_WORKGROUP);
        rq.z = __hip_atomic_fetch_add(&cnt[ti[2]], 1, __ATOMIC_RELAXED, __HIP_MEMORY_SCOPE_WORKGROUP); rq.w = __hip_atomic_fetch_add(&cnt[ti[3]], 1, __ATOMIC_RELAXED, __HIP_MEMORY_SCOPE_WORKGROUP);
        asg_e[F.tid * 4] = tq.x; asg_e[F.tid * 4 + 1] = tq.y; asg_e[F.tid * 4 + 2] = tq.z; asg_e[F.tid * 4 + 3] = tq.w;
        asg_r[F.tid * 4] = rq.x; asg_r[F.tid * 4 + 1] = rq.y; asg_r[F.tid * 4 + 2] = rq.z; asg_r[F.tid * 4 + 3] = rq.w;
    }
    __syncthreads();
    if (F.tid < NE) basel[F.tid] = (int)__hip_atomic_fetch_add((unsigned*)(F.ws + WS_MOETOT) + l * NE + F.tid, (unsigned)cnt[F.tid], __ATOMIC_RELAXED, __HIP_MEMORY_SCOPE_AGENT);
    __syncthreads();
    { int* slotp = (int*)(F.ws + WS_SLOT); int* rowtab2 = (int*)(F.ws + WS_ROWTAB2);
      for (int it = F.tid; it < ntok_blk * 4 * 8; it += NTHR) { const int a = it >> 3, c8 = it & 7, e = asg_e[a], gr = basel[e] + asg_r[a];
          if (c8 == 0) slotp[(size_t)tok0 * 4 + a] = e * 32768 + gr;
          const int blk = gr >> 8, r = gr & 255, hh = r >> 7, R = r & 127, bb = pg8::lds_byte(R, c8 * 8), pi = bb >> 13, lt = (bb & 8191) >> 4;
          rowtab2[((((size_t)e * 128 + blk) * 512 + lt) * 2 + hh) * 2 + pi] = tok0 + (a >> 2); } }
    { const float* g = GPTR(const float, A.in[I_N2G]) + l * D; f32x4 gv[4], sh[4], sc[4];
      row_ld16(g, F.lane, gv); row_ld16(modp(F, l, b, 3), F.lane, sh); row_ld16(modp(F, l, b, 4), F.lane, sc);
#pragma unroll
      for (int i = 0; i < 4; ++i) gv[i] = gv[i] * (sc[i] + 1.0f);
      for (int it = F.wave; it < ntok_blk; it += 2 * NWAVE) { const bool two = it + NWAVE < ntok_blk;
          u32x2 w0[4], w1[4];
#pragma unroll
          for (int i = 0; i < 4; ++i) { w0[i] = *(const u32x2*)(X + (size_t)(tok0 + it) * D + i * 256 + F.lane * 4); if (two) w1[i] = *(const u32x2*)(X + (size_t)(tok0 + it + NWAVE) * D + i * 256 + F.lane * 4); }
          const float r0 = sq[512 + it], r1 = two ? sq[512 + it + NWAVE] : 0.f;
          f32x4 v0[4], v1[4];
#pragma unroll
          for (int i = 0; i < 4; ++i) v0[i] = (f32x4){bflo(w0[i].x), bfhi(w0[i].x), bflo(w0[i].y), bfhi(w0[i].y)} * r0 * gv[i] + sh[i];
          row_st16_bf16(HA + (size_t)(tok0 + it) * D, F.lane, v0);
          if (two) {
#pragma unroll
              for (int i = 0; i < 4; ++i) v1[i] = (f32x4){bflo(w1[i].x), bfhi(w1[i].x), bflo(w1[i].y), bfhi(w1[i].y)} * r1 * gv[i] + sh[i];
              row_st16_bf16(HA + (size_t)(tok0 + it + NWAVE) * D, F.lane, v1); } } }
    __syncthreads();
}

__device__ __forceinline__ void ph_combine(const Frame& F, int l, const LAS int* fbk) {
    const Args& A = *F.a; const bf16_t* X = (const bf16_t*)(F.ws + WS_X); bf16_t* XO = (bf16_t*)(F.ws + WS_X2); const bf16_t* Y = (const bf16_t*)(F.ws + WS_XG);
    const int* slot = (const int*)(F.ws + WS_SLOT); const float* gate = (const float*)(F.ws + WS_GATE);

    const int stride = F.G * NWAVE; int row = F.blk * NWAVE + F.wave;
    if (row >= NTOK) return;
    int4 sq_c = *(const int4*)(slot + (size_t)row * 4); f32x4 gq_c = *(const f32x4*)(gate + (size_t)row * 4);
    int4 sq_n = sq_c; f32x4 gq_n = gq_c;
    if (row + stride < NTOK) { sq_n = *(const int4*)(slot + (size_t)(row + stride) * 4); gq_n = *(const f32x4*)(gate + (size_t)(row + stride) * 4); }
    u32x4 yc[4][2], yn[4][2]; f32x4 xc[4], xn[4];
#define CMB_LOAD(yv, xq, sq, r_) do { const int ss_[4] = {fbk[sq.x >> 15] * EBLK + (sq.x & 32767), fbk[sq.y >> 15] * EBLK + (sq.y & 32767), fbk[sq.z >> 15] * EBLK + (sq.z & 32767), fbk[sq.w >> 15] * EBLK + (sq.w & 32767)}; \
        _Pragma("unroll") for (int k = 0; k < 4; ++k) _Pragma("unroll") for (int i = 0; i < 2; ++i) yv[k][i] = *(const u32x4*)(Y + (size_t)ss_[k] * D + i * 512 + F.lane * 8); \
        _Pragma("unroll") for (int i = 0; i < 2; ++i) { const u32x4 xw_ = *(const u32x4*)(X + (size_t)(r_) * D + i * 512 + F.lane * 8); \
            xq[i * 2] = (f32x4){bflo(xw_.x), bfhi(xw_.x), bflo(xw_.y), bfhi(xw_.y)}; xq[i * 2 + 1] = (f32x4){bflo(xw_.z), bfhi(xw_.z), bflo(xw_.w), bfhi(xw_.w)}; } } while (0)
    CMB_LOAD(yc, xc, sq_c, row);
    for (; row < NTOK; row += stride) {
        const int b = row / SEQ; const bool has_n = row + stride < NTOK;
        const f32x4 gq = gq_c;
        if (has_n) CMB_LOAD(yn, xn, sq_n, row + stride);
        int4 sq_nn = sq_n; f32x4 gq_nn = gq_n;
        if (row + 2 * stride < NTOK) { sq_nn = *(const int4*)(slot + (size_t)(row + 2 * stride) * 4); gq_nn = *(const f32x4*)(gate + (size_t)(row + 2 * stride) * 4); }
        float acc[16];
#pragma unroll
        for (int i = 0; i < 16; ++i) acc[i] = 0.f;
#pragma unroll
        for (int k = 0; k < 4; ++k) { const float gk = gq[k];
#pragma unroll
            for (int i = 0; i < 2; ++i) { const u32x4 w = yc[k][i];
                acc[i * 8 + 0] += gk * bflo(w.x); acc[i * 8 + 1] += gk * bfhi(w.x); acc[i * 8 + 2] += gk * bflo(w.y); acc[i * 8 + 3] += gk * bfhi(w.y);
                acc[i * 8 + 4] += gk * bflo(w.z); acc[i * 8 + 5] += gk * bfhi(w.z); acc[i * 8 + 6] += gk * bflo(w.w); acc[i * 8 + 7] += gk * bfhi(w.w); } }
        const float* g2 = modp(F, l, b, 5);
        float xv[16]; float ssq = 0.f;
#pragma unroll
        for (int i = 0; i < 2; ++i)
#pragma unroll
            for (int h = 0; h < 2; ++h) { const int c = i * 512 + F.lane * 8 + h * 4; const f32x4 x0 = xc[i * 2 + h], gg = *(const f32x4*)(g2 + c);
#pragma unroll
                for (int j = 0; j < 4; ++j) { const float x = x0[j] + gg[j] * acc[i * 8 + h * 4 + j]; xv[i * 8 + h * 4 + j] = x; ssq += x * x; } }
        ssq = wave_sum(ssq); const float rs = rsqrtf(ssq * (1.0f / D) + EPS);
        if (l == 0) {
            bf16_t* HB = (bf16_t*)(F.ws + WS_HB); bf16_t* HA = (bf16_t*)(F.ws + WS_HA);
            const float* kvg = GPTR(const float, A.in[I_KVG]); const float* g1 = GPTR(const float, A.in[I_N1G]) + D; const float* sh = modp(F, 1, b, 0); const float* sc = modp(F, 1, b, 1);
#pragma unroll
            for (int i = 0; i < 2; ++i) { const int c = i * 512 + F.lane * 8; float o1[8], o2[8];
#pragma unroll
                for (int h = 0; h < 2; ++h) { const f32x4 kg = *(const f32x4*)(kvg + c + h * 4), gg = *(const f32x4*)(g1 + c + h * 4), s1 = *(const f32x4*)(sh + c + h * 4), s2 = *(const f32x4*)(sc + c + h * 4);
#pragma unroll
                    for (int j = 0; j < 4; ++j) { const float xh = xv[i * 8 + h * 4 + j] * rs; o1[h * 4 + j] = xh * kg[j]; o2[h * 4 + j] = xh * gg[j] * (s2[j] + 1.0f) + s1[j]; } }
                u32x4 w1, w2; w1.x = cvt_pk_bf16(o1[0], o1[1]); w1.y = cvt_pk_bf16(o1[2], o1[3]); w1.z = cvt_pk_bf16(o1[4], o1[5]); w1.w = cvt_pk_bf16(o1[6], o1[7]);
                w2.x = cvt_pk_bf16(o2[0], o2[1]); w2.y = cvt_pk_bf16(o2[2], o2[3]); w2.z = cvt_pk_bf16(o2[4], o2[5]); w2.w = cvt_pk_bf16(o2[6], o2[7]);
                u32x4 w0; w0.x = cvt_pk_bf16(xv[i * 8], xv[i * 8 + 1]); w0.y = cvt_pk_bf16(xv[i * 8 + 2], xv[i * 8 + 3]); w0.z = cvt_pk_bf16(xv[i * 8 + 4], xv[i * 8 + 5]); w0.w = cvt_pk_bf16(xv[i * 8 + 6], xv[i * 8 + 7]);
                *(u32x4*)(XO + (size_t)row * D + c) = w0; *(u32x4*)(HB + (size_t)row * D + c) = w1; *(u32x4*)(HA + (size_t)row * D + c) = w2; }
        } else {
            const float* fg = GPTR(const float, A.in[I_FG]);
#pragma unroll
            for (int i = 0; i < 2; ++i)
#pragma unroll
                for (int h = 0; h < 2; ++h) { const int c = i * 512 + F.lane * 8 + h * 4; const f32x4 gg = *(const f32x4*)(fg + c);
                    *(f32x4*)(GPTR(float, A.out) + (size_t)row * D + c) = (f32x4){xv[i * 8 + h * 4] * rs * gg[0], xv[i * 8 + h * 4 + 1] * rs * gg[1], xv[i * 8 + h * 4 + 2] * rs * gg[2], xv[i * 8 + h * 4 + 3] * rs * gg[3]}; }
        }
#pragma unroll
        for (int k = 0; k < 4; ++k) { yc[k][0] = yn[k][0]; yc[k][1] = yn[k][1]; xc[k] = xn[k]; }
        sq_c = sq_n; gq_c = gq_n; sq_n = sq_nn; gq_n = gq_nn;
    }
#undef CMB_LOAD
}

__device__ __forceinline__ void ph_latpost(const Frame& F) {
    const Args& A = *F.a; const float* LAT = (const float*)(F.ws + WS_LAT); const float* CQP = (const float*)(F.ws + WS_CQP);
    bf16_t* CKV = (bf16_t*)(F.ws + WS_CKV); bf16_t* KR = (bf16_t*)(F.ws + WS_KR); bf16_t* CQ = (bf16_t*)(F.ws + WS_CQ); const f32x2* cs = (const f32x2*)(F.ws + WS_CS);
    for (int row = F.blk * NWAVE + F.wave; row < NTOK; row += F.G * NWAVE) {
        const float* lr = LAT + (size_t)row * 512;
        { const f32x4 v = *(const f32x4*)(lr + F.lane * 4), g = *(const f32x4*)(GPTR(const float, A.in[I_CKVG]) + F.lane * 4);
          float s = wave_sum(v[0] * v[0] + v[1] * v[1] + v[2] * v[2] + v[3] * v[3]); const float rs = rsqrtf(s * (1.0f / KVLORA) + EPS);
          u32x2 w; w.x = cvt_pk_bf16(v[0] * rs * g[0], v[1] * rs * g[1]); w.y = cvt_pk_bf16(v[2] * rs * g[2], v[3] * rs * g[3]); *(u32x2*)(CKV + (size_t)row * KVLORA + F.lane * 4) = w; }
        if (F.lane < 32) { const int i = F.lane; const float x1 = lr[KVLORA + i], x2 = lr[KVLORA + 32 + i]; const f32x2 t = cs[(size_t)row * 32 + i];
          const float r1 = x1 * t[0] - x2 * t[1], r2 = x2 * t[0] + x1 * t[1]; const int p = (i >> 2) * 8 + (i & 3);
          KR[(size_t)row * DROPE + p] = (bf16_t)(cvt_pk_bf16(r1, r1) & 0xffffu); KR[(size_t)row * DROPE + p + 4] = (bf16_t)(cvt_pk_bf16(r2, r2) & 0xffffu); }
        { const float* qr = CQP + (size_t)row * 512; f32x2 v[3]; float s = 0.f;
#pragma unroll
          for (int i = 0; i < 3; ++i) { v[i] = *(const f32x2*)(qr + i * 128 + F.lane * 2); s += v[i][0] * v[i][0] + v[i][1] * v[i][1]; }
          s = wave_sum(s); const float rs = rsqrtf(s * (1.0f / QLORA) + EPS);
#pragma unroll
          for (int i = 0; i < 3; ++i) { const f32x2 g = *(const f32x2*)(GPTR(const float, A.in[I_CQG]) + i * 128 + F.lane * 2);
              *(unsigned*)(CQ + (size_t)row * QLORA + i * 128 + F.lane * 2) = cvt_pk_bf16(v[i][0] * rs * g[0], v[i][1] * rs * g[1]); } }
    }
}
constexpr int AT_KB = 24576, AT_VB0 = 49152, AT_VB = 16384;
#define AT_UPTR(p) ({ const GAS char* p_ = (const GAS char*)(p); asm volatile("" : "+s"(p_)); p_; })
#define AT_BAR() do { asm volatile("s_waitcnt lgkmcnt(0)" ::: "memory"); __builtin_amdgcn_s_barrier(); asm volatile("" ::: "memory"); } while (0)
#define AT_SB() __builtin_amdgcn_sched_barrier(0x6)
__device__ __forceinline__ void at_glds16(unsigned voff, const GAS char* sbase, unsigned lds_dst) {
    unsigned keep;
    asm volatile("s_mov_b32 %0, m0\n\ts_mov_b32 m0, %3\n\ts_nop 0\n\tglobal_load_lds_dwordx4 %1, %2\n\ts_mov_b32 m0, %0" : "=&s"(keep) : "v"(voff), "s"(sbase), "s"(lds_dst) : "memory");
}
#define AT_GLDS(sbase, voff, dstoff) at_glds16((voff), (sbase), ldsb_ + (unsigned)(dstoff))

__device__ __forceinline__ int swap23(int k) { return (k & ~0xC) | ((k & 4) << 1) | ((k & 8) >> 1); }

#if !NAIVE_ATTN
template <int VAR>
__device__ __forceinline__ void ph_attn(const Frame& F) {
    const char* Qg = (const char*)(F.ws + WS_Q); const char* KNg = (const char*)(F.ws + WS_KN); const char* KRg = (const char*)(F.ws + WS_KR); const char* VTg = (const char*)(F.ws + WS_VT);
    bf16_t* Og = (bf16_t*)(F.ws + (VAR == 0 ? WS_HC : WS_HB));
    const int lane = F.lane, w = F.wave, r32 = lane & 31, hi = lane >> 5;
    const unsigned ldsb_ = (unsigned)(size_t)F.lds;
    unsigned offK[3], offVt[2];
#pragma unroll
    for (int i = 0; i < 3; ++i) { const int g = (i * 8 + w) * 64 + lane, d0 = g >> 7, rho = (g & 127) >> 1, hh = (g & 1) ^ ((rho >> 3) & 1), key = swap23(rho);
        offK[i] = d0 < 8 ? (unsigned)key * 2048u + (unsigned)(d0 * 32 + hh * 16) : (unsigned)key * 128u + (unsigned)((d0 - 8) * 32 + hh * 16); }
#pragma unroll
    for (int i = 0; i < 2; ++i) { const int g = (i * 8 + w) * 64 + lane, ks = g >> 8, d = (g & 255) >> 1, hh = (g & 1) ^ ((d >> 3) & 1);
        offVt[i] = (unsigned)d * (unsigned)(NTOK * 2) + (unsigned)(ks * 32 + hh * 16); }
    const int rdoff = r32 * 32 + ((hi ^ ((r32 >> 3) & 1)) << 4);
    for (int item = F.blk; item < 512; item += F.G) {
        const int xcd = item & 7, kk = item >> 3, bh = xcd * 4 + (kk >> 4), x = kk & 15, b = bh >> 3, h = bh & 7;
#pragma unroll 1
        for (int pass = 0; pass < 2; ++pass) {
            const int j = pass ? 31 - x : x, NT = 4 * j + 4, cw = 4 * j + (w >> 1);
            const size_t tokb = (size_t)b * SEQ;
            const char* knb = KNg + tokb * 2048 + h * 256; const char* krb = KRg + tokb * 128; const char* vtb = VTg + ((size_t)h * 128 * NTOK + tokb) * 2;
            bf16x8 qr[12];
            { const GAS char* qp = AT_UPTR(Qg + (tokb + (size_t)j * 256 + w * 32) * (NH * DQK * 2) + h * (DQK * 2)) + (unsigned)(r32 * (NH * DQK * 2) + hi * 16);
#pragma unroll
              for (int d0 = 0; d0 < 12; ++d0) qr[d0] = *(const bf16x8*)(qp + d0 * 32);
              const float* csr = (const float*)(AT_UPTR((const float*)(F.ws + WS_CS) + (tokb + (size_t)j * 256 + w * 32) * 64) + (unsigned)(r32 * 256));
#pragma unroll
              for (int dd = 0; dd < 4; ++dd) { const int k4 = (dd * 2 + hi) * 4; const f32x4 t0 = *(const f32x4*)(csr + 2 * k4), t1 = *(const f32x4*)(csr + 2 * k4 + 4);
                  const u32x4 wq = *(const u32x4*)&qr[8 + dd];
                  const float x1[4] = {bflo(wq.x), bfhi(wq.x), bflo(wq.y), bfhi(wq.y)}, x2[4] = {bflo(wq.z), bfhi(wq.z), bflo(wq.w), bfhi(wq.w)};
                  const float co[4] = {t0[0], t0[2], t1[0], t1[2]}, si[4] = {t0[1], t0[3], t1[1], t1[3]}; float r1[4], r2[4];
#pragma unroll
                  for (int jj = 0; jj < 4; ++jj) { r1[jj] = x1[jj] * co[jj] - x2[jj] * si[jj]; r2[jj] = x2[jj] * co[jj] + x1[jj] * si[jj]; }
                  u32x4 wo = {cvt_pk_bf16(r1[0], r1[1]), cvt_pk_bf16(r1[2], r1[3]), cvt_pk_bf16(r2[0], r2[1]), cvt_pk_bf16(r2[2], r2[3])}; qr[8 + dd] = *(bf16x8*)&wo; } }
            f32x16 o[4];
#pragma unroll
            for (int d0 = 0; d0 < 4; ++d0)
#pragma unroll
                for (int r = 0; r < 16; ++r) o[d0][r] = 0.f;
            float m_run = -1e30f, l_run = 0.f;
#define AT_ISSUE_K(t, st) do { const int t_ = (t); \
                const GAS char* kp_ = AT_UPTR(knb + (size_t)t_ * (64 * 2048)); const GAS char* rp_ = AT_UPTR(krb + (size_t)t_ * (64 * 128)); \
                AT_GLDS(kp_, offK[0], (st) + w * 1024); AT_GLDS(kp_, offK[1], (st) + (8 + w) * 1024); \
                AT_GLDS(rp_, offK[2], (st) + (16 + w) * 1024); } while (0)
#define AT_ISSUE_V(t, st) do { const int t_ = (t); \
                const GAS char* vp_ = AT_UPTR(vtb + (size_t)t_ * 128); \
                AT_GLDS(vp_, offVt[0], AT_VB0 + (st) + w * 1024); AT_GLDS(vp_, offVt[1], AT_VB0 + (st) + (8 + w) * 1024); } while (0)
#define AT_DSRD(dst, ad, off) asm volatile("ds_read_b128 %0, %1 offset:%2" : "=v"(dst) : "v"(ad), "i"(off))
#define AT_LGKM(n) asm volatile("s_waitcnt lgkmcnt(%0)" :: "i"(n))
#define AT_SB0() __builtin_amdgcn_sched_barrier(0)
#define AT_KR(d_, x0, x1) do { AT_DSRD(x0, kad_, (d_) * 2048); AT_DSRD(x1, kad_, (d_) * 2048 + 1024); } while (0)
#define AT_MM(x0, x1, q_, PN0, PN1) do { AT_SB0(); __builtin_amdgcn_s_setprio(1); PN0 = __builtin_amdgcn_mfma_f32_32x32x16_bf16(x0, q_, PN0, 0, 0, 0); PN1 = __builtin_amdgcn_mfma_f32_32x32x16_bf16(x1, q_, PN1, 0, 0, 0); __builtin_amdgcn_s_setprio(0); AT_SB0(); } while (0)
#define AT_E1(PC0, PC1, e_) do { if ((e_) < 16) { PC0[(e_) & 15] = __builtin_amdgcn_exp2f(PC0[(e_) & 15] - m_run); ps_ += PC0[(e_) & 15]; } else if ((e_) < 32) { PC1[(e_) & 15] = __builtin_amdgcn_exp2f(PC1[(e_) & 15] - m_run); ps_ += PC1[(e_) & 15]; } } while (0)
#define AT_EX(PC0, PC1, i_) do { if (SM) { AT_E1(PC0, PC1, 3 * (i_)); AT_E1(PC0, PC1, 3 * (i_) + 1); AT_E1(PC0, PC1, 3 * (i_) + 2); } } while (0)
#define AT_QKX(st, P0, P1) do { \
                const unsigned kad_ = (unsigned)(size_t)((const LAS char*)F.lds + (st) + rdoff); \
                bf16x8 ka0, ka1, kb0, kb1, kc0, kc1; \
                AT_KR(0, ka0, ka1); AT_KR(1, kb0, kb1); \
                _Pragma("unroll") for (int r = 0; r < 16; ++r) { P0[r] = 0.f; P1[r] = 0.f; } \
                AT_KR(2, kc0, kc1); AT_LGKM(4); AT_MM(ka0, ka1, qr[0], P0, P1); \
                AT_KR(3, ka0, ka1); AT_LGKM(4); AT_MM(kb0, kb1, qr[1], P0, P1); \
                AT_KR(4, kb0, kb1); AT_LGKM(4); AT_MM(kc0, kc1, qr[2], P0, P1); \
                AT_KR(5, kc0, kc1); AT_LGKM(4); AT_MM(ka0, ka1, qr[3], P0, P1); \
                AT_KR(6, ka0, ka1); AT_LGKM(4); AT_MM(kb0, kb1, qr[4], P0, P1); \
                AT_KR(7, kb0, kb1); AT_LGKM(4); AT_MM(kc0, kc1, qr[5], P0, P1); \
                AT_KR(8, kc0, kc1); AT_LGKM(4); AT_MM(ka0, ka1, qr[6], P0, P1); \
                AT_KR(9, ka0, ka1); AT_LGKM(4); AT_MM(kb0, kb1, qr[7], P0, P1); \
                AT_KR(10, kb0, kb1); AT_LGKM(4); AT_MM(kc0, kc1, qr[8], P0, P1); \
                AT_KR(11, kc0, kc1); AT_LGKM(4); AT_MM(ka0, ka1, qr[9], P0, P1); \
                AT_LGKM(2); AT_MM(kb0, kb1, qr[10], P0, P1); \
                AT_LGKM(0); AT_MM(kc0, kc1, qr[11], P0, P1); } while (0)
#define AT_VR(ks_, v0, v1, v2, v3) do { AT_DSRD(v0, vad_, (ks_) * 4096); AT_DSRD(v1, vad_, (ks_) * 4096 + 1024); AT_DSRD(v2, vad_, (ks_) * 4096 + 2048); AT_DSRD(v3, vad_, (ks_) * 4096 + 3072); } while (0)
#define AT_PF(PX, b8) ({ u32x4 tp_ = {cvt_pk_bf16(PX[b8], PX[b8 + 1]), cvt_pk_bf16(PX[b8 + 2], PX[b8 + 3]), cvt_pk_bf16(PX[b8 + 4], PX[b8 + 5]), cvt_pk_bf16(PX[b8 + 6], PX[b8 + 7])}; *(bf16x8*)&tp_; })
#define AT_M4(pf_, v0, v1, v2, v3) do { AT_SB0(); __builtin_amdgcn_s_setprio(1); o[0] = __builtin_amdgcn_mfma_f32_32x32x16_bf16(v0, pf_, o[0], 0, 0, 0); o[1] = __builtin_amdgcn_mfma_f32_32x32x16_bf16(v1, pf_, o[1], 0, 0, 0); \
                o[2] = __builtin_amdgcn_mfma_f32_32x32x16_bf16(v2, pf_, o[2], 0, 0, 0); o[3] = __builtin_amdgcn_mfma_f32_32x32x16_bf16(v3, pf_, o[3], 0, 0, 0); __builtin_amdgcn_s_setprio(0); AT_SB0(); } while (0)
#define AT_MX8(PX, b8) do { _Pragma("unroll") for (int r = 0; r < 8; ++r) mxn_ = fmaxf(mxn_, PX[(b8) + r]); } while (0)
#define AT_PVX(st, PC0, PC1) do { const unsigned vad_ = (unsigned)(size_t)((const LAS char*)F.lds + AT_VB0 + (st) + rdoff); \
                bf16x8 va0, va1, va2, va3, vb0, vb1, vb2, vb3, pf_; \
                AT_VR(0, va0, va1, va2, va3); AT_VR(1, vb0, vb1, vb2, vb3); pf_ = AT_PF(PC0, 0); AT_LGKM(4); AT_M4(pf_, va0, va1, va2, va3); \
                AT_VR(2, va0, va1, va2, va3); pf_ = AT_PF(PC0, 8); AT_LGKM(4); AT_M4(pf_, vb0, vb1, vb2, vb3); \
                AT_VR(3, vb0, vb1, vb2, vb3); pf_ = AT_PF(PC1, 0); AT_LGKM(4); AT_M4(pf_, va0, va1, va2, va3); \
                pf_ = AT_PF(PC1, 8); AT_LGKM(0); AT_M4(pf_, vb0, vb1, vb2, vb3); } while (0)
#define AT_SMAX(P0, P1) do { \
                float mx = P0[0]; _Pragma("unroll") for (int r = 1; r < 16; ++r) mx = fmaxf(mx, P0[r]); _Pragma("unroll") for (int r = 0; r < 16; ++r) mx = fmaxf(mx, P1[r]); \
                mx = fmaxf(mx, __shfl_xor(mx, 32)); \
                if (!__all(mx - m_run <= 11.0f)) { const float mn = fmaxf(m_run, mx), al = __builtin_amdgcn_exp2f(m_run - mn); m_run = mn; l_run *= al; \
                    _Pragma("unroll") for (int d0 = 0; d0 < 4; ++d0) _Pragma("unroll") for (int r = 0; r < 16; ++r) o[d0][r] *= al; } } while (0)
#define AT_SEXP(P0, P1) do { \
                float ps = 0.f; \
                _Pragma("unroll") for (int r = 0; r < 16; ++r) { P0[r] = __builtin_amdgcn_exp2f(P0[r] - m_run); P1[r] = __builtin_amdgcn_exp2f(P1[r] - m_run); ps += P0[r] + P1[r]; } \
                l_run += ps; } while (0)
#define AT_STEP(t, st) do { \
                if (VAR != 1 && VAR != 6 && VAR != 7 && (t) + 1 < NT) { AT_ISSUE_K((t) + 1, (1 - (st)) * AT_KB); AT_ISSUE_V((t) + 1, (1 - (st)) * AT_VB); } \
                if (VAR != 2 && (t) <= cw) { f32x16 p0, p1; if (VAR != 5 && VAR != 7) AT_QKX((st) * AT_KB, p0, p1); else { _Pragma("unroll") for (int r = 0; r < 16; ++r) { p0[r] = m_run; p1[r] = l_run; } } \
                    if (VAR == 0 || VAR == 1) { AT_SMAX(p0, p1); AT_SEXP(p0, p1); } if (VAR != 4 && VAR != 6) AT_PVX((st) * AT_VB, p0, p1); else { m_run += p0[3] + p1[5]; } } \
                asm volatile("s_waitcnt vmcnt(0)" ::: "memory"); AT_BAR(); } while (0)
            AT_ISSUE_K(0, 0); AT_ISSUE_V(0, 0);
            asm volatile("s_waitcnt vmcnt(0)" ::: "memory"); AT_BAR();
#pragma unroll 1
            for (int t = 0; t < NT; t += 2) {
                AT_STEP(t, 0);
                AT_STEP(t + 1, 1);
            }
#undef AT_ISSUE_K
#undef AT_ISSUE_V
#undef AT_STEP
            const float lt = l_run + __shfl_xor(l_run, 32), inv = 1.0f / lt;
            bf16_t* op = (bf16_t*)(AT_UPTR(Og + (tokb + (size_t)j * 256 + w * 32) * D + h * DV) + (unsigned)(r32 * (D * 2) + 8 * hi));
#pragma unroll
            for (int d0 = 0; d0 < 4; ++d0)
#pragma unroll
                for (int g4 = 0; g4 < 4; ++g4) { u32x2 wv; wv.x = cvt_pk_bf16(o[d0][4 * g4] * inv, o[d0][4 * g4 + 1] * inv); wv.y = cvt_pk_bf16(o[d0][4 * g4 + 2] * inv, o[d0][4 * g4 + 3] * inv);
                    *(u32x2*)(op + d0 * 32 + 8 * g4) = wv; }
        }
    }
}
#else
template <int VAR>
__device__ __forceinline__ void ph_attn(const Frame& F) {
    const bf16_t* Qg = (const bf16_t*)(F.ws + WS_Q); const bf16_t* KNg = (const bf16_t*)(F.ws + WS_KN); const bf16_t* KRg = (const bf16_t*)(F.ws + WS_KR); const bf16_t* VTg = (const bf16_t*)(F.ws + WS_VT);
    bf16_t* Og = (bf16_t*)(F.ws + WS_HC);
    for (int it = F.blk * NWAVE + F.wave; it < NTOK * NH; it += F.G * NWAVE) {
        const int n = it >> 3, h = it & 7, b = n / SEQ, s = n - b * SEQ, nkb = s / 64 + 1; const size_t tokb = (size_t)b * SEQ;
        const bf16_t* q = Qg + (size_t)n * (NH * DQK) + h * DQK;
        float m = -1e30f, l = 0.f, o0 = 0.f, o1 = 0.f;
        for (int kb = 0; kb < nkb; ++kb) {
            const size_t key = tokb + kb * 64 + F.lane; float sc = 0.f;
            for (int d = 0; d < DNOPE; d += 8) { const u32x4 kv = *(const u32x4*)(KNg + key * D + h * DNOPE + d), qv = *(const u32x4*)(q + d);
                sc += bflo(kv.x) * bflo(qv.x) + bfhi(kv.x) * bfhi(qv.x) + bflo(kv.y) * bflo(qv.y) + bfhi(kv.y) * bfhi(qv.y) + bflo(kv.z) * bflo(qv.z) + bfhi(kv.z) * bfhi(qv.z) + bflo(kv.w) * bflo(qv.w) + bfhi(kv.w) * bfhi(qv.w); }
            for (int d = 0; d < DROPE; d += 8) { const u32x4 kv = *(const u32x4*)(KRg + key * DROPE + d), qv = *(const u32x4*)(q + DNOPE + d);
                sc += bflo(kv.x) * bflo(qv.x) + bfhi(kv.x) * bfhi(qv.x) + bflo(kv.y) * bflo(qv.y) + bfhi(kv.y) * bfhi(qv.y) + bflo(kv.z) * bflo(qv.z) + bfhi(kv.z) * bfhi(qv.z) + bflo(kv.w) * bflo(qv.w) + bfhi(kv.w) * bfhi(qv.w); }
            float mx = sc;
#pragma unroll
            for (int of = 32; of >= 1; of >>= 1) mx = fmaxf(mx, __shfl_xor(mx, of));
            const float mn = fmaxf(m, mx), al = exp2f(m - mn), p = exp2f(sc - mn); m = mn;
            l = l * al + wave_sum(p); o0 *= al; o1 *= al;
            for (int d = 0; d < DV; ++d) { const float v = bf2f(VTg[(size_t)(h * DV + d) * NTOK + key]); const float tot = wave_sum(p * v);
                if (F.lane == (d & 63)) { if (d < 64) o0 += tot; else o1 += tot; } }
        }
        const float inv = 1.0f / l;
        Og[(size_t)n * D + h * DV + F.lane] = (bf16_t)(cvt_pk_bf16(o0 * inv, 0.f) & 0xffffu);
        Og[(size_t)n * D + h * DV + 64 + F.lane] = (bf16_t)(cvt_pk_bf16(o1 * inv, 0.f) & 0xffffu);
    }
}
#endif
constexpr int NPH = 20;
__global__ void __launch_bounds__(NTHR, 2) yoco_fwd(Args args) {
    extern __shared__ __attribute__((aligned(16))) unsigned char lds_raw[];
    Frame F; F.lds = (LAS unsigned char*)lds_raw; F.ws = (GAS unsigned char*)args.ws; F.a = &args;
    F.tid = threadIdx.x; F.lane = F.tid & 63; F.wave = __builtin_amdgcn_readfirstlane(F.tid >> 6); F.G = gridDim.x; F.blk = blockIdx.x;
    volatile LAS unsigned* misc = (volatile LAS unsigned*)(F.lds + LDS_MISC);
    if (F.tid < 16) misc[F.tid] = 0u;
    __syncthreads();
    const int lo = args.ph_lo, hi = args.ph_hi;
    XcdBarrier bar; bar.bar = (unsigned*)(F.ws + WS_CTL); bar.x = 0; bar.st = misc;
    if (hi - lo > 1) bar = xcd_barrier_post((unsigned*)(F.ws + WS_CTL), misc);
#ifndef PH_MASK
#define PH_MASK 0xFFFFFu
#endif
#define IN(k) (((PH_MASK >> ((k) % 20 >= 15 ? (k) - 10 : (k))) & 1u) && lo <= (k) && (k) < hi)
#define FRESH() do { F.tid = threadIdx.x; asm volatile("" : "+v"(F.tid)); F.lane = F.tid & 63; F.wave = __builtin_amdgcn_readfirstlane(F.tid >> 6); F.ws = (GAS unsigned char*)args.ws; asm volatile("" : "+s"(F.ws)); } while (0)
#ifndef REPEAT_MASK
#define REPEAT_MASK 0u
#endif
#define PHBIT(k) ((k) >= 15 ? (k) - 10 : (k))
#define REPEAT(k) _Pragma("unroll 1") for (int rep_ = 0, nrep_ = ((REPEAT_MASK >> PHBIT(k)) & 1u) ? 2 : 1; rep_ < nrep_; ++rep_, (void)((rep_ < nrep_) ? (xcd_barrier(bar), 0) : 0))
#define SEAM(k) do { if (IN(k) && IN((k) + 1)) xcd_barrier(bar); } while (0)
    LAS unsigned char* stage = F.lds;
#define MOD ((const float*)(F.ws + WS_MOD))

    if (IN(0)) REPEAT(0) { FRESH(); ph_prologue(F); } SEAM(0);
    if (IN(1)) REPEAT(1) { FRESH(); ph_norm1(F); ph_router_prep(F); } SEAM(1);
    if (IN(2)) REPEAT(2) { FRESH();
        pg8::Gemm g{(const bf16_t*)(F.ws + WS_HA), (const bf16_t*)(F.ws + WS_WPW1), NTOK, 2 * D, D}; pg8::StaticOrder S; S.init(NTOK, 2 * D, F.G, F.blk);
        pg8::EpiGated<0> E{(bf16_t*)(F.ws + WS_HB), D, GPTR(const float, args.in[I_PW1B]), D, nullptr};
        GEMM_PHASE<pg8::EpiGated<0>, pg8::StaticOrder>(stage, g, S, E);
    } SEAM(2);
    if (IN(3)) REPEAT(3) { FRESH(); ph_conv(F); } SEAM(3);
    if (IN(4)) REPEAT(4) { FRESH();
        pg8::Gemm g{(const bf16_t*)(F.ws + WS_HC), (const bf16_t*)(F.ws + WS_WPW2), NTOK, D, D}; pg8::StaticOrder S; S.init(NTOK, D, F.G, F.blk);
        pg8::EpiResidB<false> E{GPTR(const float, args.in[I_X]), (bf16_t*)(F.ws + WS_X), GPTR(const float, args.in[I_PW2B]), MOD + 2 * D};
        GEMM_PHASE<pg8::EpiResidB<false>, pg8::StaticOrder>(stage, g, S, E);
    } SEAM(4);
#pragma unroll 1
    for (int l = 0; l < 2; ++l) {
        const int pb = 5 + 10 * l;
        if (IN(pb)) REPEAT(pb) { FRESH(); ph_router(F, l); } do { if (IN(pb) && IN(pb + 2)) xcd_barrier(bar); } while (0);
        LAS int* lbexp = (LAS int*)(F.lds + 131072);
        LAS int* lfb = (LAS int*)(F.lds + 131072 + 2304);
        if (IN(pb + 2)) REPEAT(pb + 2) { FRESH();
            moe_layout(F, l, lbexp, lfb); const int nblk = __builtin_amdgcn_readfirstlane(lbexp[0]);
            pg8::Gemm g{(const bf16_t*)(F.ws + WS_HA), (const bf16_t*)(F.ws + WS_WGU) + (size_t)l * NE * 2 * DE * D, nblk * 256, 2 * DE, D};
            pg8::MoeGatherOrder S; S.init(nblk * 256, 2 * DE, F.G, F.blk); S.bexp = lbexp; S.estride = (size_t)2 * DE * D * 2; S.rowtab = (const unsigned*)(F.ws + WS_ROWTAB2); S.nrows_src = NTOK; S.fblk = lfb;
            pg8::EpiGated<1> E{(bf16_t*)(F.ws + WS_ACT), DE, GPTR(const float, args.in[I_BGU]) + (size_t)l * NE * 2 * DE, DE, lbexp};
            GEMM_PHASE<pg8::EpiGated<1>, pg8::MoeGatherOrder>(stage, g, S, E);
            { int nwg = S.nwg; asm volatile("" : "+s"(nwg)); FRESH(); if (l == 0) tail_fill(F, nwg, false, TF_A0, TF_A1); else tail_fill(F, nwg, true, TF_D0, 4096); }
        } SEAM(pb + 2);
        if (IN(pb + 3)) REPEAT(pb + 3) { FRESH();
            if (!IN(pb + 2)) moe_layout(F, l, lbexp, lfb);
            const int nblk = __builtin_amdgcn_readfirstlane(lbexp[0]);
            pg8::Gemm g{(const bf16_t*)(F.ws + WS_ACT), (const bf16_t*)(F.ws + WS_WDN) + (size_t)l * NE * DE * D, nblk * 256, D, DE};
            pg8::MoeOrder S; S.init(nblk * 256, D, F.G, F.blk); S.bexp = lbexp; S.estride = (size_t)DE * D * 2; S.rev = true;
            pg8::EpiBf16P E{(bf16_t*)(F.ws + WS_XG), D, GPTR(const float, args.in[I_BDN]) + (size_t)l * NE * D, D, lbexp};
            GEMM_PHASE<pg8::EpiBf16P, pg8::MoeOrder>(stage, g, S, E);
            { int nwg = S.nwg; asm volatile("" : "+s"(nwg)); FRESH(); if (l == 0) tail_fill(F, nwg, false, TF_A1, 8192); }
        } SEAM(pb + 3);
        if (IN(pb + 4)) REPEAT(pb + 4) { FRESH(); if (!IN(pb + 2)) moe_layout(F, l, nullptr, lfb); ph_combine(F, l, lfb); } SEAM(pb + 4);
        if (l == 0) {
            if (IN(10)) REPEAT(10) { FRESH();
#pragma unroll 1
                for (int gi = 0; gi < 2; ++gi) {
                    pg8::Gemm g{(const bf16_t*)(F.ws + (gi ? WS_HA : WS_HB)), (const bf16_t*)(F.ws + (gi ? WS_WDQ : WS_WDKV)), NTOK, 512, D}; pg8::StaticOrder S; S.init(NTOK, 512, F.G, F.blk);
                    pg8::EpiLatQ E{(bf16_t*)(F.ws + (gi ? WS_CQ : WS_CKV)), gi ? QLORA : KVLORA, gi ? QLORA : KVLORA, gi ? (bf16_t*)nullptr : (bf16_t*)(F.ws + WS_KR), (const f32x2*)(F.ws + WS_CS), (float*)(F.ws + (gi ? WS_SSPQ : WS_SSPKV))};
                    GEMM_PHASE<pg8::EpiLatQ, pg8::StaticOrder>(stage, g, S, E);
                    __syncthreads(); }
            } do { if (IN(10) && IN(12)) xcd_barrier(bar); } while (0);
            if (IN(12)) REPEAT(12) { FRESH();
#pragma unroll 1
                for (int gi = 0; gi < 3; ++gi) {
                    pg8::Gemm g{(const bf16_t*)(F.ws + (gi == 0 ? WS_CKV : gi == 1 ? WS_WUV : WS_CQ)), (const bf16_t*)(F.ws + (gi == 0 ? WS_WUK : gi == 1 ? WS_CKV : WS_WUQ)),
                                gi == 1 ? D : NTOK, gi == 0 ? D : gi == 1 ? NTOK : NH * DQK, gi == 2 ? QLORA : KVLORA};
                    pg8::StaticOrder S; S.init(g.M, g.N, F.G, F.blk);
                    pg8::EpiScaled E{(bf16_t*)(F.ws + (gi == 0 ? WS_KN : gi == 1 ? WS_VT : WS_Q)), g.N, (const float*)(F.ws + (gi == 2 ? WS_SSPQ : WS_SSPKV)), gi == 1 ? 1 : 0, gi == 2 ? 8 : 4, gi == 2 ? 1.0f / QLORA : 1.0f / KVLORA};
                    GEMM_PHASE<pg8::EpiScaled, pg8::StaticOrder>(stage, g, S, E);
                    __syncthreads(); }
            } SEAM(12);
            if (IN(13)) REPEAT(13) { FRESH(); ph_attn<0>(F);
#ifdef ATTN_PROBE
                xcd_barrier(bar); FRESH(); ph_attn<ATTN_PROBE>(F);
#endif
            } SEAM(13);
            if (IN(14)) REPEAT(14) { FRESH();
                pg8::Gemm g{(const bf16_t*)(F.ws + WS_HC), (const bf16_t*)(F.ws + WS_WO), NTOK, D, D}; pg8::StaticOrder S; S.init(NTOK, D, F.G, F.blk);
                pg8::EpiResidB<true> E{(const bf16_t*)(F.ws + WS_X2), (bf16_t*)(F.ws + WS_X), nullptr, MOD + (size_t)NB * 6 * D + 2 * D};
                GEMM_PHASE<pg8::EpiResidB<true>, pg8::StaticOrder>(stage, g, S, E);
            } SEAM(14);
        }
    }
#undef IN
#undef SEAM
#undef MOD
#undef FRESH
}

extern "C" void kernel_launch(void* const* d_in, const int* in_sizes, int n_in, void* d_out, int out_size, void* d_ws, size_t ws_size, hipStream_t stream) {
    static int grid = 0;
    if (grid == 0) {
        if (n_in != 31 || out_size != NTOK * D || ws_size < WS_END) { fprintf(stderr, "kernel_launch: unexpected shapes (n_in %d, out %d, ws %zu < %zu)\n", n_in, out_size, ws_size, (size_t)WS_END); grid = -1; return; }
        int dev = 0, cus = 0, per_cu = 0;
        if (hipGetDevice(&dev) != hipSuccess || hipDeviceGetAttribute(&cus, hipDeviceAttributeMultiprocessorCount, dev) != hipSuccess) { grid = -1; return; }
        if (hipFuncSetAttribute((const void*)yoco_fwd, hipFuncAttributeMaxDynamicSharedMemorySize, LDS_BYTES) != hipSuccess) { fprintf(stderr, "kernel_launch: hipFuncSetAttribute failed\n"); grid = -1; return; }
        if (hipOccupancyMaxActiveBlocksPerMultiprocessor(&per_cu, (const void*)yoco_fwd, NTHR, LDS_BYTES) != hipSuccess || per_cu < 1) fprintf(stderr, "kernel_launch: occupancy query says %d\n", per_cu);
        (void)hipGetLastError();
        grid = cus;
        if (grid != 256) fprintf(stderr, "kernel_launch: %d CUs (built for 256)\n", grid);
        if (grid > 256) grid = 256;
    }
    if (grid < 0) return;
    (void)hipMemsetAsync((char*)d_ws + WS_CTL, 0, WS_CTL_BYTES, stream);
    Args a{};
    for (int i = 0; i < 31; ++i) a.in[i] = (const float*)d_in[i];
    a.out = (float*)d_out; a.ws = (unsigned char*)d_ws;
#if N_LAUNCH_MODE == 1
    a.ph_lo = 0; a.ph_hi = NPH;
    hipLaunchKernelGGL(yoco_fwd, dim3(grid), dim3(NTHR), LDS_BYTES, stream, a);
#else
    for (int p = 0; p < NPH; ++p) { a.ph_lo = p; a.ph_hi = p + 1; hipLaunchKernelGGL(yoco_fwd, dim3(grid), dim3(NTHR), LDS_BYTES, stream, a); }
#endif
}
```
